# Optimizing an MI355X kernel written in HIP

```python
import jax, jax.numpy as jnp
from jax import lax
import numpy as np

D_MODEL = 1024
BATCH = 8
SEQ = 4096
DEPTH = 4

CHUNK = 64
Q_BLOCK = 128
D_PLE = 256
EPS = 1e-6
SB_HEADS = 8
SB_HEAD_DIM = 64
SB_WIDTH = SB_HEADS * SB_HEAD_DIM
MLA_HEADS = 8
MLA_NOPE = 64
MLA_ROPE = 32
MLA_QK = MLA_NOPE + MLA_ROPE
MLA_V = 64
MLA_Q_RANK = 384
MLA_KV_RANK = 256
MLA_WIDTH = MLA_HEADS * MLA_V
MIX_WIDTH = SB_WIDTH + MLA_WIDTH
ROPE_THETA = 10000.0
SPLITS = [SB_WIDTH, 2 * SB_WIDTH, 3 * SB_WIDTH,
          3 * SB_WIDTH + MLA_Q_RANK,
          3 * SB_WIDTH + MLA_Q_RANK + MLA_KV_RANK]
IN_COLS = 3 * SB_WIDTH + MLA_Q_RANK + MLA_KV_RANK + MLA_ROPE
N_GROUPS = 4
EXPERTS_PER_GROUP = 8
N_EXPERTS = N_GROUPS * EXPERTS_PER_GROUP
TOP_K = 2
D_EXPERT = 256

kernel_name = "hybrid_sb_mla_hmoe_ple_trunk"


def rmsnorm(x, g):
    xf = x.astype(jnp.float32)
    y = xf * lax.rsqrt(jnp.mean(xf * xf, axis=-1, keepdims=True) + EPS)
    return (y * g.astype(jnp.float32)).astype(x.dtype)


def apply_rope(x, cos, sin):
    half = x.shape[-1] // 2
    x1, x2 = x[..., :half], x[..., half:]
    return jnp.concatenate([x1 * cos - x2 * sin, x2 * cos + x1 * sin], axis=-1)


def split_heads(t, n):
    b, s, _ = t.shape
    return t.reshape(b, s, n, -1).transpose(0, 2, 1, 3)


def merge_heads(t):
    b, h, s, d = t.shape
    return t.transpose(0, 2, 1, 3).reshape(b, s, h * d)


def to_blocks(t):
    b, h, s, d = t.shape
    return t.reshape(b, h, s // Q_BLOCK, Q_BLOCK, d).transpose(2, 0, 1, 3, 4)


def from_blocks(t):
    nb, b, h, qb, d = t.shape
    return t.transpose(1, 2, 0, 3, 4).reshape(b, h, nb * qb, d)


def stick_breaking_attention(q, k, v):
    s_len, dh = q.shape[2], q.shape[3]
    scale = dh ** -0.5
    key_idx = jnp.arange(s_len)

    def block(args):
        q_blk, start = args
        z = jnp.einsum("bhqd,bhkd->bhqk", q_blk, k).astype(jnp.float32) * scale
        q_idx = start + jnp.arange(Q_BLOCK)
        mask = key_idx[None, :] < q_idx[:, None]
        log_not = jnp.where(mask, jax.nn.log_sigmoid(-z), 0.0)
        later = lax.cumsum(log_not, axis=3, reverse=True) - log_not
        w = jnp.where(mask, jnp.exp(jax.nn.log_sigmoid(z) + later), 0.0)
        return jnp.einsum("bhqk,bhkd->bhqd", w.astype(v.dtype), v)

    starts = jnp.arange(s_len // Q_BLOCK) * Q_BLOCK
    return from_blocks(lax.map(block, (to_blocks(q), starts)))


def chunk_causal_softmax_attention(q, k, v):
    s_len, dh = q.shape[2], q.shape[3]
    scale = dh ** -0.5
    key_chunk = jnp.arange(s_len) // CHUNK

    def block(args):
        q_blk, start = args
        sc = jnp.einsum("bhqd,bhkd->bhqk", q_blk, k).astype(jnp.float32) * scale
        q_chunk = (start + jnp.arange(Q_BLOCK)) // CHUNK
        mask = key_chunk[None, :] <= q_chunk[:, None]
        pr = jax.nn.softmax(jnp.where(mask, sc, -jnp.inf), axis=-1)
        return jnp.einsum("bhqk,bhkd->bhqd", pr.astype(v.dtype), v)

    starts = jnp.arange(s_len // Q_BLOCK) * Q_BLOCK
    return from_blocks(lax.map(block, (to_blocks(q), starts)))


def hier_moe(x, w_rg, b_rg, w_re, b_re, w_gate, w_up, w_down):
    b, s, d = x.shape
    t = x.reshape(-1, d)
    tf = t.astype(jnp.float32)
    group_p = jax.nn.softmax(tf @ w_rg.astype(jnp.float32) + b_rg.astype(jnp.float32), axis=-1)
    gp, g = lax.top_k(group_p, 1)
    e_logits = (tf @ w_re.astype(jnp.float32) + b_re.astype(jnp.float32)).reshape(-1, N_GROUPS, EXPERTS_PER_GROUP)
    e_logits = jnp.take_along_axis(e_logits, g[:, :, None], axis=1)[:, 0]
    top_l, top_i = lax.top_k(e_logits, TOP_K)
    top_w = jax.nn.softmax(top_l, axis=-1) * gp
    expert_id = g * EXPERTS_PER_GROUP + top_i
    combine = jnp.sum(jax.nn.one_hot(expert_id, N_EXPERTS, dtype=jnp.float32) * top_w[..., None], axis=1)
    y = jnp.zeros_like(tf)
    for e in range(N_EXPERTS):
        hid = jax.nn.silu(t @ w_gate[e]) * (t @ w_up[e])
        y = y + combine[:, e:e + 1] * (hid @ w_down[e]).astype(jnp.float32)
    return y.astype(x.dtype).reshape(b, s, d)


def setup_inputs(seed: int = 0) -> dict:
    key = jax.random.key(seed)
    ks = iter(jax.random.split(key, 32))
    f32 = jnp.float32

    def w(shape, fan_in):
        return jax.random.normal(next(ks), shape, f32) * (fan_in ** -0.5)

    def gain(shape):
        return 1.0 + 0.02 * jax.random.normal(next(ks), shape, f32)

    x = jax.random.normal(next(ks), (BATCH, SEQ, D_MODEL), f32)
    p = jax.random.normal(next(ks), (DEPTH, BATCH, SEQ, D_PLE), f32)
    offsets = jax.random.randint(next(ks), (BATCH,), 0, 1000, dtype=jnp.int32) * CHUNK
    positions = (offsets[:, None] + jnp.arange(SEQ, dtype=jnp.int32)[None, :]).astype(jnp.int32)
    return {
        "x": x,
        "p": p,
        "positions": positions,
        "g_mix": gain((DEPTH, D_MODEL)),
        "w_in": w((DEPTH, D_MODEL, IN_COLS), D_MODEL),
        "g_cq": gain((DEPTH, MLA_Q_RANK)),
        "w_uq": w((DEPTH, MLA_Q_RANK, MLA_HEADS * MLA_QK), MLA_Q_RANK),
        "g_ckv": gain((DEPTH, MLA_KV_RANK)),
        "w_ukv": w((DEPTH, MLA_KV_RANK, MLA_HEADS * (MLA_NOPE + MLA_V)), MLA_KV_RANK),
        "g_osb": gain((DEPTH, SB_WIDTH)),
        "g_omla": gain((DEPTH, MLA_WIDTH)),
        "w_out": w((DEPTH, MIX_WIDTH, D_MODEL), MIX_WIDTH),
        "g_moe": gain((DEPTH, D_MODEL)),
        "w_rg": w((DEPTH, D_MODEL, N_GROUPS), D_MODEL),
        "b_rg": 0.01 * jax.random.normal(next(ks), (DEPTH, N_GROUPS), f32),
        "w_re": w((DEPTH, D_MODEL, N_EXPERTS), D_MODEL),
        "b_re": 0.01 * jax.random.normal(next(ks), (DEPTH, N_EXPERTS), f32),
        "w_gate": w((DEPTH, N_EXPERTS, D_MODEL, D_EXPERT), D_MODEL),
        "w_up": w((DEPTH, N_EXPERTS, D_MODEL, D_EXPERT), D_MODEL),
        "w_down": w((DEPTH, N_EXPERTS, D_EXPERT, D_MODEL), D_EXPERT),
        "g_ple": gain((DEPTH, D_MODEL)),
        "w_pg": w((DEPTH, D_MODEL, D_MODEL), D_MODEL),
        "w_pe": w((DEPTH, D_PLE, D_MODEL), D_PLE),
        "g_final": gain((D_MODEL,)),
    }


def reference(x, p, positions, g_mix, w_in, g_cq, w_uq, g_ckv, w_ukv, g_osb, g_omla,
              w_out, g_moe, w_rg, b_rg, w_re, b_re, w_gate, w_up, w_down,
              g_ple, w_pg, w_pe, g_final):
    b, s, _ = x.shape
    inv_freq = ROPE_THETA ** (-jnp.arange(0, MLA_ROPE, 2, dtype=jnp.float32) / MLA_ROPE)
    ang = positions.astype(jnp.float32)[..., None] * inv_freq
    cos = jnp.cos(ang).astype(x.dtype)
    sin = jnp.sin(ang).astype(x.dtype)

    h = x
    for i in range(DEPTH):
        hn = rmsnorm(h, g_mix[i])
        proj = hn @ w_in[i]
        q_sb, k_sb, v_sb, c_q, c_kv, k_r = jnp.split(proj, SPLITS, axis=-1)

        o_sb = merge_heads(stick_breaking_attention(
            split_heads(q_sb, SB_HEADS), split_heads(k_sb, SB_HEADS), split_heads(v_sb, SB_HEADS)))

        q = (rmsnorm(c_q, g_cq[i]) @ w_uq[i]).reshape(b, s, MLA_HEADS, MLA_QK)
        q_nope, q_rope = q[..., :MLA_NOPE], q[..., MLA_NOPE:]
        q_rope = apply_rope(q_rope, cos[:, :, None, :], sin[:, :, None, :])
        kv = (rmsnorm(c_kv, g_ckv[i]) @ w_ukv[i]).reshape(b, s, MLA_HEADS, MLA_NOPE + MLA_V)
        k_nope, v_mla = kv[..., :MLA_NOPE], kv[..., MLA_NOPE:]
        k_rope = jnp.broadcast_to(apply_rope(k_r, cos, sin)[:, :, None, :], (b, s, MLA_HEADS, MLA_ROPE))
        q_full = jnp.concatenate([q_nope, q_rope], axis=-1).transpose(0, 2, 1, 3)
        k_full = jnp.concatenate([k_nope, k_rope], axis=-1).transpose(0, 2, 1, 3)
        o_mla = merge_heads(chunk_causal_softmax_attention(q_full, k_full, v_mla.transpose(0, 2, 1, 3)))

        mixed = jnp.concatenate([rmsnorm(o_sb, g_osb[i]), rmsnorm(o_mla, g_omla[i])], axis=-1)
        h = h + mixed @ w_out[i]

        h = h + hier_moe(rmsnorm(h, g_moe[i]), w_rg[i], b_rg[i], w_re[i], b_re[i],
                         w_gate[i], w_up[i], w_down[i])

        gate = jax.nn.sigmoid((rmsnorm(h, g_ple[i]) @ w_pg[i]).astype(jnp.float32))
        h = h + (gate * (p[i] @ w_pe[i]).astype(jnp.float32)).astype(h.dtype)

    return rmsnorm(h, g_final)
```

```cpp
#include <hip/hip_runtime.h>
#include <cstdio>
#include <cstdint>
#include <cmath>

#define GAS __attribute__((address_space(1)))
#define LAS __attribute__((address_space(3)))
typedef unsigned short bf16_t;
typedef short bf16x8 __attribute__((ext_vector_type(8)));
typedef float f32x4 __attribute__((ext_vector_type(4)));
typedef float f32x2 __attribute__((ext_vector_type(2)));
typedef unsigned u32x4 __attribute__((ext_vector_type(4)));
typedef unsigned u32x2 __attribute__((ext_vector_type(2)));

constexpr int NB = 8, SEQ = 4096, DM = 1024, NLAYER = 4, T = NB * SEQ;
constexpr int DPLE = 256, SBW = 512, MLAW = 512, QRANK = 384, KVRANK = 256, ROPE = 32, QKD = 96;
constexpr int INC = 2208, INP = 2304;
constexpr int NEXP = 32, DEXP = 256;
constexpr float EPS = 1e-6f;
constexpr float LOG2E = 1.4426950408889634f;
constexpr float QS_SB = 0.125f * LOG2E;
constexpr float QS_MLA = 0.10206207261596575f * LOG2E;
constexpr int NWAVES = 8, NTHREADS = 512;

constexpr size_t MiB = 1u << 20;
constexpr size_t WS_CTL = 0, CTL_BYTES = 1 * MiB;
constexpr size_t WS_COS = 1 * MiB, WS_SIN = 3 * MiB;
constexpr size_t WS_RS = 5 * MiB, WS_RSCQ = 6 * MiB, WS_RSCKV = 7 * MiB;
constexpr size_t WS_LISTE = 8 * MiB, WS_LISTW = 12 * MiB;
constexpr size_t WS_WR = 16 * MiB;
constexpr size_t WS_WSM = 18 * MiB, WSM_STRIDE = 11 * MiB;
constexpr size_t WSM_IN = 0, WSM_OUT = 4608 * 1024, WSM_PG = WSM_OUT + 2 * MiB, WSM_UQ = WSM_PG + 2 * MiB, WSM_UKV = WSM_UQ + 576 * 1024, WSM_PE = WSM_UKV + 512 * 1024;
constexpr size_t WS_WG1 = 62 * MiB, WS_WD = 94 * MiB;
constexpr size_t WS_H32 = 110 * MiB, WS_HB = 238 * MiB;
constexpr size_t WS_ATT = 302 * MiB;
constexpr size_t WS_QKV = WS_ATT, WS_CKV = WS_ATT + 96 * MiB, WS_CQ = WS_CKV + 16 * MiB, WS_KR = WS_CQ + 24 * MiB, WS_QM = WS_KR + 2 * MiB,
                 WS_KN = WS_QM + 48 * MiB, WS_VM = WS_KN + 32 * MiB, WS_OA = WS_VM + 32 * MiB, WS_ATT_END = WS_OA + 64 * MiB;
constexpr size_t WS_HID = WS_ATT, WS_Y = WS_ATT + 36 * MiB, WS_PE = WS_Y + 128 * MiB, WS_PB = WS_PE + 64 * MiB, WS_MOE_END = WS_PB + 16 * MiB;
constexpr size_t WS_END = WS_ATT_END > WS_MOE_END ? WS_ATT_END : WS_MOE_END;
static_assert(WSM_PE + 512 * 1024 <= WSM_STRIDE, "small weights");
static_assert(WS_WSM + 4 * WSM_STRIDE <= WS_WG1, "ws map");
constexpr int CW_CNT = 1024;

constexpr int LDS_BYTES = 152 * 1024;

struct Params {
    const float* in[24];
    float* out;
    unsigned char* ws;
    float inv_freq[16];
};

__device__ __forceinline__ float bf2f(unsigned v) { return __uint_as_float(v << 16); }
__device__ __forceinline__ unsigned f2bf(float f) { unsigned u = __float_as_uint(f); return (u + 0x7fffu + ((u >> 16) & 1u)) >> 16; }
__device__ __forceinline__ unsigned pk2(float lo, float hi) { return f2bf(lo) | (f2bf(hi) << 16); }
__device__ __forceinline__ float wave_sum(float v) {
#pragma unroll
    for (int o = 1; o < 64; o <<= 1) v += __shfl_xor(v, o);
    return v;
}
__device__ __forceinline__ float fexp2(float x) { return __builtin_amdgcn_exp2f(x); }
__device__ __forceinline__ float flog2(float x) { return __builtin_amdgcn_logf(x); }
__device__ __forceinline__ float frcp(float x) { return __builtin_amdgcn_rcpf(x); }
__device__ __forceinline__ void unpack8(u32x4 w, float* f) {
    f[0] = __uint_as_float(w.x << 16); f[1] = __uint_as_float(w.x & 0xffff0000u);
    f[2] = __uint_as_float(w.y << 16); f[3] = __uint_as_float(w.y & 0xffff0000u);
    f[4] = __uint_as_float(w.z << 16); f[5] = __uint_as_float(w.z & 0xffff0000u);
    f[6] = __uint_as_float(w.w << 16); f[7] = __uint_as_float(w.w & 0xffff0000u);
}
__device__ __forceinline__ u32x4 pack8(f32x4 a, f32x4 b) { u32x4 w; w.x = pk2(a[0], a[1]); w.y = pk2(a[2], a[3]); w.z = pk2(b[0], b[1]); w.w = pk2(b[2], b[3]); return w; }

namespace pg8 {
constexpr int BM = 256, BK = 64, HALF = 128, HTB = HALF * BK * 2, STAGE_BYTES = 8 * HTB, NXCD = 8, WGM = 8;
__host__ __device__ __forceinline__ int lds_byte(int r, int c) { const int st = (r >> 4) * 2 + (c >> 5), rr = r & 15, cc = c & 31, ob = rr * 64 + cc * 2; return st * 1024 + (ob ^ (((ob >> 9) & 1) << 5)); }
__host__ __device__ __forceinline__ void stage_rc(int b, int& R, int& C) { const int st = b / 1024, sb = b % 1024, swz = sb ^ (((sb >> 9) & 1) << 5); R = (st >> 1) * 16 + swz / 64; C = (st & 1) * 32 + (swz % 64) / 2; }
__host__ __device__ __forceinline__ int perm32(int rho) { const int n = rho >> 4, i = rho & 15; return 8 * (i >> 2) + 4 * n + (i & 3); }

struct Unit { int pm, pn, e, tile, nrows; };

struct StaticOrder {
    int nM, nN, nwg, G, c;
    __device__ void init(int M, int N, int G_, int c_) { nM = M / BM; nN = N / BM; nwg = nM * nN; G = G_; c = c_; }
    __device__ bool next(int i, Unit& u) const {
        const long L = (long)i * G + c; if (L >= nwg) return false;
        int wgid = (int)L; { const int q = nwg / NXCD, r = nwg % NXCD, xcd = wgid % NXCD, off = wgid / NXCD; wgid = (xcd < r ? xcd * (q + 1) : r * (q + 1) + (xcd - r) * q) + off; }
        const int nig = WGM * nN, gid = wgid / nig, fm = gid * WGM, gsz = (nM - fm) < WGM ? (nM - fm) : WGM;
        u.pm = fm + ((wgid % nig) % gsz); u.pn = (wgid % nig) / gsz; u.e = 0; u.tile = 0; u.nrows = 256; return true;
    }
};

template <class Epi, class Sched>
__device__ __forceinline__ void gemm_phase(LAS unsigned char* lds, const char* Abase, const int K, const Sched& S, const Epi& E) {
    const int tid = threadIdx.x, wid = __builtin_amdgcn_readfirstlane(tid >> 6), lane = tid & 63, wr = wid >> 2, wc = wid & 3, fr = lane & 15, fq = lane >> 4;
    const int nt = K / BK;
    unsigned voffB[2];
#pragma unroll
    for (int i = 0; i < 2; ++i) { int R, C; stage_rc(tid * 16 + i * 8192, R, C); const int Rb = (R & ~31) + perm32(R & 31); voffB[i] = (unsigned)(Rb * K + C) * 2u; }
    const size_t kstep = (size_t)(BK * 2);
    const size_t hstep = (size_t)HALF * K * 2;
    const unsigned ldsw = (unsigned)wid * 1024u;
    const int aoff = lds_byte(wr * 64 + fr, fq * 8), boff = lds_byte(wc * 32 + fr, fq * 8);
#define PG8_SA(b, h) (((b) * 2 + (h)) * HTB)
#define PG8_SB(b, h) ((4 + (b) * 2 + (h)) * HTB)
#define PG8_STAGE(bufoff, gbase, voff) do { _Pragma("unroll") for (int _i = 0; _i < 2; ++_i) \
        __builtin_amdgcn_global_load_lds((const unsigned*)((const char*)(gbase) + (voff)[_i]), (LAS unsigned*)(lds + (bufoff) + ldsw + _i * 8192), 16, 0, 0); } while (0)
#define PG8_LDA(dst, b, h) do { _Pragma("unroll") for (int m = 0; m < 4; ++m) _Pragma("unroll") for (int k = 0; k < 2; ++k) dst[m][k] = *(const LAS bf16x8*)(lds + PG8_SA(b, h) + aoff + m * 2048 + k * 1024); } while (0)
#define PG8_LDB(dst, b, h) do { _Pragma("unroll") for (int n = 0; n < 2; ++n) _Pragma("unroll") for (int k = 0; k < 2; ++k) dst[n][k] = *(const LAS bf16x8*)(lds + PG8_SB(b, h) + boff + n * 2048 + k * 1024); } while (0)
#define PG8_MMA(ai, bj, At, Bt) do { __builtin_amdgcn_s_setprio(1); _Pragma("unroll") for (int m = 0; m < 4; ++m) _Pragma("unroll") for (int n = 0; n < 2; ++n) _Pragma("unroll") for (int k = 0; k < 2; ++k) \
        acc[ai][bj][m][n] = __builtin_amdgcn_mfma_f32_16x16x32_bf16(Bt[n][k], At[m][k], acc[ai][bj][m][n], 0, 0, 0); __builtin_amdgcn_s_setprio(0); } while (0)
#define PG8_WAIT_V(n) asm volatile("s_waitcnt vmcnt(" #n ")" ::: "memory")
#define PG8_WAIT_L(n) asm volatile("s_waitcnt lgkmcnt(" #n ")" ::: "memory")
#define PG8_BAR __builtin_amdgcn_s_barrier()
#define PG8_SCHED __builtin_amdgcn_sched_barrier(0)
    Unit cur, nxt; int ui = 0;
    if (!S.next(0, cur)) return;
    f32x4 acc[2][2][4][2];
#pragma unroll
    for (int a = 0; a < 2; ++a)
#pragma unroll
        for (int b = 0; b < 2; ++b)
#pragma unroll
            for (int m = 0; m < 4; ++m)
#pragma unroll
                for (int n = 0; n < 2; ++n) acc[a][b][m][n] = (f32x4){0.f, 0.f, 0.f, 0.f};
    bf16x8 At[4][2], B0[2][2], B1[2][2];
    unsigned vc[2][2];
    LAS u32x4* vslot = (LAS u32x4*)(lds + STAGE_BYTES + 1024) + tid;
#define PG8_AOFFS(dst, U) do { int t2_ = tid; asm volatile("" : "+v"(t2_)); _Pragma("unroll") for (int i = 0; i < 2; ++i) { int R, C; stage_rc(t2_ * 16 + i * 8192, R, C); \
        dst[0][i] = S.a_off(U, R) + (unsigned)C * 2u; dst[1][i] = S.a_off(U, HALF + R) + (unsigned)C * 2u; } } while (0)
    PG8_AOFFS(vc, cur);
    const char* cB = S.b_tile(cur);
    PG8_STAGE(PG8_SB(0, 0), cB, voffB); PG8_STAGE(PG8_SB(0, 1), cB + hstep, voffB); PG8_STAGE(PG8_SA(0, 0), Abase, vc[0]); PG8_STAGE(PG8_SA(0, 1), Abase, vc[1]);
    if (wr == 1) PG8_BAR;
    PG8_WAIT_V(2); PG8_BAR;
    PG8_STAGE(PG8_SB(1, 0), cB + kstep, voffB); PG8_STAGE(PG8_SA(1, 0), Abase + kstep, vc[0]); PG8_STAGE(PG8_SB(1, 1), cB + hstep + kstep, voffB);
    PG8_WAIT_V(6); PG8_BAR;
    for (;;) {
        const bool has_next = S.next(ui + 1, nxt);
        const char* nB = cB;
        { unsigned vn[2][2];
          if (has_next) { PG8_AOFFS(vn, nxt); nB = S.b_tile(nxt); *vslot = (u32x4){vn[0][0], vn[0][1], vn[1][0], vn[1][1]}; }
          else *vslot = (u32x4){vc[0][0], vc[0][1], vc[1][0], vc[1][1]}; }
        for (int t = 0; t < nt; t += 2) {
            const bool last = (t == nt - 2);
            const char* a1 = Abase + (size_t)(t + 1) * kstep;
            const char* a2 = last ? Abase : Abase + (size_t)(t + 2) * kstep; const char* b2 = last ? nB : cB + (size_t)(t + 2) * kstep;
            const char* a3 = a2 + kstep; const char* b3 = b2 + kstep;
            unsigned w2[2][2];
            if (last) { const u32x4 q = *vslot; w2[0][0] = q.x; w2[0][1] = q.y; w2[1][0] = q.z; w2[1][1] = q.w; }
            else { w2[0][0] = vc[0][0]; w2[0][1] = vc[0][1]; w2[1][0] = vc[1][0]; w2[1][1] = vc[1][1]; }
            PG8_LDB(B0, 0, 0); PG8_LDB(B1, 0, 1); PG8_SCHED; PG8_LDA(At, 0, 0); PG8_STAGE(PG8_SA(1, 1), a1, vc[1]);
            PG8_WAIT_V(8); PG8_WAIT_L(0); PG8_BAR; PG8_MMA(0, 0, At, B0); PG8_MMA(0, 1, At, B1); PG8_BAR; PG8_SCHED;
            PG8_LDA(At, 0, 1); PG8_STAGE(PG8_SB(0, 0), b2, voffB); PG8_STAGE(PG8_SB(0, 1), b2 + hstep, voffB); PG8_STAGE(PG8_SA(0, 0), a2, w2[0]);
            PG8_WAIT_V(8); PG8_WAIT_L(0); PG8_BAR; PG8_MMA(1, 0, At, B0); PG8_MMA(1, 1, At, B1); PG8_BAR; PG8_SCHED;
            PG8_LDB(B0, 1, 0); PG8_LDB(B1, 1, 1); PG8_SCHED; PG8_LDA(At, 1, 0); PG8_STAGE(PG8_SA(0, 1), a2, w2[1]);
            PG8_WAIT_V(8); PG8_WAIT_L(0); PG8_BAR; PG8_MMA(0, 0, At, B0); PG8_MMA(0, 1, At, B1); PG8_BAR; PG8_SCHED;
            PG8_LDA(At, 1, 1); PG8_STAGE(PG8_SB(1, 0), b3, voffB); PG8_STAGE(PG8_SB(1, 1), b3 + hstep, voffB); PG8_STAGE(PG8_SA(1, 0), a3, w2[0]);
            PG8_WAIT_V(8); PG8_WAIT_L(0); PG8_BAR; PG8_MMA(1, 0, At, B0); PG8_MMA(1, 1, At, B1); PG8_BAR; PG8_SCHED;
        }
        if (wr == 0) PG8_BAR;
        { int fr2 = fr, fq2 = fq; asm volatile("" : "+v"(fr2), "+v"(fq2));
          E(acc, cur, wr, wc, fr2, fq2); }
        if (!has_next) break;
#pragma unroll
        for (int a = 0; a < 2; ++a)
#pragma unroll
            for (int b = 0; b < 2; ++b)
#pragma unroll
                for (int m = 0; m < 4; ++m)
#pragma unroll
                    for (int n = 0; n < 2; ++n) acc[a][b][m][n] = (f32x4){0.f, 0.f, 0.f, 0.f};
        cur = nxt; cB = nB; ++ui;
        { const u32x4 q = *vslot; vc[0][0] = q.x; vc[0][1] = q.y; vc[1][0] = q.z; vc[1][1] = q.w; }
        if (wr == 1) PG8_BAR;
    }
    PG8_WAIT_V(0);
    PG8_BAR;
#undef PG8_AOFFS
#undef PG8_SA
#undef PG8_SB
#undef PG8_STAGE
#undef PG8_LDA
#undef PG8_LDB
#undef PG8_MMA
#undef PG8_WAIT_V
#undef PG8_WAIT_L
#undef PG8_BAR
#undef PG8_SCHED
}
}
using pg8::Unit;

struct DenseSched {
    pg8::StaticOrder o; const char* Bt; int K;
    __device__ __forceinline__ bool next(int i, Unit& u) const { return o.next(i, u); }
    __device__ __forceinline__ unsigned a_off(const Unit& u, int r) const { return (unsigned)(u.pm * 256 + r) * (unsigned)(K * 2); }
    __device__ __forceinline__ const char* b_tile(const Unit& u) const { return Bt + (size_t)u.pn * 256 * K * 2; }
};
struct MoeSched {
    int G, c, npn, gather; const LAS int* tb; const int* liste; const char* Bt; int K, nB;
    __device__ __forceinline__ bool next(int i, Unit& u) const {
        const int L = i * G + c, ntile = tb[32];
        if (L >= ntile * npn) return false;
        const int ti = L / npn; u.pn = L % npn; u.pm = ti;
        int e = 0;
#pragma unroll 1
        for (; e < 31; ++e) if (ti < tb[e + 1]) break;
        u.e = e; u.tile = ti - tb[e]; const int rem = tb[40 + e] - 256 * u.tile; u.nrows = rem < 256 ? rem : 256; return true;
    }
    __device__ __forceinline__ unsigned a_off(const Unit& u, int r) const {
        if (gather) { int tok = 0; if (r < u.nrows) tok = liste[(size_t)u.e * T + 256 * u.tile + r] >> 1; return (unsigned)tok * (unsigned)(K * 2); }
        return (unsigned)(u.pm * 256 + r) * (unsigned)(K * 2);
    }
    __device__ __forceinline__ const char* b_tile(const Unit& u) const { return Bt + ((size_t)u.e * nB + (size_t)u.pn * 256) * K * 2; }
};

struct EpiIn {
    const float* RS; bf16_t* QKV; bf16_t* CKV; bf16_t* CQ; bf16_t* KR; const float* COS; const float* SIN;
    __device__ __forceinline__ void operator()(const f32x4 (&acc)[2][2][4][2], const Unit& u, int wr, int wc, int fr, int fq) const {
        const int pn = u.pn;
#pragma unroll
        for (int ai = 0; ai < 2; ++ai)
#pragma unroll
            for (int m = 0; m < 4; ++m) {
                const int row = u.pm * 256 + ai * 128 + wr * 64 + m * 16 + fr; const float rs = RS[row];
#pragma unroll
                for (int bj = 0; bj < 2; ++bj) {
                    const int c = bj * 128 + wc * 32 + fq * 8;
                    f32x4 v0 = acc[ai][bj][m][0] * rs, v1 = acc[ai][bj][m][1] * rs;
                    if (pn < 6) { if (pn < 2) { v0 = v0 * QS_SB; v1 = v1 * QS_SB; } *(u32x4*)(QKV + (size_t)row * 1536 + pn * 256 + c) = pack8(v0, v1); }
                    else if (pn == 6) { *(u32x4*)(CKV + (size_t)row * 256 + c) = pack8(v0, v1); }
                    else if (pn == 7) { *(u32x4*)(CQ + (size_t)row * 384 + c) = pack8(v0, v1); }
                    else if (bj == 0) { *(u32x4*)(CQ + (size_t)row * 384 + 256 + c) = pack8(v0, v1); }
                    else if (wc == 0) {
                        const int ib = 8 * (fq & 1);
                        const f32x4 c0 = *(const f32x4*)(COS + (size_t)row * 16 + ib), c1 = *(const f32x4*)(COS + (size_t)row * 16 + ib + 4);
                        const f32x4 s0 = *(const f32x4*)(SIN + (size_t)row * 16 + ib), s1 = *(const f32x4*)(SIN + (size_t)row * 16 + ib + 4);
                        f32x4 p0, p1;
#pragma unroll
                        for (int i = 0; i < 4; ++i) { p0[i] = __shfl_xor(v0[i], 32); p1[i] = __shfl_xor(v1[i], 32); }
                        const float sg = (fq < 2) ? -1.f : 1.f;
                        const f32x4 o0 = v0 * c0 + p0 * s0 * sg, o1 = v1 * c1 + p1 * s1 * sg;
                        *(u32x4*)(KR + (size_t)row * 32 + fq * 8) = pack8(o0, o1);
                    }
                }
                asm volatile("" ::: "memory");
            }
    }
};
struct EpiUq {
    const float* RS; bf16_t* QM; const float* COS; const float* SIN;
    __device__ __forceinline__ void operator()(const f32x4 (&acc)[2][2][4][2], const Unit& u, int wr, int wc, int fr, int fq) const {
#pragma unroll
        for (int ai = 0; ai < 2; ++ai)
#pragma unroll
            for (int m = 0; m < 4; ++m) {
                const int row = u.pm * 256 + ai * 128 + wr * 64 + m * 16 + fr; const float rs = RS[row] * QS_MLA;
#pragma unroll
                for (int bj = 0; bj < 2; ++bj) {
                    const int c = u.pn * 256 + bj * 128 + wc * 32 + fq * 8; const int g32 = u.pn * 8 + bj * 4 + wc;
                    f32x4 v0 = acc[ai][bj][m][0] * rs, v1 = acc[ai][bj][m][1] * rs;
                    if ((g32 % 3) == 2) {
                        const int ib = 8 * (fq & 1);
                        const f32x4 c0 = *(const f32x4*)(COS + (size_t)row * 16 + ib), c1 = *(const f32x4*)(COS + (size_t)row * 16 + ib + 4);
                        const f32x4 s0 = *(const f32x4*)(SIN + (size_t)row * 16 + ib), s1 = *(const f32x4*)(SIN + (size_t)row * 16 + ib + 4);
                        f32x4 p0, p1;
#pragma unroll
                        for (int i = 0; i < 4; ++i) { p0[i] = __shfl_xor(v0[i], 32); p1[i] = __shfl_xor(v1[i], 32); }
                        const float sg = (fq < 2) ? -1.f : 1.f;
                        v0 = v0 * c0 + p0 * s0 * sg; v1 = v1 * c1 + p1 * s1 * sg;
                    }
                    *(u32x4*)(QM + (size_t)row * 768 + c) = pack8(v0, v1);
                }
                asm volatile("" ::: "memory");
            }
    }
};
struct EpiUkv {
    const float* RS; bf16_t* KN; bf16_t* VM;
    __device__ __forceinline__ void operator()(const f32x4 (&acc)[2][2][4][2], const Unit& u, int wr, int wc, int fr, int fq) const {
        bf16_t* dst = u.pn < 2 ? KN : VM; const int cb = (u.pn & 1) * 256;
#pragma unroll
        for (int ai = 0; ai < 2; ++ai)
#pragma unroll
            for (int m = 0; m < 4; ++m) {
                const int row = u.pm * 256 + ai * 128 + wr * 64 + m * 16 + fr; const float rs = RS[row];
#pragma unroll
                for (int bj = 0; bj < 2; ++bj) { const int c = cb + bj * 128 + wc * 32 + fq * 8;
                    *(u32x4*)(dst + (size_t)row * 512 + c) = pack8(acc[ai][bj][m][0] * rs, acc[ai][bj][m][1] * rs); }
            }
    }
};
struct EpiBf {
    bf16_t* O; int ldc;
    __device__ __forceinline__ void operator()(const f32x4 (&acc)[2][2][4][2], const Unit& u, int wr, int wc, int fr, int fq) const {
#pragma unroll
        for (int ai = 0; ai < 2; ++ai)
#pragma unroll
            for (int m = 0; m < 4; ++m) {
                const int row = u.pm * 256 + ai * 128 + wr * 64 + m * 16 + fr;
#pragma unroll
                for (int bj = 0; bj < 2; ++bj) { const int c = u.pn * 256 + bj * 128 + wc * 32 + fq * 8;
                    *(u32x4*)(O + (size_t)row * ldc + c) = pack8(acc[ai][bj][m][0], acc[ai][bj][m][1]); }
            }
    }
};
struct EpiOut {
    const float* hin; float* hout;
    __device__ __forceinline__ void operator()(const f32x4 (&acc)[2][2][4][2], const Unit& u, int wr, int wc, int fr, int fq) const {
#pragma unroll
        for (int ai = 0; ai < 2; ++ai)
#pragma unroll
            for (int m = 0; m < 4; ++m) {
                const int row = u.pm * 256 + ai * 128 + wr * 64 + m * 16 + fr;
#pragma unroll
                for (int bj = 0; bj < 2; ++bj) { const size_t o = (size_t)row * DM + u.pn * 256 + bj * 128 + wc * 32 + fq * 8;
                    const f32x4 a = *(const f32x4*)(hin + o), b = *(const f32x4*)(hin + o + 4);
                    *(f32x4*)(hout + o) = a + acc[ai][bj][m][0]; *(f32x4*)(hout + o + 4) = b + acc[ai][bj][m][1]; }
                asm volatile("" ::: "memory");
            }
    }
};
struct EpiG1 {
    const float* RS; const int* liste; bf16_t* HID;
    __device__ __forceinline__ void operator()(const f32x4 (&acc)[2][2][4][2], const Unit& u, int wr, int wc, int fr, int fq) const {
#pragma unroll
        for (int ai = 0; ai < 2; ++ai)
#pragma unroll
            for (int m = 0; m < 4; ++m) {
                const int r = ai * 128 + wr * 64 + m * 16 + fr;
                if (r < u.nrows) {
                    const int tok = liste[(size_t)u.e * T + 256 * u.tile + r] >> 1; const float rs = RS[tok];
                    f32x4 h[2];
#pragma unroll
                    for (int n = 0; n < 2; ++n) { const f32x4 g = acc[ai][0][m][n] * rs, up = acc[ai][1][m][n] * rs;
#pragma unroll
                        for (int i = 0; i < 4; ++i) h[n][i] = g[i] * frcp(1.f + fexp2(-g[i] * LOG2E)) * up[i]; }
                    *(u32x4*)(HID + (size_t)(u.pm * 256 + r) * 256 + u.pn * 128 + wc * 32 + fq * 8) = pack8(h[0], h[1]);
                }
                asm volatile("" ::: "memory");
            }
    }
};
struct EpiDn {
    const int* liste; const float* listw; bf16_t* Y;
    __device__ __forceinline__ void operator()(const f32x4 (&acc)[2][2][4][2], const Unit& u, int wr, int wc, int fr, int fq) const {
#pragma unroll
        for (int ai = 0; ai < 2; ++ai)
#pragma unroll
            for (int m = 0; m < 4; ++m) {
                const int r = ai * 128 + wr * 64 + m * 16 + fr;
                if (r < u.nrows) {
                    const size_t li = (size_t)u.e * T + 256 * u.tile + r; const int ent = liste[li]; const float w = listw[li];
#pragma unroll
                    for (int bj = 0; bj < 2; ++bj) { const int c = u.pn * 256 + bj * 128 + wc * 32 + fq * 8;
                        *(u32x4*)(Y + (size_t)ent * DM + c) = pack8(acc[ai][bj][m][0] * w, acc[ai][bj][m][1] * w); }
                }
                asm volatile("" ::: "memory");
            }
    }
};
struct EpiPle {
    const float* RS; const bf16_t* PE; float* H;
    __device__ __forceinline__ void operator()(const f32x4 (&acc)[2][2][4][2], const Unit& u, int wr, int wc, int fr, int fq) const {
#pragma unroll
        for (int ai = 0; ai < 2; ++ai)
#pragma unroll
            for (int m = 0; m < 4; ++m) {
                const int row = u.pm * 256 + ai * 128 + wr * 64 + m * 16 + fr; const float rs = RS[row];
#pragma unroll
                for (int bj = 0; bj < 2; ++bj) { const size_t o = (size_t)row * DM + u.pn * 256 + bj * 128 + wc * 32 + fq * 8;
                    float pe[8]; unpack8(*(const u32x4*)(PE + o), pe);
                    f32x4 a = *(const f32x4*)(H + o), b = *(const f32x4*)(H + o + 4);
#pragma unroll
                    for (int i = 0; i < 4; ++i) { a[i] += frcp(1.f + fexp2(-acc[ai][bj][m][0][i] * rs * LOG2E)) * pe[i]; b[i] += frcp(1.f + fexp2(-acc[ai][bj][m][1][i] * rs * LOG2E)) * pe[4 + i]; }
                    *(f32x4*)(H + o) = a; *(f32x4*)(H + o + 4) = b; }
                asm volatile("" ::: "memory");
            }
    }
};

struct Frame {
    LAS unsigned char* lds; int tid, lane, wave, G, bx;
    const Params* P; unsigned char* ws;
    __device__ __forceinline__ int gw() const { return bx * NWAVES + wave; }
    __device__ __forceinline__ int ngw() const { return G * NWAVES; }
};
template <class Tp> __device__ __forceinline__ Tp* wsp(const Frame& F, size_t off) { return (Tp*)(F.ws + off); }

__device__ __forceinline__ void prep_item(const float* W, int ldw, int srccol0, const float* g, bf16_t* dstrow0, int K, int k0, LAS float* scr, int lane) {
    const int c = lane & 7;
    if (srccol0 < 0) {
#pragma unroll
        for (int j = 0; j < 4; ++j) { const int n = (lane >> 3) + 8 * j; *(u32x4*)(dstrow0 + (size_t)n * K + k0 + 8 * c) = (u32x4){0u, 0u, 0u, 0u}; }
        return;
    }
#pragma unroll 8
    for (int i = 0; i < 32; ++i) { const int kk = 2 * i + (lane >> 5); float v = W[(size_t)(k0 + kk) * ldw + srccol0 + (lane & 31)]; if (g) v *= g[k0 + kk]; scr[kk * 33 + (lane & 31)] = v; }
    asm volatile("s_waitcnt lgkmcnt(0)" ::: "memory");
#pragma unroll
    for (int j = 0; j < 4; ++j) { const int n = (lane >> 3) + 8 * j; const LAS float* s = scr + (8 * c) * 33 + n;
        u32x4 o; o.x = pk2(s[0 * 33], s[1 * 33]); o.y = pk2(s[2 * 33], s[3 * 33]); o.z = pk2(s[4 * 33], s[5 * 33]); o.w = pk2(s[6 * 33], s[7 * 33]);
        *(u32x4*)(dstrow0 + (size_t)n * K + k0 + 8 * c) = o; }
    asm volatile("s_waitcnt lgkmcnt(0)" ::: "memory");
}
__device__ __forceinline__ void phase_prep_small(Frame& F) {
    const Params& P = *F.P;
    LAS float* scr = (LAS float*)(F.lds + F.wave * 16384);
    constexpr int I_IN = 16 * 72, I_UQ = 6 * 24, I_UKV = 4 * 32, I_OUT = 16 * 32, I_PG = 16 * 32, I_PE = 4 * 32, I_L = I_IN + I_UQ + I_UKV + I_OUT + I_PG + I_PE;
    for (int it = F.gw(); it < NLAYER * I_L; it += F.ngw()) {
        const int l = it / I_L; int r = it % I_L;
        unsigned char* wb = F.ws + WS_WSM + (size_t)l * WSM_STRIDE;
        if (r < I_IN) { const int kb = r / 72, gi = r % 72, n0 = gi * 32; int src;
            if (n0 < 1536) src = n0; else if (n0 < 1792) src = 1920 + (n0 - 1536); else if (n0 < 2176) src = 1536 + (n0 - 1792); else if (n0 < 2208) src = n0; else src = -1;
            prep_item(P.in[4] + (size_t)l * DM * INC, INC, src, P.in[3] + l * DM, (bf16_t*)(wb + WSM_IN) + (size_t)n0 * DM, DM, kb * 64, scr, F.lane); continue; }
        r -= I_IN;
        if (r < I_UQ) { const int kb = r / 24, n0 = (r % 24) * 32;
            prep_item(P.in[6] + (size_t)l * QRANK * 768, 768, n0, P.in[5] + l * QRANK, (bf16_t*)(wb + WSM_UQ) + (size_t)n0 * QRANK, QRANK, kb * 64, scr, F.lane); continue; }
        r -= I_UQ;
        if (r < I_UKV) { const int kb = r / 32, n0 = (r % 32) * 32; const int hh = (n0 & 511) >> 6, d = n0 & 63; const int src = hh * 128 + (n0 >= 512 ? 64 : 0) + d;
            prep_item(P.in[8] + (size_t)l * KVRANK * 1024, 1024, src, P.in[7] + l * KVRANK, (bf16_t*)(wb + WSM_UKV) + (size_t)n0 * KVRANK, KVRANK, kb * 64, scr, F.lane); continue; }
        r -= I_UKV;
        if (r < I_OUT) { const int kb = r / 32, n0 = (r % 32) * 32; const int k0 = kb * 64;
            const float* g = k0 < 512 ? P.in[9] + l * 512 : P.in[10] + l * 512 - 512;
            prep_item(P.in[11] + (size_t)l * DM * DM, DM, n0, g, (bf16_t*)(wb + WSM_OUT) + (size_t)n0 * DM, DM, k0, scr, F.lane); continue; }
        r -= I_OUT;
        if (r < I_PG) { const int kb = r / 32, n0 = (r % 32) * 32;
            prep_item(P.in[21] + (size_t)l * DM * DM, DM, n0, P.in[20] + l * DM, (bf16_t*)(wb + WSM_PG) + (size_t)n0 * DM, DM, kb * 64, scr, F.lane); continue; }
        r -= I_PG;
        { const int kb = r / 32, n0 = (r % 32) * 32;
            prep_item(P.in[22] + (size_t)l * DPLE * DM, DM, n0, nullptr, (bf16_t*)(wb + WSM_PE) + (size_t)n0 * DPLE, DPLE, kb * 64, scr, F.lane); }
    }
    float* WR = wsp<float>(F, WS_WR);
    for (int i = F.bx * NTHREADS + F.tid; i < NLAYER * 36 * DM; i += F.G * NTHREADS) {
        const int l = i / (36 * DM), j = (i / DM) % 36, k = i % DM;
        const float w = j < 4 ? P.in[13][((size_t)l * DM + k) * 4 + j] : P.in[15][((size_t)l * DM + k) * 32 + (j - 4)];
        WR[i] = w * P.in[12][l * DM + k];
    }
    float* COS = wsp<float>(F, WS_COS); float* SIN = wsp<float>(F, WS_SIN); const int* pos = (const int*)P.in[2];
    for (int i = F.bx * NTHREADS + F.tid; i < T * 16; i += F.G * NTHREADS) {
        const float ang = (float)pos[i >> 4] * P.inv_freq[i & 15];
        const double a = (double)ang; const double q = __builtin_rint(a * 0.63661977236758134308);
        double r = __builtin_fma(-q, 1.57079632679489655800, a); r = __builtin_fma(-q, 6.12323399573676603587e-17, r);
        const double z = r * r;
        const double sp = r + r * z * (-0.166666666416265235595 + z * (0.0083333293858894631756 + z * (-0.000198393348360966317347 + z * 0.0000027183114939898219064)));
        const double cp = 1.0 + z * (-0.499999997251031003120 + z * (0.0416666233237390631894 + z * (-0.00138867637746099294692 + z * 0.0000243904487962774090654)));
        const int qi = (int)((long long)q & 3);
        const double sv = (qi == 0) ? sp : (qi == 1) ? cp : (qi == 2) ? -sp : -cp;
        const double cv = (qi == 0) ? cp : (qi == 1) ? -sp : (qi == 2) ? -cp : sp;
        COS[i] = (float)cv; SIN[i] = (float)sv;
    }
}
__device__ __forceinline__ void phase_prep_moe(Frame& F, int l) {
    const Params& P = *F.P;
    LAS float* scr = (LAS float*)(F.lds + F.wave * 16384);
    constexpr int I_G1 = 16 * 16, I_DN = 4 * 32, I_E = I_G1 + I_DN;
    bf16_t* WG1 = wsp<bf16_t>(F, WS_WG1); bf16_t* WD = wsp<bf16_t>(F, WS_WD);
    for (int it = F.gw(); it < NEXP * I_E; it += F.ngw()) {
        const int e = it / I_E; int r = it % I_E;
        if (r < I_G1) { const int kb = r / 16, n0 = (r % 16) * 32; const int pn = n0 >> 8, c = n0 & 255;
            const float* W = (c < 128 ? P.in[17] : P.in[18]) + ((size_t)l * NEXP + e) * DM * DEXP; const int src = pn * 128 + (c & 127);
            prep_item(W, DEXP, src, P.in[12] + l * DM, WG1 + ((size_t)e * 512 + n0) * DM, DM, kb * 64, scr, F.lane); }
        else { r -= I_G1; const int kb = r / 32, n0 = (r % 32) * 32;
            prep_item(P.in[19] + ((size_t)l * NEXP + e) * DEXP * DM, DM, n0, nullptr, WD + ((size_t)e * DM + n0) * DEXP, DEXP, kb * 64, scr, F.lane); }
    }
}

__device__ __forceinline__ void phase_norm(Frame& F, const float* hin) {
    bf16_t* HB = wsp<bf16_t>(F, WS_HB); float* RS = wsp<float>(F, WS_RS);
    for (int row = F.gw(); row < T; row += F.ngw()) {
        const f32x4* xr = (const f32x4*)(hin + (size_t)row * DM) + F.lane; f32x4 v[4]; float s = 0.f;
#pragma unroll
        for (int j = 0; j < 4; ++j) { v[j] = xr[64 * j]; s += (v[j][0] * v[j][0] + v[j][1] * v[j][1]) + (v[j][2] * v[j][2] + v[j][3] * v[j][3]); }
        s = wave_sum(s);
        u32x2* o = (u32x2*)(HB + (size_t)row * DM) + F.lane;
#pragma unroll
        for (int j = 0; j < 4; ++j) o[64 * j] = (u32x2){pk2(v[j][0], v[j][1]), pk2(v[j][2], v[j][3])};
        if (F.lane == 0) RS[row] = 1.0f / sqrtf(s * (1.f / DM) + EPS);
    }
}
__device__ __forceinline__ void phase_rs2(Frame& F) {
    const bf16_t* CQ = wsp<bf16_t>(F, WS_CQ); const bf16_t* CKV = wsp<bf16_t>(F, WS_CKV); float* RQ = wsp<float>(F, WS_RSCQ); float* RK = wsp<float>(F, WS_RSCKV);
    for (int row = F.gw(); row < T; row += F.ngw()) {
        float sq = 0.f, sk = 0.f, f[8];
        if (F.lane < 48) { unpack8(*(const u32x4*)(CQ + (size_t)row * QRANK + F.lane * 8), f);
#pragma unroll
            for (int i = 0; i < 8; ++i) sq += f[i] * f[i]; }
        if (F.lane < 32) { unpack8(*(const u32x4*)(CKV + (size_t)row * KVRANK + F.lane * 8), f);
#pragma unroll
            for (int i = 0; i < 8; ++i) sk += f[i] * f[i]; }
        sq = wave_sum(sq); sk = wave_sum(sk);
        if (F.lane == 0) { RQ[row] = 1.0f / sqrtf(sq * (1.f / QRANK) + EPS); RK[row] = 1.0f / sqrtf(sk * (1.f / KVRANK) + EPS); }
    }
}
__device__ __forceinline__ void phase_onorm(Frame& F) {
    bf16_t* OA = wsp<bf16_t>(F, WS_OA);
    for (int row = F.gw(); row < T; row += F.ngw()) {
        u32x4* p = (u32x4*)(OA + (size_t)row * DM + F.lane * 16); float f[16]; unpack8(p[0], f); unpack8(p[1], f + 8);
        float s = 0.f;
#pragma unroll
        for (int i = 0; i < 16; ++i) s += f[i] * f[i];
#pragma unroll
        for (int o = 1; o < 32; o <<= 1) s += __shfl_xor(s, o);
        const float rs = 1.0f / sqrtf(s * (1.f / 512.f) + EPS);
#pragma unroll
        for (int i = 0; i < 16; ++i) f[i] *= rs;
        p[0] = (u32x4){pk2(f[0], f[1]), pk2(f[2], f[3]), pk2(f[4], f[5]), pk2(f[6], f[7])};
        p[1] = (u32x4){pk2(f[8], f[9]), pk2(f[10], f[11]), pk2(f[12], f[13]), pk2(f[14], f[15])};
    }
}
__device__ __forceinline__ void phase_route(Frame& F, int l) {
    const Params& P = *F.P;
    LAS float* WL = (LAS float*)F.lds;
    const float* WR = wsp<float>(F, WS_WR) + (size_t)l * 36 * DM;
    for (int i = F.tid; i < 36 * DM / 4; i += NTHREADS) ((LAS f32x4*)WL)[i] = ((const f32x4*)WR)[i];
    __syncthreads();
    const float* H = wsp<float>(F, WS_H32); bf16_t* HB = wsp<bf16_t>(F, WS_HB); float* RS = wsp<float>(F, WS_RS);
    unsigned* cnt = wsp<unsigned>(F, WS_CTL) + CW_CNT + 64 * l; int* liste = wsp<int>(F, WS_LISTE); float* listw = wsp<float>(F, WS_LISTW);
    const float* brg = P.in[14] + l * 4; const float* bre = P.in[16] + l * 32;
    for (int row = F.gw(); row < T; row += F.ngw()) {
        const f32x4* xr = (const f32x4*)(H + (size_t)row * DM) + F.lane; f32x4 v[4]; float s = 0.f;
#pragma unroll
        for (int j = 0; j < 4; ++j) { v[j] = xr[64 * j]; s += (v[j][0] * v[j][0] + v[j][1] * v[j][1]) + (v[j][2] * v[j][2] + v[j][3] * v[j][3]); }
        s = wave_sum(s); const float rs = 1.0f / sqrtf(s * (1.f / DM) + EPS);
        u32x2* o = (u32x2*)(HB + (size_t)row * DM) + F.lane;
#pragma unroll
        for (int j = 0; j < 4; ++j) o[64 * j] = (u32x2){pk2(v[j][0], v[j][1]), pk2(v[j][2], v[j][3])};
        float gl[4];
#pragma unroll
        for (int q = 0; q < 4; ++q) { float a = 0.f;
#pragma unroll
            for (int j = 0; j < 4; ++j) { const f32x4 w = ((const LAS f32x4*)(WL + q * DM))[F.lane + 64 * j]; a += (v[j][0] * w[0] + v[j][1] * w[1]) + (v[j][2] * w[2] + v[j][3] * w[3]); }
            gl[q] = wave_sum(a) * rs; }
        const float g0 = gl[0] + brg[0], g1 = gl[1] + brg[1], g2 = gl[2] + brg[2], g3 = gl[3] + brg[3];
        int g = 0; float gm = g0; if (g1 > gm) { gm = g1; g = 1; } if (g2 > gm) { gm = g2; g = 2; } if (g3 > gm) { gm = g3; g = 3; }
        g = __builtin_amdgcn_readfirstlane(g);
        const float gp = 1.0f / (fexp2((g0 - gm) * LOG2E) + fexp2((g1 - gm) * LOG2E) + fexp2((g2 - gm) * LOG2E) + fexp2((g3 - gm) * LOG2E));
        float le[8];
#pragma unroll
        for (int q = 0; q < 8; ++q) { float a = 0.f; const LAS f32x4* wq = (const LAS f32x4*)(WL + (4 + g * 8 + q) * DM);
#pragma unroll
            for (int j = 0; j < 4; ++j) { const f32x4 w = wq[F.lane + 64 * j]; a += (v[j][0] * w[0] + v[j][1] * w[1]) + (v[j][2] * w[2] + v[j][3] * w[3]); }
            le[q] = wave_sum(a) * rs + bre[g * 8 + q]; }
        int i1 = 0; float l1 = le[0];
#pragma unroll
        for (int j = 1; j < 8; ++j) if (le[j] > l1) { l1 = le[j]; i1 = j; }
        int i2 = -1; float l2 = -3.0e38f;
#pragma unroll
        for (int j = 0; j < 8; ++j) if (j != i1 && le[j] > l2) { l2 = le[j]; i2 = j; }
        const float e2 = fexp2((l2 - l1) * LOG2E); const float w1 = gp / (1.f + e2), w2 = gp * e2 / (1.f + e2);
        if (F.lane == 0) {
            RS[row] = rs;
            const int ea = g * 8 + i1, eb = g * 8 + i2;
            const unsigned pa = atomicAdd(cnt + ea, 1u); liste[(size_t)ea * T + pa] = row * 2; listw[(size_t)ea * T + pa] = w1;
            const unsigned pb = atomicAdd(cnt + eb, 1u); liste[(size_t)eb * T + pb] = row * 2 + 1; listw[(size_t)eb * T + pb] = w2;
        }
    }
}
__device__ __forceinline__ void phase_norm2(Frame& F, int l) {
    const Params& P = *F.P;
    float* H = wsp<float>(F, WS_H32); bf16_t* HB = wsp<bf16_t>(F, WS_HB); float* RS = wsp<float>(F, WS_RS); const bf16_t* Y = wsp<bf16_t>(F, WS_Y); bf16_t* PB = wsp<bf16_t>(F, WS_PB);
    const float* pl = P.in[1] + (size_t)l * T * DPLE;
    for (int row = F.gw(); row < T; row += F.ngw()) {
        f32x4* xr = (f32x4*)(H + (size_t)row * DM) + F.lane; f32x4 v[4]; float s = 0.f;
        const u32x2* y0 = (const u32x2*)(Y + (size_t)row * 2 * DM) + F.lane; const u32x2* y1 = y0 + DM / 4;
#pragma unroll
        for (int j = 0; j < 4; ++j) { v[j] = xr[64 * j]; const u32x2 a = y0[64 * j], b = y1[64 * j];
            v[j][0] += bf2f(a.x & 0xffffu) + bf2f(b.x & 0xffffu); v[j][1] += bf2f(a.x >> 16) + bf2f(b.x >> 16);
            v[j][2] += bf2f(a.y & 0xffffu) + bf2f(b.y & 0xffffu); v[j][3] += bf2f(a.y >> 16) + bf2f(b.y >> 16);
            s += (v[j][0] * v[j][0] + v[j][1] * v[j][1]) + (v[j][2] * v[j][2] + v[j][3] * v[j][3]); xr[64 * j] = v[j]; }
        s = wave_sum(s);
        u32x2* o = (u32x2*)(HB + (size_t)row * DM) + F.lane;
#pragma unroll
        for (int j = 0; j < 4; ++j) o[64 * j] = (u32x2){pk2(v[j][0], v[j][1]), pk2(v[j][2], v[j][3])};
        if (F.lane == 0) RS[row] = 1.0f / sqrtf(s * (1.f / DM) + EPS);
        const f32x4 pv = ((const f32x4*)(pl + (size_t)row * DPLE))[F.lane];
        ((u32x2*)(PB + (size_t)row * DPLE))[F.lane] = (u32x2){pk2(pv[0], pv[1]), pk2(pv[2], pv[3])};
    }
}
__device__ __forceinline__ void phase_final(Frame& F) {
    const Params& P = *F.P; const float* H = wsp<float>(F, WS_H32); const float* g = P.in[23];
    for (int row = F.gw(); row < T; row += F.ngw()) {
        const f32x4* xr = (const f32x4*)(H + (size_t)row * DM) + F.lane; f32x4 v[4]; float s = 0.f;
#pragma unroll
        for (int j = 0; j < 4; ++j) { v[j] = xr[64 * j]; s += (v[j][0] * v[j][0] + v[j][1] * v[j][1]) + (v[j][2] * v[j][2] + v[j][3] * v[j][3]); }
        s = wave_sum(s); const float rs = 1.0f / sqrtf(s * (1.f / DM) + EPS);
        f32x4* o = (f32x4*)(P.out + (size_t)row * DM) + F.lane;
#pragma unroll
        for (int j = 0; j < 4; ++j) o[64 * j] = v[j] * rs * ((const f32x4*)g)[F.lane + 64 * j];
    }
}

__device__ __forceinline__ void phase_sb_naive(Frame& F) {
    LAS float* Ks = (LAS float*)F.lds; LAS float* Vs = Ks + 64 * 64;
    const bf16_t* QKV = wsp<bf16_t>(F, WS_QKV); bf16_t* OA = wsp<bf16_t>(F, WS_OA);
    const int tid = F.tid;
    for (int u = F.bx; u < 512; u += F.G) {
        const int b = u >> 6, h = (u >> 3) & 7, qb = u & 7; const int t = qb * 512 + tid; const size_t row = (size_t)b * SEQ + t;
        float q[64], acc[64];
#pragma unroll
        for (int j = 0; j < 8; ++j) unpack8(*(const u32x4*)(QKV + row * 1536 + h * 64 + j * 8), q + j * 8);
#pragma unroll
        for (int d = 0; d < 64; ++d) acc[d] = 0.f;
        float c = 0.f;
        for (int kt = qb * 8 + 7; kt >= 0; --kt) {
            __syncthreads();
            { const size_t kr = (size_t)b * SEQ + kt * 64 + (tid >> 3); float f[8];
              unpack8(*(const u32x4*)(QKV + kr * 1536 + 512 + h * 64 + (tid & 7) * 8), f);
#pragma unroll
              for (int i = 0; i < 8; ++i) Ks[(tid >> 3) * 64 + (tid & 7) * 8 + i] = f[i];
              unpack8(*(const u32x4*)(QKV + kr * 1536 + 1024 + h * 64 + (tid & 7) * 8), f);
#pragma unroll
              for (int i = 0; i < 8; ++i) Vs[(tid >> 3) * 64 + (tid & 7) * 8 + i] = f[i]; }
            __syncthreads();
#pragma unroll 1
            for (int kk = 63; kk >= 0; --kk) {
                const int key = kt * 64 + kk; float z = 0.f;
#pragma unroll
                for (int d4 = 0; d4 < 16; ++d4) { const f32x4 k4 = ((const LAS f32x4*)(Ks + kk * 64))[d4]; z += (q[4 * d4] * k4[0] + q[4 * d4 + 1] * k4[1]) + (q[4 * d4 + 2] * k4[2] + q[4 * d4 + 3] * k4[3]); }
                if (key < t) {
                    const float e = fexp2(fminf(z, 126.f)); c -= flog2(1.f + e); const float w = fexp2(z + c);
#pragma unroll
                    for (int d4 = 0; d4 < 16; ++d4) { const f32x4 v4 = ((const LAS f32x4*)(Vs + kk * 64))[d4]; acc[4 * d4] += w * v4[0]; acc[4 * d4 + 1] += w * v4[1]; acc[4 * d4 + 2] += w * v4[2]; acc[4 * d4 + 3] += w * v4[3]; }
                }
            }
            if (__syncthreads_and(c < -150.f)) break;
        }
#pragma unroll
        for (int j = 0; j < 8; ++j) *(u32x4*)(OA + row * DM + h * 64 + j * 8) = (u32x4){pk2(acc[8 * j], acc[8 * j + 1]), pk2(acc[8 * j + 2], acc[8 * j + 3]), pk2(acc[8 * j + 4], acc[8 * j + 5]), pk2(acc[8 * j + 6], acc[8 * j + 7])};
    }
}
__device__ __forceinline__ void phase_mla_naive(Frame& F) {
    LAS float* Ks = (LAS float*)F.lds; LAS float* Vs = Ks + 64 * 96;
    const bf16_t* QM = wsp<bf16_t>(F, WS_QM); const bf16_t* KN = wsp<bf16_t>(F, WS_KN); const bf16_t* KR = wsp<bf16_t>(F, WS_KR); const bf16_t* VM = wsp<bf16_t>(F, WS_VM); bf16_t* OA = wsp<bf16_t>(F, WS_OA);
    const int tid = F.tid;
    for (int u = F.bx; u < 512; u += F.G) {
        const int b = u >> 6, h = (u >> 3) & 7, qb = 7 - (u & 7); const int t = qb * 512 + tid; const size_t row = (size_t)b * SEQ + t;
        float q[96], acc[64];
#pragma unroll
        for (int j = 0; j < 12; ++j) unpack8(*(const u32x4*)(QM + row * 768 + h * 96 + j * 8), q + j * 8);
#pragma unroll
        for (int d = 0; d < 64; ++d) acc[d] = 0.f;
        float mx = -3.0e38f, lsum = 0.f;
        const int ntile = qb * 8 + 8, myc = t >> 6;
        for (int kt = 0; kt < ntile; ++kt) {
            __syncthreads();
            { const size_t kr = (size_t)b * SEQ + kt * 64 + (tid >> 3); float f[8]; const int ch = tid & 7;
              unpack8(*(const u32x4*)(KN + kr * 512 + h * 64 + ch * 8), f);
#pragma unroll
              for (int i = 0; i < 8; ++i) Ks[(tid >> 3) * 96 + ch * 8 + i] = f[i];
              if (ch < 4) { unpack8(*(const u32x4*)(KR + kr * 32 + ch * 8), f);
#pragma unroll
                  for (int i = 0; i < 8; ++i) Ks[(tid >> 3) * 96 + 64 + ch * 8 + i] = f[i]; }
              unpack8(*(const u32x4*)(VM + kr * 512 + h * 64 + ch * 8), f);
#pragma unroll
              for (int i = 0; i < 8; ++i) Vs[(tid >> 3) * 64 + ch * 8 + i] = f[i]; }
            __syncthreads();
            if (kt <= myc) {
#pragma unroll 1
                for (int kk = 0; kk < 64; ++kk) {
                    float s = 0.f;
#pragma unroll
                    for (int d4 = 0; d4 < 24; ++d4) { const f32x4 k4 = ((const LAS f32x4*)(Ks + kk * 96))[d4]; s += (q[4 * d4] * k4[0] + q[4 * d4 + 1] * k4[1]) + (q[4 * d4 + 2] * k4[2] + q[4 * d4 + 3] * k4[3]); }
                    if (s > mx) { const float f = fexp2(mx - s); lsum *= f;
#pragma unroll
                        for (int d = 0; d < 64; ++d) acc[d] *= f;
                        mx = s; }
                    const float p = fexp2(s - mx); lsum += p;
#pragma unroll
                    for (int d4 = 0; d4 < 16; ++d4) { const f32x4 v4 = ((const LAS f32x4*)(Vs + kk * 64))[d4]; acc[4 * d4] += p * v4[0]; acc[4 * d4 + 1] += p * v4[1]; acc[4 * d4 + 2] += p * v4[2]; acc[4 * d4 + 3] += p * v4[3]; }
                }
            }
        }
        const float il = 1.0f / lsum;
#pragma unroll
        for (int j = 0; j < 8; ++j) *(u32x4*)(OA + row * DM + 512 + h * 64 + j * 8) = (u32x4){pk2(acc[8 * j] * il, acc[8 * j + 1] * il), pk2(acc[8 * j + 2] * il, acc[8 * j + 3] * il), pk2(acc[8 * j + 4] * il, acc[8 * j + 5] * il), pk2(acc[8 * j + 6] * il, acc[8 * j + 7] * il)};
    }
}

__device__ __forceinline__ DenseSched dense_sched(const Frame& F, int N, const void* Bt, int K) { DenseSched S; S.o.init(T, N, F.G, F.bx); S.Bt = (const char*)Bt; S.K = K; return S; }
__device__ __forceinline__ void phase_inproj(Frame& F, int l) {
    const DenseSched S = dense_sched(F, INP, F.ws + WS_WSM + (size_t)l * WSM_STRIDE + WSM_IN, DM);
    const EpiIn E{wsp<float>(F, WS_RS), wsp<bf16_t>(F, WS_QKV), wsp<bf16_t>(F, WS_CKV), wsp<bf16_t>(F, WS_CQ), wsp<bf16_t>(F, WS_KR), wsp<float>(F, WS_COS), wsp<float>(F, WS_SIN)};
    pg8::gemm_phase(F.lds, (const char*)(F.ws + WS_HB), DM, S, E);
}
__device__ __forceinline__ void phase_uq(Frame& F, int l) {
    const DenseSched S = dense_sched(F, 768, F.ws + WS_WSM + (size_t)l * WSM_STRIDE + WSM_UQ, QRANK);
    const EpiUq E{wsp<float>(F, WS_RSCQ), wsp<bf16_t>(F, WS_QM), wsp<float>(F, WS_COS), wsp<float>(F, WS_SIN)};
    pg8::gemm_phase(F.lds, (const char*)(F.ws + WS_CQ), QRANK, S, E);
}
__device__ __forceinline__ void phase_ukv(Frame& F, int l) {
    const DenseSched S = dense_sched(F, 1024, F.ws + WS_WSM + (size_t)l * WSM_STRIDE + WSM_UKV, KVRANK);
    const EpiUkv E{wsp<float>(F, WS_RSCKV), wsp<bf16_t>(F, WS_KN), wsp<bf16_t>(F, WS_VM)};
    pg8::gemm_phase(F.lds, (const char*)(F.ws + WS_CKV), KVRANK, S, E);
}
__device__ __forceinline__ void phase_outproj(Frame& F, int l) {
    const DenseSched S = dense_sched(F, DM, F.ws + WS_WSM + (size_t)l * WSM_STRIDE + WSM_OUT, DM);
    const EpiOut E{l == 0 ? F.P->in[0] : wsp<float>(F, WS_H32), wsp<float>(F, WS_H32)};
    pg8::gemm_phase(F.lds, (const char*)(F.ws + WS_OA), DM, S, E);
}
__device__ __forceinline__ void moe_table(Frame& F, int l) {
    LAS int* tb = (LAS int*)(F.lds + pg8::STAGE_BYTES);
    __syncthreads();
    if (F.tid == 0) { const unsigned* cnt = wsp<unsigned>(F, WS_CTL) + CW_CNT + 64 * l; int acc = 0;
        for (int e = 0; e < NEXP; ++e) { const int c = (int)__hip_atomic_load(cnt + e, __ATOMIC_RELAXED, __HIP_MEMORY_SCOPE_AGENT); tb[e] = acc; tb[40 + e] = c; acc += (c + 255) >> 8; }
        tb[32] = acc; }
    __syncthreads();
}
__device__ __forceinline__ void phase_moe1(Frame& F, int l) {
    moe_table(F, l);
    MoeSched S; S.G = F.G; S.c = F.bx; S.npn = 2; S.gather = 1; S.tb = (const LAS int*)(F.lds + pg8::STAGE_BYTES); S.liste = wsp<int>(F, WS_LISTE); S.Bt = (const char*)(F.ws + WS_WG1); S.K = DM; S.nB = 512;
    const EpiG1 E{wsp<float>(F, WS_RS), wsp<int>(F, WS_LISTE), wsp<bf16_t>(F, WS_HID)};
    pg8::gemm_phase(F.lds, (const char*)(F.ws + WS_HB), DM, S, E);
}
__device__ __forceinline__ void phase_moe2(Frame& F, int l) {
    moe_table(F, l);
    MoeSched S; S.G = F.G; S.c = F.bx; S.npn = 4; S.gather = 0; S.tb = (const LAS int*)(F.lds + pg8::STAGE_BYTES); S.liste = wsp<int>(F, WS_LISTE); S.Bt = (const char*)(F.ws + WS_WD); S.K = DEXP; S.nB = 1024;
    const EpiDn E{wsp<int>(F, WS_LISTE), wsp<float>(F, WS_LISTW), wsp<bf16_t>(F, WS_Y)};
    pg8::gemm_phase(F.lds, (const char*)(F.ws + WS_HID), DEXP, S, E);
}
__device__ __forceinline__ void phase_pe(Frame& F, int l) {
    const DenseSched S = dense_sched(F, DM, F.ws + WS_WSM + (size_t)l * WSM_STRIDE + WSM_PE, DPLE);
    const EpiBf E{wsp<bf16_t>(F, WS_PE), DM};
    pg8::gemm_phase(F.lds, (const char*)(F.ws + WS_PB), DPLE, S, E);
}
__device__ __forceinline__ void phase_ple(Frame& F, int l) {
    const DenseSched S = dense_sched(F, DM, F.ws + WS_WSM + (size_t)l * WSM_STRIDE + WSM_PG, DM);
    const EpiPle E{wsp<float>(F, WS_RS), wsp<bf16_t>(F, WS_PE), wsp<float>(F, WS_H32)};
    pg8::gemm_phase(F.lds, (const char*)(F.ws + WS_HB), DM, S, E);
}

enum { PH_PREP = 0, PH_PREPMOE, PH_NORM0, PH_NORM, PH_INPROJ, PH_RS2, PH_UQ, PH_UKV, PH_SB, PH_MLA, PH_ONORM, PH_OUTPROJ, PH_ROUTE, PH_MOE1, PH_MOE2, PH_NORM2, PH_PE, PH_PLE, PH_FINAL };
template <int PH> __global__ void __launch_bounds__(NTHREADS, 2) k_phase(Params P, int l) {
    extern __shared__ __attribute__((aligned(16))) unsigned char lds_raw[];
    Frame F; F.lds = (LAS unsigned char*)lds_raw; F.tid = threadIdx.x; F.lane = F.tid & 63; F.wave = __builtin_amdgcn_readfirstlane(F.tid >> 6); F.G = gridDim.x; F.bx = blockIdx.x; F.P = &P; F.ws = P.ws;
    if constexpr (PH == PH_PREP) phase_prep_small(F);
    if constexpr (PH == PH_PREPMOE) phase_prep_moe(F, l);
    if constexpr (PH == PH_NORM0) phase_norm(F, P.in[0]);
    if constexpr (PH == PH_NORM) phase_norm(F, wsp<float>(F, WS_H32));
    if constexpr (PH == PH_INPROJ) phase_inproj(F, l);
    if constexpr (PH == PH_RS2) phase_rs2(F);
    if constexpr (PH == PH_UQ) phase_uq(F, l);
    if constexpr (PH == PH_UKV) phase_ukv(F, l);
    if constexpr (PH == PH_SB) phase_sb_naive(F);
    if constexpr (PH == PH_MLA) phase_mla_naive(F);
    if constexpr (PH == PH_ONORM) phase_onorm(F);
    if constexpr (PH == PH_OUTPROJ) phase_outproj(F, l);
    if constexpr (PH == PH_ROUTE) phase_route(F, l);
    if constexpr (PH == PH_MOE1) phase_moe1(F, l);
    if constexpr (PH == PH_MOE2) phase_moe2(F, l);
    if constexpr (PH == PH_NORM2) phase_norm2(F, l);
    if constexpr (PH == PH_PE) phase_pe(F, l);
    if constexpr (PH == PH_PLE) phase_ple(F, l);
    if constexpr (PH == PH_FINAL) phase_final(F);
}

template <int PH> static void launch_phase(const Params& P, int l, int grid, hipStream_t stream) {
    static bool attr = false;
    if (!attr) { (void)hipFuncSetAttribute((const void*)k_phase<PH>, hipFuncAttributeMaxDynamicSharedMemorySize, LDS_BYTES); attr = true; }
    hipLaunchKernelGGL(k_phase<PH>, dim3(grid), dim3(NTHREADS), LDS_BYTES, stream, P, l);
}

extern "C" void kernel_launch(void* const* d_in, const int* in_sizes, int n_in, void* d_out, int out_size, void* d_ws, size_t ws_size, hipStream_t stream) {
    if (n_in != 24 || out_size != T * DM || ws_size < WS_END) { fprintf(stderr, "kernel_launch: unexpected shapes (n_in %d, out %d, ws %zu < %zu)\n", n_in, out_size, ws_size, (size_t)WS_END); return; }
    Params P{};
    for (int i = 0; i < 24; ++i) P.in[i] = (const float*)d_in[i];
    P.out = (float*)d_out; P.ws = (unsigned char*)d_ws;
    for (int i = 0; i < 16; ++i) P.inv_freq[i] = (float)pow(10000.0, -(double)i / 16.0);
    const int grid = 256;
    (void)hipMemsetAsync((char*)d_ws + WS_CTL, 0, CTL_BYTES, stream);
    launch_phase<PH_PREP>(P, 0, grid, stream);
    launch_phase<PH_NORM0>(P, 0, grid, stream);
    for (int l = 0; l < NLAYER; ++l) {
        launch_phase<PH_PREPMOE>(P, l, grid, stream);
        launch_phase<PH_INPROJ>(P, l, grid, stream);
        launch_phase<PH_RS2>(P, l, grid, stream);
        launch_phase<PH_UQ>(P, l, grid, stream);
        launch_phase<PH_UKV>(P, l, grid, stream);
        launch_phase<PH_SB>(P, l, grid, stream);
        launch_phase<PH_MLA>(P, l, grid, stream);
        launch_phase<PH_ONORM>(P, l, grid, stream);
        launch_phase<PH_OUTPROJ>(P, l, grid, stream);
        launch_phase<PH_ROUTE>(P, l, grid, stream);
        launch_phase<PH_MOE1>(P, l, grid, stream);
        launch_phase<PH_MOE2>(P, l, grid, stream);
        launch_phase<PH_NORM2>(P, l, grid, stream);
        launch_phase<PH_PE>(P, l, grid, stream);
        launch_phase<PH_PLE>(P, l, grid, stream);
        if (l + 1 < NLAYER) launch_phase<PH_NORM>(P, l, grid, stream);
    }
    launch_phase<PH_FINAL>(P, 0, grid, stream);
}
```

```cpp
#include <hip/hip_runtime.h>
#include <cstdio>
#include <cstdint>
#include <cmath>

#define GAS __attribute__((address_space(1)))
#define LAS __attribute__((address_space(3)))
typedef unsigned short bf16_t;
typedef short bf16x8 __attribute__((ext_vector_type(8)));
typedef float f32x4 __attribute__((ext_vector_type(4)));
typedef float f32x2 __attribute__((ext_vector_type(2)));
typedef unsigned u32x4 __attribute__((ext_vector_type(4)));
typedef unsigned u32x2 __attribute__((ext_vector_type(2)));

constexpr int NB = 8, SEQ = 4096, DM = 1024, NLAYER = 4, T = NB * SEQ;
constexpr int DPLE = 256, SBW = 512, MLAW = 512, QRANK = 384, KVRANK = 256, ROPE = 32, QKD = 96;
constexpr int INC = 2208, INP = 2304;
constexpr int NEXP = 32, DEXP = 256;
constexpr float EPS = 1e-6f;
constexpr float LOG2E = 1.4426950408889634f;
constexpr float QS_SB = 0.125f * LOG2E;
constexpr float QS_MLA = 0.10206207261596575f * LOG2E;
constexpr int NWAVES = 8, NTHREADS = 512;

constexpr size_t MiB = 1u << 20;
constexpr size_t WS_CTL = 0, CTL_BYTES = 1 * MiB;
constexpr size_t WS_COS = 1 * MiB, WS_SIN = 3 * MiB;
constexpr size_t WS_RS = 5 * MiB, WS_RSCQ = 6 * MiB, WS_RSCKV = 7 * MiB;
constexpr size_t WS_LISTE = 8 * MiB, WS_LISTW = 12 * MiB;
constexpr size_t WS_WR = 16 * MiB;
constexpr size_t WS_WSM = 18 * MiB, WSM_STRIDE = 11 * MiB;
constexpr size_t WSM_IN = 0, WSM_OUT = 4608 * 1024, WSM_PG = WSM_OUT + 2 * MiB, WSM_UQ = WSM_PG + 2 * MiB, WSM_UKV = WSM_UQ + 576 * 1024, WSM_PE = WSM_UKV + 512 * 1024;
constexpr size_t WS_WG1 = 62 * MiB, WS_WD = 94 * MiB;
constexpr size_t WS_H32 = 110 * MiB, WS_HB = 238 * MiB;
constexpr size_t WS_ATT = 302 * MiB;
constexpr size_t WS_QKV = WS_ATT, WS_CKV = WS_ATT + 96 * MiB, WS_CQ = WS_CKV + 16 * MiB, WS_KR = WS_CQ + 24 * MiB, WS_QM = WS_KR + 2 * MiB,
                 WS_KN = WS_QM + 48 * MiB, WS_VM = WS_KN + 32 * MiB, WS_OA = WS_VM + 32 * MiB, WS_ATT_END = WS_OA + 64 * MiB;
constexpr size_t WS_HID = WS_ATT, WS_Y = WS_ATT + 36 * MiB, WS_PE = WS_Y + 128 * MiB, WS_PB = WS_PE + 64 * MiB, WS_MOE_END = WS_PB + 16 * MiB;
constexpr size_t WS_END = WS_ATT_END > WS_MOE_END ? WS_ATT_END : WS_MOE_END;
static_assert(WSM_PE + 512 * 1024 <= WSM_STRIDE, "small weights");
static_assert(WS_WSM + 4 * WSM_STRIDE <= WS_WG1, "ws map");
constexpr int CW_CNT = 1024;

constexpr int LDS_BYTES = 152 * 1024;

struct Params {
    const float* in[24];
    float* out;
    unsigned char* ws;
    float inv_freq[16];
};

__device__ __forceinline__ float bf2f(unsigned v) { return __uint_as_float(v << 16); }
__device__ __forceinline__ unsigned f2bf(float f) { unsigned u = __float_as_uint(f); return (u + 0x7fffu + ((u >> 16) & 1u)) >> 16; }
__device__ __forceinline__ unsigned pk2(float lo, float hi) { return f2bf(lo) | (f2bf(hi) << 16); }
__device__ __forceinline__ float wave_sum(float v) {
#pragma unroll
    for (int o = 1; o < 64; o <<= 1) v += __shfl_xor(v, o);
    return v;
}
__device__ __forceinline__ float fexp2(float x) { return __builtin_amdgcn_exp2f(x); }
__device__ __forceinline__ float flog2(float x) { return __builtin_amdgcn_logf(x); }
__device__ __forceinline__ float frcp(float x) { return __builtin_amdgcn_rcpf(x); }
__device__ __forceinline__ void unpack8(u32x4 w, float* f) {
    f[0] = __uint_as_float(w.x << 16); f[1] = __uint_as_float(w.x & 0xffff0000u);
    f[2] = __uint_as_float(w.y << 16); f[3] = __uint_as_float(w.y & 0xffff0000u);
    f[4] = __uint_as_float(w.z << 16); f[5] = __uint_as_float(w.z & 0xffff0000u);
    f[6] = __uint_as_float(w.w << 16); f[7] = __uint_as_float(w.w & 0xffff0000u);
}
__device__ __forceinline__ u32x4 pack8(f32x4 a, f32x4 b) { u32x4 w; w.x = pk2(a[0], a[1]); w.y = pk2(a[2], a[3]); w.z = pk2(b[0], b[1]); w.w = pk2(b[2], b[3]); return w; }

namespace pg8 {
constexpr int BM = 256, BK = 64, HALF = 128, HTB = HALF * BK * 2, STAGE_BYTES = 8 * HTB, NXCD = 8, WGM = 8;
__host__ __device__ __forceinline__ int lds_byte(int r, int c) { const int st = (r >> 4) * 2 + (c >> 5), rr = r & 15, cc = c & 31, ob = rr * 64 + cc * 2; return st * 1024 + (ob ^ (((ob >> 9) & 1) << 5)); }
__host__ __device__ __forceinline__ void stage_rc(int b, int& R, int& C) { const int st = b / 1024, sb = b % 1024, swz = sb ^ (((sb >> 9) & 1) << 5); R = (st >> 1) * 16 + swz / 64; C = (st & 1) * 32 + (swz % 64) / 2; }
__host__ __device__ __forceinline__ int perm32(int rho) { const int n = rho >> 4, i = rho & 15; return 8 * (i >> 2) + 4 * n + (i & 3); }

struct Unit { int pm, pn, e, tile, nrows; };

struct StaticOrder {
    int nM, nN, nwg, G, c;
    __device__ void init(int M, int N, int G_, int c_) { nM = M / BM; nN = N / BM; nwg = nM * nN; G = G_; c = c_; }
    __device__ bool next(int i, Unit& u) const {
        const long L = (long)i * G + c; if (L >= nwg) return false;
        int wgid = (int)L; { const int q = nwg / NXCD, r = nwg % NXCD, xcd = wgid % NXCD, off = wgid / NXCD; wgid = (xcd < r ? xcd * (q + 1) : r * (q + 1) + (xcd - r) * q) + off; }
        const int nig = WGM * nN, gid = wgid / nig, fm = gid * WGM, gsz = (nM - fm) < WGM ? (nM - fm) : WGM;
        u.pm = fm + ((wgid % nig) % gsz); u.pn = (wgid % nig) / gsz; u.e = 0; u.tile = 0; u.nrows = 256; return true;
    }
};

template <class Epi, class Sched>
__device__ __forceinline__ void gemm_phase(LAS unsigned char* lds, const int tid, const char* Abase, const int K, const Sched& S, const Epi& E) {
    const int wid = __builtin_amdgcn_readfirstlane(tid >> 6), lane = tid & 63, wr = wid >> 2, wc = wid & 3, fr = lane & 15, fq = lane >> 4;
    const int nt = K / BK;
    unsigned voffB[2];
#pragma unroll
    for (int i = 0; i < 2; ++i) { int R, C; stage_rc(tid * 16 + i * 8192, R, C); const int Rb = (R & ~31) + perm32(R & 31); voffB[i] = (unsigned)(Rb * K + C) * 2u; }
    const size_t kstep = (size_t)(BK * 2);
    const size_t hstep = (size_t)HALF * K * 2;
    const unsigned ldsw = (unsigned)wid * 1024u;
    const int aoff = lds_byte(wr * 64 + fr, fq * 8), boff = lds_byte(wc * 32 + fr, fq * 8);
#define PG8_SA(b, h) (((b) * 2 + (h)) * HTB)
#define PG8_SB(b, h) ((4 + (b) * 2 + (h)) * HTB)
#define PG8_STAGE(bufoff, gbase, voff) do { _Pragma("unroll") for (int _i = 0; _i < 2; ++_i) \
        __builtin_amdgcn_global_load_lds((const unsigned*)((const char*)(gbase) + (voff)[_i]), (LAS unsigned*)(lds + (bufoff) + ldsw + _i * 8192), 16, 0, 0); } while (0)
#define PG8_LDA(dst, b, h) do { _Pragma("unroll") for (int m = 0; m < 4; ++m) _Pragma("unroll") for (int k = 0; k < 2; ++k) dst[m][k] = *(const LAS bf16x8*)(lds + PG8_SA(b, h) + aoff + m * 2048 + k * 1024); } while (0)
#define PG8_LDB(dst, b, h) do { _Pragma("unroll") for (int n = 0; n < 2; ++n) _Pragma("unroll") for (int k = 0; k < 2; ++k) dst[n][k] = *(const LAS bf16x8*)(lds + PG8_SB(b, h) + boff + n * 2048 + k * 1024); } while (0)
#define PG8_MMA(ai, bj, At, Bt) do { __builtin_amdgcn_s_setprio(1); _Pragma("unroll") for (int m = 0; m < 4; ++m) _Pragma("unroll") for (int n = 0; n < 2; ++n) _Pragma("unroll") for (int k = 0; k < 2; ++k) \
        acc[ai][bj][m][n] = __builtin_amdgcn_mfma_f32_16x16x32_bf16(Bt[n][k], At[m][k], acc[ai][bj][m][n], 0, 0, 0); __builtin_amdgcn_s_setprio(0); } while (0)
#define PG8_WAIT_V(n) asm volatile("s_waitcnt vmcnt(" #n ")" ::: "memory")
#define PG8_WAIT_L(n) asm volatile("s_waitcnt lgkmcnt(" #n ")" ::: "memory")
#define PG8_BAR __builtin_amdgcn_s_barrier()
#define PG8_SCHED __builtin_amdgcn_sched_barrier(0)
    Unit cur, nxt; int ui = 0;
    if (!S.next(0, cur)) return;
    f32x4 acc[2][2][4][2];
#pragma unroll
    for (int a = 0; a < 2; ++a)
#pragma unroll
        for (int b = 0; b < 2; ++b)
#pragma unroll
            for (int m = 0; m < 4; ++m)
#pragma unroll
                for (int n = 0; n < 2; ++n) acc[a][b][m][n] = (f32x4){0.f, 0.f, 0.f, 0.f};
    bf16x8 At[4][2], B0[2][2], B1[2][2];
    unsigned vc[2][2];
    LAS u32x4* vslot = (LAS u32x4*)(lds + STAGE_BYTES + 1024) + tid;
#define PG8_AOFFS(dst, U) do { int t2_ = tid; asm volatile("" : "+v"(t2_)); _Pragma("unroll") for (int i = 0; i < 2; ++i) { int R, C; stage_rc(t2_ * 16 + i * 8192, R, C); \
        dst[0][i] = S.a_off(U, R) + (unsigned)C * 2u; dst[1][i] = S.a_off(U, HALF + R) + (unsigned)C * 2u; } } while (0)
    PG8_AOFFS(vc, cur);
    const char* cB = S.b_tile(cur);
    PG8_STAGE(PG8_SB(0, 0), cB, voffB); PG8_STAGE(PG8_SB(0, 1), cB + hstep, voffB); PG8_STAGE(PG8_SA(0, 0), Abase, vc[0]); PG8_STAGE(PG8_SA(0, 1), Abase, vc[1]);
    if (wr == 1) PG8_BAR;
    PG8_WAIT_V(2); PG8_BAR;
    PG8_STAGE(PG8_SB(1, 0), cB + kstep, voffB); PG8_STAGE(PG8_SA(1, 0), Abase + kstep, vc[0]); PG8_STAGE(PG8_SB(1, 1), cB + hstep + kstep, voffB);
    PG8_WAIT_V(6); PG8_BAR;
    for (;;) {
        const bool has_next = S.next(ui + 1, nxt);
        const char* nB = cB;
        { unsigned vn[2][2];
          if (has_next) { PG8_AOFFS(vn, nxt); nB = S.b_tile(nxt); *vslot = (u32x4){vn[0][0], vn[0][1], vn[1][0], vn[1][1]}; }
          else *vslot = (u32x4){vc[0][0], vc[0][1], vc[1][0], vc[1][1]}; }
        for (int t = 0; t < nt; t += 2) {
            const bool last = (t == nt - 2);
            const char* a1 = Abase + (size_t)(t + 1) * kstep;
            const char* a2 = last ? Abase : Abase + (size_t)(t + 2) * kstep; const char* b2 = last ? nB : cB + (size_t)(t + 2) * kstep;
            const char* a3 = a2 + kstep; const char* b3 = b2 + kstep;
            unsigned w2[2][2];
            if (last) { const u32x4 q = *vslot; w2[0][0] = q.x; w2[0][1] = q.y; w2[1][0] = q.z; w2[1][1] = q.w; }
            else { w2[0][0] = vc[0][0]; w2[0][1] = vc[0][1]; w2[1][0] = vc[1][0]; w2[1][1] = vc[1][1]; }
            PG8_LDB(B0, 0, 0); PG8_LDB(B1, 0, 1); PG8_SCHED; PG8_LDA(At, 0, 0); PG8_STAGE(PG8_SA(1, 1), a1, vc[1]);
            PG8_WAIT_V(8); PG8_WAIT_L(0); PG8_BAR; PG8_MMA(0, 0, At, B0); PG8_MMA(0, 1, At, B1); PG8_BAR; PG8_SCHED;
            PG8_LDA(At, 0, 1); PG8_STAGE(PG8_SB(0, 0), b2, voffB); PG8_STAGE(PG8_SB(0, 1), b2 + hstep, voffB); PG8_STAGE(PG8_SA(0, 0), a2, w2[0]);
            PG8_WAIT_V(8); PG8_WAIT_L(0); PG8_BAR; PG8_MMA(1, 0, At, B0); PG8_MMA(1, 1, At, B1); PG8_BAR; PG8_SCHED;
            PG8_LDB(B0, 1, 0); PG8_LDB(B1, 1, 1); PG8_SCHED; PG8_LDA(At, 1, 0); PG8_STAGE(PG8_SA(0, 1), a2, w2[1]);
            PG8_WAIT_V(8); PG8_WAIT_L(0); PG8_BAR; PG8_MMA(0, 0, At, B0); PG8_MMA(0, 1, At, B1); PG8_BAR; PG8_SCHED;
            PG8_LDA(At, 1, 1); PG8_STAGE(PG8_SB(1, 0), b3, voffB); PG8_STAGE(PG8_SB(1, 1), b3 + hstep, voffB); PG8_STAGE(PG8_SA(1, 0), a3, w2[0]);
            PG8_WAIT_V(8); PG8_WAIT_L(0); PG8_BAR; PG8_MMA(1, 0, At, B0); PG8_MMA(1, 1, At, B1); PG8_BAR; PG8_SCHED;
        }
        if (wr == 0) PG8_BAR;
        { int fr2 = fr, fq2 = fq; asm volatile("" : "+v"(fr2), "+v"(fq2));
          E(acc, cur, wr, wc, fr2, fq2); }
        if (!has_next) break;
#pragma unroll
        for (int a = 0; a < 2; ++a)
#pragma unroll
            for (int b = 0; b < 2; ++b)
#pragma unroll
                for (int m = 0; m < 4; ++m)
#pragma unroll
                    for (int n = 0; n < 2; ++n) acc[a][b][m][n] = (f32x4){0.f, 0.f, 0.f, 0.f};
        cur = nxt; cB = nB; ++ui;
        { const u32x4 q = *vslot; vc[0][0] = q.x; vc[0][1] = q.y; vc[1][0] = q.z; vc[1][1] = q.w; }
        if (wr == 1) PG8_BAR;
    }
    PG8_WAIT_V(0);
    PG8_BAR;
#undef PG8_AOFFS
#undef PG8_SA
#undef PG8_SB
#undef PG8_STAGE
#undef PG8_LDA
#undef PG8_LDB
#undef PG8_MMA
#undef PG8_WAIT_V
#undef PG8_WAIT_L
#undef PG8_BAR
#undef PG8_SCHED
}
}
using pg8::Unit;

struct DenseSched {
    pg8::StaticOrder o; const char* Bt; int K;
    __device__ __forceinline__ bool next(int i, Unit& u) const { return o.next(i, u); }
    __device__ __forceinline__ unsigned a_off(const Unit& u, int r) const { return (unsigned)(u.pm * 256 + r) * (unsigned)(K * 2); }
    __device__ __forceinline__ const char* b_tile(const Unit& u) const { return Bt + (size_t)u.pn * 256 * K * 2; }
};
struct MoeSched {
    int G, c, npn, gather; const LAS int* tb; const int* liste; const char* Bt; int K, nB;
    __device__ __forceinline__ bool next(int i, Unit& u) const {
        const int L = i * G + c, ntile = tb[32];
        if (L >= ntile * npn) return false;
        const int ti = L / npn; u.pn = L % npn; u.pm = ti;
        int e = 0;
#pragma unroll 1
        for (; e < 31; ++e) if (ti < tb[e + 1]) break;
        u.e = e; u.tile = ti - tb[e]; const int rem = tb[40 + e] - 256 * u.tile; u.nrows = rem < 256 ? rem : 256; return true;
    }
    __device__ __forceinline__ unsigned a_off(const Unit& u, int r) const {
        if (gather) { int tok = 0; if (r < u.nrows) tok = liste[(size_t)u.e * T + 256 * u.tile + r] >> 1; return (unsigned)tok * (unsigned)(K * 2); }
        return (unsigned)(u.pm * 256 + r) * (unsigned)(K * 2);
    }
    __device__ __forceinline__ const char* b_tile(const Unit& u) const { return Bt + ((size_t)u.e * nB + (size_t)u.pn * 256) * K * 2; }
};

struct EpiIn {
    const float* RS; bf16_t* QKV; bf16_t* CKV; bf16_t* CQ; bf16_t* KR; const float* COS; const float* SIN;
    __device__ __forceinline__ void operator()(const f32x4 (&acc)[2][2][4][2], const Unit& u, int wr, int wc, int fr, int fq) const {
        const int pn = u.pn;
#pragma unroll
        for (int ai = 0; ai < 2; ++ai)
#pragma unroll
            for (int m = 0; m < 4; ++m) {
                const int row = u.pm * 256 + ai * 128 + wr * 64 + m * 16 + fr; const float rs = RS[row];
#pragma unroll
                for (int bj = 0; bj < 2; ++bj) {
                    const int c = bj * 128 + wc * 32 + fq * 8;
                    f32x4 v0 = acc[ai][bj][m][0] * rs, v1 = acc[ai][bj][m][1] * rs;
                    if (pn < 6) { if (pn < 2) { v0 = v0 * QS_SB; v1 = v1 * QS_SB; } *(u32x4*)(QKV + (size_t)row * 1536 + pn * 256 + c) = pack8(v0, v1); }
                    else if (pn == 6) { *(u32x4*)(CKV + (size_t)row * 256 + c) = pack8(v0, v1); }
                    else if (pn == 7) { *(u32x4*)(CQ + (size_t)row * 384 + c) = pack8(v0, v1); }
                    else if (bj == 0) { *(u32x4*)(CQ + (size_t)row * 384 + 256 + c) = pack8(v0, v1); }
                    else if (wc == 0) {
                        const int ib = 8 * (fq & 1);
                        const f32x4 c0 = *(const f32x4*)(COS + (size_t)row * 16 + ib), c1 = *(const f32x4*)(COS + (size_t)row * 16 + ib + 4);
                        const f32x4 s0 = *(const f32x4*)(SIN + (size_t)row * 16 + ib), s1 = *(const f32x4*)(SIN + (size_t)row * 16 + ib + 4);
                        f32x4 p0, p1;
#pragma unroll
                        for (int i = 0; i < 4; ++i) { p0[i] = __shfl_xor(v0[i], 32); p1[i] = __shfl_xor(v1[i], 32); }
                        const float sg = (fq < 2) ? -1.f : 1.f;
                        const f32x4 o0 = v0 * c0 + p0 * s0 * sg, o1 = v1 * c1 + p1 * s1 * sg;
                        *(u32x4*)(KR + (size_t)row * 32 + fq * 8) = pack8(o0, o1);
                    }
                }
                asm volatile("" ::: "memory");
            }
    }
};
struct EpiUq {
    const float* RS; bf16_t* QM; const float* COS; const float* SIN;
    __device__ __forceinline__ void operator()(const f32x4 (&acc)[2][2][4][2], const Unit& u, int wr, int wc, int fr, int fq) const {
#pragma unroll
        for (int ai = 0; ai < 2; ++ai)
#pragma unroll
            for (int m = 0; m < 4; ++m) {
                const int row = u.pm * 256 + ai * 128 + wr * 64 + m * 16 + fr; const float rs = RS[row] * QS_MLA;
#pragma unroll
                for (int bj = 0; bj < 2; ++bj) {
                    const int c = u.pn * 256 + bj * 128 + wc * 32 + fq * 8; const int g32 = u.pn * 8 + bj * 4 + wc;
                    f32x4 v0 = acc[ai][bj][m][0] * rs, v1 = acc[ai][bj][m][1] * rs;
                    if ((g32 % 3) == 2) {
                        const int ib = 8 * (fq & 1);
                        const f32x4 c0 = *(const f32x4*)(COS + (size_t)row * 16 + ib), c1 = *(const f32x4*)(COS + (size_t)row * 16 + ib + 4);
                        const f32x4 s0 = *(const f32x4*)(SIN + (size_t)row * 16 + ib), s1 = *(const f32x4*)(SIN + (size_t)row * 16 + ib + 4);
                        f32x4 p0, p1;
#pragma unroll
                        for (int i = 0; i < 4; ++i) { p0[i] = __shfl_xor(v0[i], 32); p1[i] = __shfl_xor(v1[i], 32); }
                        const float sg = (fq < 2) ? -1.f : 1.f;
                        v0 = v0 * c0 + p0 * s0 * sg; v1 = v1 * c1 + p1 * s1 * sg;
                    }
                    *(u32x4*)(QM + (size_t)row * 768 + c) = pack8(v0, v1);
                }
                asm volatile("" ::: "memory");
            }
    }
};
struct EpiUkv {
    const float* RS; bf16_t* KN; bf16_t* VM;
    __device__ __forceinline__ void operator()(const f32x4 (&acc)[2][2][4][2], const Unit& u, int wr, int wc, int fr, int fq) const {
        bf16_t* dst = u.pn < 2 ? KN : VM; const int cb = (u.pn & 1) * 256;
#pragma unroll
        for (int ai = 0; ai < 2; ++ai)
#pragma unroll
            for (int m = 0; m < 4; ++m) {
                const int row = u.pm * 256 + ai * 128 + wr * 64 + m * 16 + fr; const float rs = RS[row];
#pragma unroll
                for (int bj = 0; bj < 2; ++bj) { const int c = cb + bj * 128 + wc * 32 + fq * 8;
                    *(u32x4*)(dst + (size_t)row * 512 + c) = pack8(acc[ai][bj][m][0] * rs, acc[ai][bj][m][1] * rs); }
            }
    }
};
struct EpiBf {
    bf16_t* O; int ldc;
    __device__ __forceinline__ void operator()(const f32x4 (&acc)[2][2][4][2], const Unit& u, int wr, int wc, int fr, int fq) const {
#pragma unroll
        for (int ai = 0; ai < 2; ++ai)
#pragma unroll
            for (int m = 0; m < 4; ++m) {
                const int row = u.pm * 256 + ai * 128 + wr * 64 + m * 16 + fr;
#pragma unroll
                for (int bj = 0; bj < 2; ++bj) { const int c = u.pn * 256 + bj * 128 + wc * 32 + fq * 8;
                    *(u32x4*)(O + (size_t)row * ldc + c) = pack8(acc[ai][bj][m][0], acc[ai][bj][m][1]); }
            }
    }
};
struct EpiOut {
    const float* hin; float* hout;
    __device__ __forceinline__ void operator()(const f32x4 (&acc)[2][2][4][2], const Unit& u, int wr, int wc, int fr, int fq) const {
#pragma unroll
        for (int ai = 0; ai < 2; ++ai)
#pragma unroll
            for (int m = 0; m < 4; ++m) {
                const int row = u.pm * 256 + ai * 128 + wr * 64 + m * 16 + fr;
#pragma unroll
                for (int bj = 0; bj < 2; ++bj) { const size_t o = (size_t)row * DM + u.pn * 256 + bj * 128 + wc * 32 + fq * 8;
                    const f32x4 a = *(const f32x4*)(hin + o), b = *(const f32x4*)(hin + o + 4);
                    *(f32x4*)(hout + o) = a + acc[ai][bj][m][0]; *(f32x4*)(hout + o + 4) = b + acc[ai][bj][m][1]; }
                asm volatile("" ::: "memory");
            }
    }
};
struct EpiG1 {
    const float* RS; const int* liste; bf16_t* HID;
    __device__ __forceinline__ void operator()(const f32x4 (&acc)[2][2][4][2], const Unit& u, int wr, int wc, int fr, int fq) const {
#pragma unroll
        for (int ai = 0; ai < 2; ++ai)
#pragma unroll
            for (int m = 0; m < 4; ++m) {
                const int r = ai * 128 + wr * 64 + m * 16 + fr;
                if (r < u.nrows) {
                    const int tok = liste[(size_t)u.e * T + 256 * u.tile + r] >> 1; const float rs = RS[tok];
                    f32x4 h[2];
#pragma unroll
                    for (int n = 0; n < 2; ++n) { const f32x4 g = acc[ai][0][m][n] * rs, up = acc[ai][1][m][n] * rs;
#pragma unroll
                        for (int i = 0; i < 4; ++i) h[n][i] = g[i] * frcp(1.f + fexp2(-g[i] * LOG2E)) * up[i]; }
                    *(u32x4*)(HID + (size_t)(u.pm * 256 + r) * 256 + u.pn * 128 + wc * 32 + fq * 8) = pack8(h[0], h[1]);
                }
                asm volatile("" ::: "memory");
            }
    }
};
struct EpiDn {
    const int* liste; const float* listw; bf16_t* Y;
    __device__ __forceinline__ void operator()(const f32x4 (&acc)[2][2][4][2], const Unit& u, int wr, int wc, int fr, int fq) const {
#pragma unroll
        for (int ai = 0; ai < 2; ++ai)
#pragma unroll
            for (int m = 0; m < 4; ++m) {
                const int r = ai * 128 + wr * 64 + m * 16 + fr;
                if (r < u.nrows) {
                    const size_t li = (size_t)u.e * T + 256 * u.tile + r; const int ent = liste[li]; const float w = listw[li];
#pragma unroll
                    for (int bj = 0; bj < 2; ++bj) { const int c = u.pn * 256 + bj * 128 + wc * 32 + fq * 8;
                        *(u32x4*)(Y + (size_t)ent * DM + c) = pack8(acc[ai][bj][m][0] * w, acc[ai][bj][m][1] * w); }
                }
                asm volatile("" ::: "memory");
            }
    }
};
struct EpiPle {
    const float* RS; const bf16_t* PE; float* H;
    __device__ __forceinline__ void operator()(const f32x4 (&acc)[2][2][4][2], const Unit& u, int wr, int wc, int fr, int fq) const {
#pragma unroll
        for (int ai = 0; ai < 2; ++ai)
#pragma unroll
            for (int m = 0; m < 4; ++m) {
                const int row = u.pm * 256 + ai * 128 + wr * 64 + m * 16 + fr; const float rs = RS[row];
#pragma unroll
                for (int bj = 0; bj < 2; ++bj) { const size_t o = (size_t)row * DM + u.pn * 256 + bj * 128 + wc * 32 + fq * 8;
                    float pe[8]; unpack8(*(const u32x4*)(PE + o), pe);
                    f32x4 a = *(const f32x4*)(H + o), b = *(const f32x4*)(H + o + 4);
#pragma unroll
                    for (int i = 0; i < 4; ++i) { a[i] += frcp(1.f + fexp2(-acc[ai][bj][m][0][i] * rs * LOG2E)) * pe[i]; b[i] += frcp(1.f + fexp2(-acc[ai][bj][m][1][i] * rs * LOG2E)) * pe[4 + i]; }
                    *(f32x4*)(H + o) = a; *(f32x4*)(H + o + 4) = b; }
                asm volatile("" ::: "memory");
            }
    }
};


#define XB_TMO      128
#define XB_XCNT(j)  (256  + 64 * (j))
#define XB_XSUB(j)  (1280 + 64 * (j))
#define XB_XGEN(j)  (2304 + 64 * (j))
#define XB_TOP      3328
#define XB_TOPGEN   3392
#define XCD_BAR_WORDS 3456
#define XB_SPIN_CAP (1u << 18)

__device__ __forceinline__ unsigned xb_ld(unsigned* p)              { return __hip_atomic_load(p, __ATOMIC_RELAXED, __HIP_MEMORY_SCOPE_AGENT); }
__device__ __forceinline__ unsigned xb_add(unsigned* p, unsigned v) { return __hip_atomic_fetch_add(p, v, __ATOMIC_RELAXED, __HIP_MEMORY_SCOPE_AGENT); }
__device__ __forceinline__ unsigned xb_xcc_id() { return (unsigned)__builtin_amdgcn_s_getreg((3 << 11) | 20) & 0xFu; }
#define XB_SPIN(cond, bar) do { unsigned _sp = 0; while (cond) { __builtin_amdgcn_s_sleep(1); \
    if ((++_sp & 255u) == 0u) { if (xb_ld(&(bar)[XB_TMO])) break; if (_sp > XB_SPIN_CAP) { atomicAdd(&(bar)[XB_TMO], 1u); break; } } } } while (0)

struct XcdBarrier {
    unsigned* bar; unsigned x;
    volatile LAS unsigned* st;
};

__device__ __forceinline__ XcdBarrier xcd_barrier_post(unsigned* bar, volatile LAS unsigned* st) {
    XcdBarrier b; b.bar = bar; b.x = xb_xcc_id(); b.st = st;
    if (threadIdx.x == 0) (void)xb_add(&bar[XB_XCNT(b.x)], 1u);
    return b;
}
__device__ __forceinline__ void xcd_barrier_complete(unsigned* bar, unsigned x, unsigned& nloc, unsigned& nx) {
    const unsigned G = gridDim.x * gridDim.y * gridDim.z;
    unsigned sum, cnt, mine, sp = 0u;
    for (;;) {
        sum = 0u; cnt = 0u; mine = 0u;
#pragma unroll
        for (unsigned j = 0; j < 16; ++j) { const unsigned c = xb_ld(&bar[XB_XCNT(j)]); sum += c; cnt += (c > 0u) ? 1u : 0u; mine = (j == x) ? c : mine; }
        if (sum == G) break;
        __builtin_amdgcn_s_sleep(1);
        if ((++sp & 255u) == 0u) { if (xb_ld(&bar[XB_TMO])) break; if (sp > XB_SPIN_CAP) { atomicAdd(&bar[XB_TMO], 1u); break; } }
    }
    nloc = mine > 0u ? mine : 1u; nx = cnt > 0u ? cnt : 1u;
}

__device__ __forceinline__ void xcd_barrier(const XcdBarrier& b) {
    asm volatile("s_waitcnt vmcnt(0)" ::: "memory");
    __syncthreads();
    if (threadIdx.x == 0) {
        unsigned* bar = b.bar;
        __builtin_amdgcn_s_waitcnt(0);
        unsigned nloc = b.st[0], nx = b.st[1];
        if (nloc == 0u) { xcd_barrier_complete(bar, b.x, nloc, nx); b.st[0] = nloc; b.st[1] = nx; }
        const unsigned old = xb_add(&bar[XB_XSUB(b.x)], 1u);
        const unsigned gen = old / nloc;
        if (old + 1u == (gen + 1u) * nloc) {
            __builtin_amdgcn_fence(__ATOMIC_RELEASE, "agent");
            asm volatile("s_waitcnt vmcnt(0)" ::: "memory");
            const unsigned og = xb_add(&bar[XB_TOP], 1u);
            const unsigned tg = og / nx;
            if (og + 1u == (tg + 1u) * nx) xb_add(&bar[XB_TOPGEN], 1u);
            else XB_SPIN(xb_ld(&bar[XB_TOPGEN]) == tg, bar);
            __builtin_amdgcn_fence(__ATOMIC_ACQUIRE, "agent");
            xb_add(&bar[XB_XGEN(b.x)], 1u);
            asm volatile("s_waitcnt vmcnt(0)" ::: "memory");
        } else {
            XB_SPIN(xb_ld(&bar[XB_XGEN(b.x)]) == gen, bar);
            __builtin_amdgcn_fence(__ATOMIC_ACQUIRE, "agent");
            asm volatile("s_waitcnt vmcnt(0)" ::: "memory");
        }
    }
    __syncthreads();
}


struct Frame {
    LAS unsigned char* lds; int tid, lane, wave, G, bx;
    const Params* P; unsigned char* ws;
    __device__ __forceinline__ int gw() const { return bx * NWAVES + wave; }
    __device__ __forceinline__ int ngw() const { return G * NWAVES; }
};
template <class Tp> __device__ __forceinline__ Tp* wsp(const Frame& F, size_t off) { return (Tp*)(F.ws + off); }

__device__ __forceinline__ void prep_item(const float* W, int ldw, int srccol0, const float* g, bf16_t* dstrow0, int K, int k0, LAS float* scr, int lane) {
    const int c = lane & 7;
    if (srccol0 < 0) {
#pragma unroll
        for (int j = 0; j < 4; ++j) { const int n = (lane >> 3) + 8 * j; *(u32x4*)(dstrow0 + (size_t)n * K + k0 + 8 * c) = (u32x4){0u, 0u, 0u, 0u}; }
        return;
    }
#pragma unroll 8
    for (int i = 0; i < 32; ++i) { const int kk = 2 * i + (lane >> 5); float v = W[(size_t)(k0 + kk) * ldw + srccol0 + (lane & 31)]; if (g) v *= g[k0 + kk]; scr[kk * 33 + (lane & 31)] = v; }
    asm volatile("s_waitcnt lgkmcnt(0)" ::: "memory");
#pragma unroll
    for (int j = 0; j < 4; ++j) { const int n = (lane >> 3) + 8 * j; const LAS float* s = scr + (8 * c) * 33 + n;
        u32x4 o; o.x = pk2(s[0 * 33], s[1 * 33]); o.y = pk2(s[2 * 33], s[3 * 33]); o.z = pk2(s[4 * 33], s[5 * 33]); o.w = pk2(s[6 * 33], s[7 * 33]);
        *(u32x4*)(dstrow0 + (size_t)n * K + k0 + 8 * c) = o; }
    asm volatile("s_waitcnt lgkmcnt(0)" ::: "memory");
}
__device__ __forceinline__ void phase_prep_small(Frame& F) {
    const Params& P = *F.P;
    LAS float* scr = (LAS float*)(F.lds + F.wave * 16384);
    constexpr int I_IN = 16 * 72, I_UQ = 6 * 24, I_UKV = 4 * 32, I_OUT = 16 * 32, I_PG = 16 * 32, I_PE = 4 * 32, I_L = I_IN + I_UQ + I_UKV + I_OUT + I_PG + I_PE;
    for (int it = F.gw(); it < NLAYER * I_L; it += F.ngw()) {
        const int l = it / I_L; int r = it % I_L;
        unsigned char* wb = F.ws + WS_WSM + (size_t)l * WSM_STRIDE;
        if (r < I_IN) { const int kb = r / 72, gi = r % 72, n0 = gi * 32; int src;
            if (n0 < 1536) src = n0; else if (n0 < 1792) src = 1920 + (n0 - 1536); else if (n0 < 2176) src = 1536 + (n0 - 1792); else if (n0 < 2208) src = n0; else src = -1;
            prep_item(P.in[4] + (size_t)l * DM * INC, INC, src, P.in[3] + l * DM, (bf16_t*)(wb + WSM_IN) + (size_t)n0 * DM, DM, kb * 64, scr, F.lane); continue; }
        r -= I_IN;
        if (r < I_UQ) { const int kb = r / 24, n0 = (r % 24) * 32;
            prep_item(P.in[6] + (size_t)l * QRANK * 768, 768, n0, P.in[5] + l * QRANK, (bf16_t*)(wb + WSM_UQ) + (size_t)n0 * QRANK, QRANK, kb * 64, scr, F.lane); continue; }
        r -= I_UQ;
        if (r < I_UKV) { const int kb = r / 32, n0 = (r % 32) * 32; const int hh = (n0 & 511) >> 6, d = n0 & 63; const int src = hh * 128 + (n0 >= 512 ? 64 : 0) + d;
            prep_item(P.in[8] + (size_t)l * KVRANK * 1024, 1024, src, P.in[7] + l * KVRANK, (bf16_t*)(wb + WSM_UKV) + (size_t)n0 * KVRANK, KVRANK, kb * 64, scr, F.lane); continue; }
        r -= I_UKV;
        if (r < I_OUT) { const int kb = r / 32, n0 = (r % 32) * 32; const int k0 = kb * 64;
            const float* g = k0 < 512 ? P.in[9] + l * 512 : P.in[10] + l * 512 - 512;
            prep_item(P.in[11] + (size_t)l * DM * DM, DM, n0, g, (bf16_t*)(wb + WSM_OUT) + (size_t)n0 * DM, DM, k0, scr, F.lane); continue; }
        r -= I_OUT;
        if (r < I_PG) { const int kb = r / 32, n0 = (r % 32) * 32;
            prep_item(P.in[21] + (size_t)l * DM * DM, DM, n0, P.in[20] + l * DM, (bf16_t*)(wb + WSM_PG) + (size_t)n0 * DM, DM, kb * 64, scr, F.lane); continue; }
        r -= I_PG;
        { const int kb = r / 32, n0 = (r % 32) * 32;
            prep_item(P.in[22] + (size_t)l * DPLE * DM, DM, n0, nullptr, (bf16_t*)(wb + WSM_PE) + (size_t)n0 * DPLE, DPLE, kb * 64, scr, F.lane); }
    }
    float* WR = wsp<float>(F, WS_WR);
    for (int i = F.bx * NTHREADS + F.tid; i < NLAYER * 36 * DM; i += F.G * NTHREADS) {
        const int l = i / (36 * DM), j = (i / DM) % 36, k = i % DM;
        const float w = j < 4 ? P.in[13][((size_t)l * DM + k) * 4 + j] : P.in[15][((size_t)l * DM + k) * 32 + (j - 4)];
        WR[i] = w * P.in[12][l * DM + k];
    }
    float* COS = wsp<float>(F, WS_COS); float* SIN = wsp<float>(F, WS_SIN); const int* pos = (const int*)P.in[2];
    for (int i = F.bx * NTHREADS + F.tid; i < T * 16; i += F.G * NTHREADS) {
        const float ang = (float)pos[i >> 4] * P.inv_freq[i & 15];
        const double a = (double)ang; const double q = __builtin_rint(a * 0.63661977236758134308);
        double r = __builtin_fma(-q, 1.57079632679489655800, a); r = __builtin_fma(-q, 6.12323399573676603587e-17, r);
        const double z = r * r;
        const double sp = r + r * z * (-0.166666666416265235595 + z * (0.0083333293858894631756 + z * (-0.000198393348360966317347 + z * 0.0000027183114939898219064)));
        const double cp = 1.0 + z * (-0.499999997251031003120 + z * (0.0416666233237390631894 + z * (-0.00138867637746099294692 + z * 0.0000243904487962774090654)));
        const int qi = (int)((long long)q & 3);
        const double sv = (qi == 0) ? sp : (qi == 1) ? cp : (qi == 2) ? -sp : -cp;
        const double cv = (qi == 0) ? cp : (qi == 1) ? -sp : (qi == 2) ? -cp : sp;
        COS[i] = (float)cv; SIN[i] = (float)sv;
    }
}
__device__ __forceinline__ void phase_prep_moe(Frame& F, int l) {
    const Params& P = *F.P;
    LAS float* scr = (LAS float*)(F.lds + F.wave * 16384);
    constexpr int I_G1 = 16 * 16, I_DN = 4 * 32, I_E = I_G1 + I_DN;
    bf16_t* WG1 = wsp<bf16_t>(F, WS_WG1); bf16_t* WD = wsp<bf16_t>(F, WS_WD);
    for (int it = F.gw(); it < NEXP * I_E; it += F.ngw()) {
        const int e = it / I_E; int r = it % I_E;
        if (r < I_G1) { const int kb = r / 16, n0 = (r % 16) * 32; const int pn = n0 >> 8, c = n0 & 255;
            const float* W = (c < 128 ? P.in[17] : P.in[18]) + ((size_t)l * NEXP + e) * DM * DEXP; const int src = pn * 128 + (c & 127);
            prep_item(W, DEXP, src, P.in[12] + l * DM, WG1 + ((size_t)e * 512 + n0) * DM, DM, kb * 64, scr, F.lane); }
        else { r -= I_G1; const int kb = r / 32, n0 = (r % 32) * 32;
            prep_item(P.in[19] + ((size_t)l * NEXP + e) * DEXP * DM, DM, n0, nullptr, WD + ((size_t)e * DM + n0) * DEXP, DEXP, kb * 64, scr, F.lane); }
    }
}

__device__ __forceinline__ void phase_norm(Frame& F, const float* hin) {
    bf16_t* HB = wsp<bf16_t>(F, WS_HB); float* RS = wsp<float>(F, WS_RS);
    for (int row = F.gw(); row < T; row += F.ngw()) {
        const f32x4* xr = (const f32x4*)(hin + (size_t)row * DM) + F.lane; f32x4 v[4]; float s = 0.f;
#pragma unroll
        for (int j = 0; j < 4; ++j) { v[j] = xr[64 * j]; s += (v[j][0] * v[j][0] + v[j][1] * v[j][1]) + (v[j][2] * v[j][2] + v[j][3] * v[j][3]); }
        s = wave_sum(s);
        u32x2* o = (u32x2*)(HB + (size_t)row * DM) + F.lane;
#pragma unroll
        for (int j = 0; j < 4; ++j) o[64 * j] = (u32x2){pk2(v[j][0], v[j][1]), pk2(v[j][2], v[j][3])};
        if (F.lane == 0) RS[row] = 1.0f / sqrtf(s * (1.f / DM) + EPS);
    }
}
__device__ __forceinline__ void phase_rs2(Frame& F) {
    const bf16_t* CQ = wsp<bf16_t>(F, WS_CQ); const bf16_t* CKV = wsp<bf16_t>(F, WS_CKV); float* RQ = wsp<float>(F, WS_RSCQ); float* RK = wsp<float>(F, WS_RSCKV);
    for (int row = F.gw(); row < T; row += F.ngw()) {
        float sq = 0.f, sk = 0.f, f[8];
        if (F.lane < 48) { unpack8(*(const u32x4*)(CQ + (size_t)row * QRANK + F.lane * 8), f);
#pragma unroll
            for (int i = 0; i < 8; ++i) sq += f[i] * f[i]; }
        if (F.lane < 32) { unpack8(*(const u32x4*)(CKV + (size_t)row * KVRANK + F.lane * 8), f);
#pragma unroll
            for (int i = 0; i < 8; ++i) sk += f[i] * f[i]; }
        sq = wave_sum(sq); sk = wave_sum(sk);
        if (F.lane == 0) { RQ[row] = 1.0f / sqrtf(sq * (1.f / QRANK) + EPS); RK[row] = 1.0f / sqrtf(sk * (1.f / KVRANK) + EPS); }
    }
}
__device__ __forceinline__ void phase_onorm(Frame& F) {
    bf16_t* OA = wsp<bf16_t>(F, WS_OA);
    for (int row = F.gw(); row < T; row += F.ngw()) {
        u32x4* p = (u32x4*)(OA + (size_t)row * DM + F.lane * 16); float f[16]; unpack8(p[0], f); unpack8(p[1], f + 8);
        float s = 0.f;
#pragma unroll
        for (int i = 0; i < 16; ++i) s += f[i] * f[i];
#pragma unroll
        for (int o = 1; o < 32; o <<= 1) s += __shfl_xor(s, o);
        const float rs = 1.0f / sqrtf(s * (1.f / 512.f) + EPS);
#pragma unroll
        for (int i = 0; i < 16; ++i) f[i] *= rs;
        p[0] = (u32x4){pk2(f[0], f[1]), pk2(f[2], f[3]), pk2(f[4], f[5]), pk2(f[6], f[7])};
        p[1] = (u32x4){pk2(f[8], f[9]), pk2(f[10], f[11]), pk2(f[12], f[13]), pk2(f[14], f[15])};
    }
}
__device__ __forceinline__ void phase_route(Frame& F, int l) {
    const Params& P = *F.P;
    LAS float* WL = (LAS float*)F.lds;
    const float* WR = wsp<float>(F, WS_WR) + (size_t)l * 36 * DM;
    for (int i = F.tid; i < 36 * DM / 4; i += NTHREADS) ((LAS f32x4*)WL)[i] = ((const f32x4*)WR)[i];
    __syncthreads();
    const float* H = wsp<float>(F, WS_H32); bf16_t* HB = wsp<bf16_t>(F, WS_HB); float* RS = wsp<float>(F, WS_RS);
    unsigned* cnt = wsp<unsigned>(F, WS_CTL) + CW_CNT + 64 * l; int* liste = wsp<int>(F, WS_LISTE); float* listw = wsp<float>(F, WS_LISTW);
    const float* brg = P.in[14] + l * 4; const float* bre = P.in[16] + l * 32;
    for (int row = F.gw(); row < T; row += F.ngw()) {
        const f32x4* xr = (const f32x4*)(H + (size_t)row * DM) + F.lane; f32x4 v[4]; float s = 0.f;
#pragma unroll
        for (int j = 0; j < 4; ++j) { v[j] = xr[64 * j]; s += (v[j][0] * v[j][0] + v[j][1] * v[j][1]) + (v[j][2] * v[j][2] + v[j][3] * v[j][3]); }
        s = wave_sum(s); const float rs = 1.0f / sqrtf(s * (1.f / DM) + EPS);
        u32x2* o = (u32x2*)(HB + (size_t)row * DM) + F.lane;
#pragma unroll
        for (int j = 0; j < 4; ++j) o[64 * j] = (u32x2){pk2(v[j][0], v[j][1]), pk2(v[j][2], v[j][3])};
        float gl[4];
#pragma unroll
        for (int q = 0; q < 4; ++q) { float a = 0.f;
#pragma unroll
            for (int j = 0; j < 4; ++j) { const f32x4 w = ((const LAS f32x4*)(WL + q * DM))[F.lane + 64 * j]; a += (v[j][0] * w[0] + v[j][1] * w[1]) + (v[j][2] * w[2] + v[j][3] * w[3]); }
            gl[q] = wave_sum(a) * rs; }
        const float g0 = gl[0] + brg[0], g1 = gl[1] + brg[1], g2 = gl[2] + brg[2], g3 = gl[3] + brg[3];
        int g = 0; float gm = g0; if (g1 > gm) { gm = g1; g = 1; } if (g2 > gm) { gm = g2; g = 2; } if (g3 > gm) { gm = g3; g = 3; }
        g = __builtin_amdgcn_readfirstlane(g);
        const float gp = 1.0f / (fexp2((g0 - gm) * LOG2E) + fexp2((g1 - gm) * LOG2E) + fexp2((g2 - gm) * LOG2E) + fexp2((g3 - gm) * LOG2E));
        float le[8];
#pragma unroll
        for (int q = 0; q < 8; ++q) { float a = 0.f; const LAS f32x4* wq = (const LAS f32x4*)(WL + (4 + g * 8 + q) * DM);
#pragma unroll
            for (int j = 0; j < 4; ++j) { const f32x4 w = wq[F.lane + 64 * j]; a += (v[j][0] * w[0] + v[j][1] * w[1]) + (v[j][2] * w[2] + v[j][3] * w[3]); }
            le[q] = wave_sum(a) * rs + bre[g * 8 + q]; }
        int i1 = 0; float l1 = le[0];
#pragma unroll
        for (int j = 1; j < 8; ++j) if (le[j] > l1) { l1 = le[j]; i1 = j; }
        int i2 = -1; float l2 = -3.0e38f;
#pragma unroll
        for (int j = 0; j < 8; ++j) if (j != i1 && le[j] > l2) { l2 = le[j]; i2 = j; }
        const float e2 = fexp2((l2 - l1) * LOG2E); const float w1 = gp / (1.f + e2), w2 = gp * e2 / (1.f + e2);
        if (F.lane == 0) {
            RS[row] = rs;
            const int ea = g * 8 + i1, eb = g * 8 + i2;
            const unsigned pa = atomicAdd(cnt + ea, 1u); liste[(size_t)ea * T + pa] = row * 2; listw[(size_t)ea * T + pa] = w1;
            const unsigned pb = atomicAdd(cnt + eb, 1u); liste[(size_t)eb * T + pb] = row * 2 + 1; listw[(size_t)eb * T + pb] = w2;
        }
    }
}
__device__ __forceinline__ void phase_norm2(Frame& F, int l) {
    const Params& P = *F.P;
    float* H = wsp<float>(F, WS_H32); bf16_t* HB = wsp<bf16_t>(F, WS_HB); float* RS = wsp<float>(F, WS_RS); const bf16_t* Y = wsp<bf16_t>(F, WS_Y); bf16_t* PB = wsp<bf16_t>(F, WS_PB);
    const float* pl = P.in[1] + (size_t)l * T * DPLE;
    for (int row = F.gw(); row < T; row += F.ngw()) {
        f32x4* xr = (f32x4*)(H + (size_t)row * DM) + F.lane; f32x4 v[4]; float s = 0.f;
        const u32x2* y0 = (const u32x2*)(Y + (size_t)row * 2 * DM) + F.lane; const u32x2* y1 = y0 + DM / 4;
#pragma unroll
        for (int j = 0; j < 4; ++j) { v[j] = xr[64 * j]; const u32x2 a = y0[64 * j], b = y1[64 * j];
            v[j][0] += bf2f(a.x & 0xffffu) + bf2f(b.x & 0xffffu); v[j][1] += bf2f(a.x >> 16) + bf2f(b.x >> 16);
            v[j][2] += bf2f(a.y & 0xffffu) + bf2f(b.y & 0xffffu); v[j][3] += bf2f(a.y >> 16) + bf2f(b.y >> 16);
            s += (v[j][0] * v[j][0] + v[j][1] * v[j][1]) + (v[j][2] * v[j][2] + v[j][3] * v[j][3]); xr[64 * j] = v[j]; }
        s = wave_sum(s);
        u32x2* o = (u32x2*)(HB + (size_t)row * DM) + F.lane;
#pragma unroll
        for (int j = 0; j < 4; ++j) o[64 * j] = (u32x2){pk2(v[j][0], v[j][1]), pk2(v[j][2], v[j][3])};
        if (F.lane == 0) RS[row] = 1.0f / sqrtf(s * (1.f / DM) + EPS);
        const f32x4 pv = ((const f32x4*)(pl + (size_t)row * DPLE))[F.lane];
        ((u32x2*)(PB + (size_t)row * DPLE))[F.lane] = (u32x2){pk2(pv[0], pv[1]), pk2(pv[2], pv[3])};
    }
}
__device__ __forceinline__ void phase_final(Frame& F) {
    const Params& P = *F.P; const float* H = wsp<float>(F, WS_H32); const float* g = P.in[23];
    for (int row = F.gw(); row < T; row += F.ngw()) {
        const f32x4* xr = (const f32x4*)(H + (size_t)row * DM) + F.lane; f32x4 v[4]; float s = 0.f;
#pragma unroll
        for (int j = 0; j < 4; ++j) { v[j] = xr[64 * j]; s += (v[j][0] * v[j][0] + v[j][1] * v[j][1]) + (v[j][2] * v[j][2] + v[j][3] * v[j][3]); }
        s = wave_sum(s); const float rs = 1.0f / sqrtf(s * (1.f / DM) + EPS);
        f32x4* o = (f32x4*)(P.out + (size_t)row * DM) + F.lane;
#pragma unroll
        for (int j = 0; j < 4; ++j) o[64 * j] = v[j] * rs * ((const f32x4*)g)[F.lane + 64 * j];
    }
}

__device__ __forceinline__ void phase_sb_naive(Frame& F) {
    LAS float* Ks = (LAS float*)F.lds; LAS float* Vs = Ks + 64 * 64;
    const bf16_t* QKV = wsp<bf16_t>(F, WS_QKV); bf16_t* OA = wsp<bf16_t>(F, WS_OA);
    const int tid = F.tid;
    for (int u = F.bx; u < 512; u += F.G) {
        const int b = u >> 6, h = (u >> 3) & 7, qb = u & 7; const int t = qb * 512 + tid; const size_t row = (size_t)b * SEQ + t;
        float q[64], acc[64];
#pragma unroll
        for (int j = 0; j < 8; ++j) unpack8(*(const u32x4*)(QKV + row * 1536 + h * 64 + j * 8), q + j * 8);
#pragma unroll
        for (int d = 0; d < 64; ++d) acc[d] = 0.f;
        float c = 0.f;
        for (int kt = qb * 8 + 7; kt >= 0; --kt) {
            __syncthreads();
            { const size_t kr = (size_t)b * SEQ + kt * 64 + (tid >> 3); float f[8];
              unpack8(*(const u32x4*)(QKV + kr * 1536 + 512 + h * 64 + (tid & 7) * 8), f);
#pragma unroll
              for (int i = 0; i < 8; ++i) Ks[(tid >> 3) * 64 + (tid & 7) * 8 + i] = f[i];
              unpack8(*(const u32x4*)(QKV + kr * 1536 + 1024 + h * 64 + (tid & 7) * 8), f);
#pragma unroll
              for (int i = 0; i < 8; ++i) Vs[(tid >> 3) * 64 + (tid & 7) * 8 + i] = f[i]; }
            __syncthreads();
#pragma unroll 1
            for (int kk = 63; kk >= 0; --kk) {
                const int key = kt * 64 + kk; float z = 0.f;
#pragma unroll
                for (int d4 = 0; d4 < 16; ++d4) { const f32x4 k4 = ((const LAS f32x4*)(Ks + kk * 64))[d4]; z += (q[4 * d4] * k4[0] + q[4 * d4 + 1] * k4[1]) + (q[4 * d4 + 2] * k4[2] + q[4 * d4 + 3] * k4[3]); }
                if (key < t) {
                    const float e = fexp2(fminf(z, 126.f)); c -= flog2(1.f + e); const float w = fexp2(z + c);
#pragma unroll
                    for (int d4 = 0; d4 < 16; ++d4) { const f32x4 v4 = ((const LAS f32x4*)(Vs + kk * 64))[d4]; acc[4 * d4] += w * v4[0]; acc[4 * d4 + 1] += w * v4[1]; acc[4 * d4 + 2] += w * v4[2]; acc[4 * d4 + 3] += w * v4[3]; }
                }
            }
            { volatile LAS unsigned* fl = (volatile LAS unsigned*)(F.lds + 40960);
              __syncthreads(); if (tid == 0) *fl = 1u; __syncthreads();
              if (!__all(c < -150.f) && F.lane == 0) *fl = 0u;
              __syncthreads(); if (*fl != 0u) break; }
        }
#pragma unroll
        for (int j = 0; j < 8; ++j) *(u32x4*)(OA + row * DM + h * 64 + j * 8) = (u32x4){pk2(acc[8 * j], acc[8 * j + 1]), pk2(acc[8 * j + 2], acc[8 * j + 3]), pk2(acc[8 * j + 4], acc[8 * j + 5]), pk2(acc[8 * j + 6], acc[8 * j + 7])};
    }
}
__device__ __forceinline__ void phase_mla_naive(Frame& F) {
    LAS float* Ks = (LAS float*)F.lds; LAS float* Vs = Ks + 64 * 96;
    const bf16_t* QM = wsp<bf16_t>(F, WS_QM); const bf16_t* KN = wsp<bf16_t>(F, WS_KN); const bf16_t* KR = wsp<bf16_t>(F, WS_KR); const bf16_t* VM = wsp<bf16_t>(F, WS_VM); bf16_t* OA = wsp<bf16_t>(F, WS_OA);
    const int tid = F.tid;
    for (int u = F.bx; u < 512; u += F.G) {
        const int b = u >> 6, h = (u >> 3) & 7, qb = 7 - (u & 7); const int t = qb * 512 + tid; const size_t row = (size_t)b * SEQ + t;
        float q[96], acc[64];
#pragma unroll
        for (int j = 0; j < 12; ++j) unpack8(*(const u32x4*)(QM + row * 768 + h * 96 + j * 8), q + j * 8);
#pragma unroll
        for (int d = 0; d < 64; ++d) acc[d] = 0.f;
        float mx = -3.0e38f, lsum = 0.f;
        const int ntile = qb * 8 + 8, myc = t >> 6;
        for (int kt = 0; kt < ntile; ++kt) {
            __syncthreads();
            { const size_t kr = (size_t)b * SEQ + kt * 64 + (tid >> 3); float f[8]; const int ch = tid & 7;
              unpack8(*(const u32x4*)(KN + kr * 512 + h * 64 + ch * 8), f);
#pragma unroll
              for (int i = 0; i < 8; ++i) Ks[(tid >> 3) * 96 + ch * 8 + i] = f[i];
              if (ch < 4) { unpack8(*(const u32x4*)(KR + kr * 32 + ch * 8), f);
#pragma unroll
                  for (int i = 0; i < 8; ++i) Ks[(tid >> 3) * 96 + 64 + ch * 8 + i] = f[i]; }
              unpack8(*(const u32x4*)(VM + kr * 512 + h * 64 + ch * 8), f);
#pragma unroll
              for (int i = 0; i < 8; ++i) Vs[(tid >> 3) * 64 + ch * 8 + i] = f[i]; }
            __syncthreads();
            if (kt <= myc) {
#pragma unroll 1
                for (int kk = 0; kk < 64; ++kk) {
                    float s = 0.f;
#pragma unroll
                    for (int d4 = 0; d4 < 24; ++d4) { const f32x4 k4 = ((const LAS f32x4*)(Ks + kk * 96))[d4]; s += (q[4 * d4] * k4[0] + q[4 * d4 + 1] * k4[1]) + (q[4 * d4 + 2] * k4[2] + q[4 * d4 + 3] * k4[3]); }
                    if (s > mx) { const float f = fexp2(mx - s); lsum *= f;
#pragma unroll
                        for (int d = 0; d < 64; ++d) acc[d] *= f;
                        mx = s; }
                    const float p = fexp2(s - mx); lsum += p;
#pragma unroll
                    for (int d4 = 0; d4 < 16; ++d4) { const f32x4 v4 = ((const LAS f32x4*)(Vs + kk * 64))[d4]; acc[4 * d4] += p * v4[0]; acc[4 * d4 + 1] += p * v4[1]; acc[4 * d4 + 2] += p * v4[2]; acc[4 * d4 + 3] += p * v4[3]; }
                }
            }
        }
        const float il = 1.0f / lsum;
#pragma unroll
        for (int j = 0; j < 8; ++j) *(u32x4*)(OA + row * DM + 512 + h * 64 + j * 8) = (u32x4){pk2(acc[8 * j] * il, acc[8 * j + 1] * il), pk2(acc[8 * j + 2] * il, acc[8 * j + 3] * il), pk2(acc[8 * j + 4] * il, acc[8 * j + 5] * il), pk2(acc[8 * j + 6] * il, acc[8 * j + 7] * il)};
    }
}

__device__ __forceinline__ DenseSched dense_sched(const Frame& F, int N, const void* Bt, int K) { DenseSched S; S.o.init(T, N, F.G, F.bx); S.Bt = (const char*)Bt; S.K = K; return S; }
__device__ __forceinline__ void phase_inproj(Frame& F, int l) {
    const DenseSched S = dense_sched(F, INP, F.ws + WS_WSM + (size_t)l * WSM_STRIDE + WSM_IN, DM);
    const EpiIn E{wsp<float>(F, WS_RS), wsp<bf16_t>(F, WS_QKV), wsp<bf16_t>(F, WS_CKV), wsp<bf16_t>(F, WS_CQ), wsp<bf16_t>(F, WS_KR), wsp<float>(F, WS_COS), wsp<float>(F, WS_SIN)};
    pg8::gemm_phase(F.lds, F.tid, (const char*)(F.ws + WS_HB), DM, S, E);
}
__device__ __forceinline__ void phase_uq(Frame& F, int l) {
    const DenseSched S = dense_sched(F, 768, F.ws + WS_WSM + (size_t)l * WSM_STRIDE + WSM_UQ, QRANK);
    const EpiUq E{wsp<float>(F, WS_RSCQ), wsp<bf16_t>(F, WS_QM), wsp<float>(F, WS_COS), wsp<float>(F, WS_SIN)};
    pg8::gemm_phase(F.lds, F.tid, (const char*)(F.ws + WS_CQ), QRANK, S, E);
}
__device__ __forceinline__ void phase_ukv(Frame& F, int l) {
    const DenseSched S = dense_sched(F, 1024, F.ws + WS_WSM + (size_t)l * WSM_STRIDE + WSM_UKV, KVRANK);
    const EpiUkv E{wsp<float>(F, WS_RSCKV), wsp<bf16_t>(F, WS_KN), wsp<bf16_t>(F, WS_VM)};
    pg8::gemm_phase(F.lds, F.tid, (const char*)(F.ws + WS_CKV), KVRANK, S, E);
}
__device__ __forceinline__ void phase_outproj(Frame& F, int l) {
    const DenseSched S = dense_sched(F, DM, F.ws + WS_WSM + (size_t)l * WSM_STRIDE + WSM_OUT, DM);
    const EpiOut E{l == 0 ? F.P->in[0] : wsp<float>(F, WS_H32), wsp<float>(F, WS_H32)};
    pg8::gemm_phase(F.lds, F.tid, (const char*)(F.ws + WS_OA), DM, S, E);
}
__device__ __forceinline__ void moe_table(Frame& F, int l) {
    LAS int* tb = (LAS int*)(F.lds + pg8::STAGE_BYTES);
    __syncthreads();
    if (F.tid == 0) { const unsigned* cnt = wsp<unsigned>(F, WS_CTL) + CW_CNT + 64 * l; int acc = 0;
        for (int e = 0; e < NEXP; ++e) { const int c = (int)__hip_atomic_load(cnt + e, __ATOMIC_RELAXED, __HIP_MEMORY_SCOPE_AGENT); tb[e] = acc; tb[40 + e] = c; acc += (c + 255) >> 8; }
        tb[32] = acc; }
    __syncthreads();
}
__device__ __forceinline__ void phase_moe1(Frame& F, int l) {
    moe_table(F, l);
    MoeSched S; S.G = F.G; S.c = F.bx; S.npn = 2; S.gather = 1; S.tb = (const LAS int*)(F.lds + pg8::STAGE_BYTES); S.liste = wsp<int>(F, WS_LISTE); S.Bt = (const char*)(F.ws + WS_WG1); S.K = DM; S.nB = 512;
    const EpiG1 E{wsp<float>(F, WS_RS), wsp<int>(F, WS_LISTE), wsp<bf16_t>(F, WS_HID)};
    pg8::gemm_phase(F.lds, F.tid, (const char*)(F.ws + WS_HB), DM, S, E);
}
__device__ __forceinline__ void phase_moe2(Frame& F, int l) {
    moe_table(F, l);
    MoeSched S; S.G = F.G; S.c = F.bx; S.npn = 4; S.gather = 0; S.tb = (const LAS int*)(F.lds + pg8::STAGE_BYTES); S.liste = wsp<int>(F, WS_LISTE); S.Bt = (const char*)(F.ws + WS_WD); S.K = DEXP; S.nB = 1024;
    const EpiDn E{wsp<int>(F, WS_LISTE), wsp<float>(F, WS_LISTW), wsp<bf16_t>(F, WS_Y)};
    pg8::gemm_phase(F.lds, F.tid, (const char*)(F.ws + WS_HID), DEXP, S, E);
}
__device__ __forceinline__ void phase_pe(Frame& F, int l) {
    const DenseSched S = dense_sched(F, DM, F.ws + WS_WSM + (size_t)l * WSM_STRIDE + WSM_PE, DPLE);
    const EpiBf E{wsp<bf16_t>(F, WS_PE), DM};
    pg8::gemm_phase(F.lds, F.tid, (const char*)(F.ws + WS_PB), DPLE, S, E);
}
__device__ __forceinline__ void phase_ple(Frame& F, int l) {
    const DenseSched S = dense_sched(F, DM, F.ws + WS_WSM + (size_t)l * WSM_STRIDE + WSM_PG, DM);
    const EpiPle E{wsp<float>(F, WS_RS), wsp<bf16_t>(F, WS_PE), wsp<float>(F, WS_H32)};
    pg8::gemm_phase(F.lds, F.tid, (const char*)(F.ws + WS_HB), DM, S, E);
}

enum { PH_PREP = 0, PH_PREPMOE, PH_NORM0, PH_NORM, PH_INPROJ, PH_RS2, PH_UQ, PH_UKV, PH_SB, PH_MLA, PH_ONORM, PH_OUTPROJ, PH_ROUTE, PH_MOE1, PH_MOE2, PH_NORM2, PH_PE, PH_PLE, PH_FINAL };
template <int PH> __global__ void __launch_bounds__(NTHREADS, 2) k_phase(Params P, int l) {
    extern __shared__ __attribute__((aligned(16))) unsigned char lds_raw[];
    Frame F; F.lds = (LAS unsigned char*)lds_raw; F.tid = threadIdx.x; F.lane = F.tid & 63; F.wave = __builtin_amdgcn_readfirstlane(F.tid >> 6); F.G = gridDim.x; F.bx = blockIdx.x; F.P = &P; F.ws = P.ws;
    if constexpr (PH == PH_PREP) phase_prep_small(F);
    if constexpr (PH == PH_PREPMOE) phase_prep_moe(F, l);
    if constexpr (PH == PH_NORM0) phase_norm(F, P.in[0]);
    if constexpr (PH == PH_NORM) phase_norm(F, wsp<float>(F, WS_H32));
    if constexpr (PH == PH_INPROJ) phase_inproj(F, l);
    if constexpr (PH == PH_RS2) phase_rs2(F);
    if constexpr (PH == PH_UQ) phase_uq(F, l);
    if constexpr (PH == PH_UKV) phase_ukv(F, l);
    if constexpr (PH == PH_SB) phase_sb_naive(F);
    if constexpr (PH == PH_MLA) phase_mla_naive(F);
    if constexpr (PH == PH_ONORM) phase_onorm(F);
    if constexpr (PH == PH_OUTPROJ) phase_outproj(F, l);
    if constexpr (PH == PH_ROUTE) phase_route(F, l);
    if constexpr (PH == PH_MOE1) phase_moe1(F, l);
    if constexpr (PH == PH_MOE2) phase_moe2(F, l);
    if constexpr (PH == PH_NORM2) phase_norm2(F, l);
    if constexpr (PH == PH_PE) phase_pe(F, l);
    if constexpr (PH == PH_PLE) phase_ple(F, l);
    if constexpr (PH == PH_FINAL) phase_final(F);
}

template <int PH> static void launch_phase(const Params& P, int l, int grid, hipStream_t stream) {
    static bool attr = false;
    if (!attr) { (void)hipFuncSetAttribute((const void*)k_phase<PH>, hipFuncAttributeMaxDynamicSharedMemorySize, LDS_BYTES); attr = true; }
    hipLaunchKernelGGL(k_phase<PH>, dim3(grid), dim3(NTHREADS), LDS_BYTES, stream, P, l);
}

constexpr int CW_BAR = 4096;
constexpr int MISC_OFF = 150 * 1024;
static_assert((CW_BAR + XCD_BAR_WORDS) * 4 <= (int)CTL_BYTES && MISC_OFF + 16 <= LDS_BYTES, "control words");
__global__ void __launch_bounds__(NTHREADS, 2) mega_fwd(Params P) {
    extern __shared__ __attribute__((aligned(16))) unsigned char lds_raw[];
    Frame F; F.lds = (LAS unsigned char*)lds_raw; F.tid = threadIdx.x; F.lane = F.tid & 63; F.wave = __builtin_amdgcn_readfirstlane(F.tid >> 6); F.G = gridDim.x; F.bx = blockIdx.x; F.P = &P; F.ws = P.ws;
    volatile LAS unsigned* st = (volatile LAS unsigned*)(F.lds + MISC_OFF);
    if (F.tid < 4) st[F.tid] = 0u;
    __syncthreads();
    const XcdBarrier bar = xcd_barrier_post(wsp<unsigned>(F, WS_CTL) + CW_BAR, st);
#define GRID_BAR() do { XcdBarrier b_ = bar; asm volatile("" : "+s"(b_.x)); asm volatile("" : "+s"(b_.bar)); xcd_barrier(b_); PH_BEGIN(); } while (0)
#define PH_BEGIN() do { asm volatile("" : "+v"(F.tid)); F.lane = F.tid & 63; asm volatile("" : "+s"(F.ws)); } while (0)
    phase_prep_small(F);
    phase_norm(F, P.in[0]);
    GRID_BAR();
#pragma unroll 1
    for (int l = 0; l < NLAYER; ++l) {
        PH_BEGIN();
        phase_prep_moe(F, l);
        __syncthreads(); PH_BEGIN();
        phase_inproj(F, l);
        GRID_BAR();
        phase_rs2(F);
        GRID_BAR();
        phase_uq(F, l);
        PH_BEGIN();
        phase_ukv(F, l);
        GRID_BAR();
        phase_sb_naive(F);
        __syncthreads(); PH_BEGIN();
        phase_mla_naive(F);
        GRID_BAR();
        phase_onorm(F);
        GRID_BAR();
        phase_outproj(F, l);
        GRID_BAR();
        phase_route(F, l);
        GRID_BAR();
        phase_moe1(F, l);
        GRID_BAR();
        phase_moe2(F, l);
        GRID_BAR();
        phase_norm2(F, l);
        GRID_BAR();
        phase_pe(F, l);
        GRID_BAR();
        phase_ple(F, l);
        GRID_BAR();
        if (l + 1 < NLAYER) { phase_norm(F, wsp<float>(F, WS_H32)); GRID_BAR(); }
    }
    phase_final(F);
#undef GRID_BAR
#undef PH_BEGIN
}

#ifndef MK_MULTI
#define MK_MULTI 0
#endif
extern "C" void kernel_launch(void* const* d_in, const int* in_sizes, int n_in, void* d_out, int out_size, void* d_ws, size_t ws_size, hipStream_t stream) {
    if (n_in != 24 || out_size != T * DM || ws_size < WS_END) { fprintf(stderr, "kernel_launch: unexpected shapes (n_in %d, out %d, ws %zu < %zu)\n", n_in, out_size, ws_size, (size_t)WS_END); return; }
    Params P{};
    for (int i = 0; i < 24; ++i) P.in[i] = (const float*)d_in[i];
    P.out = (float*)d_out; P.ws = (unsigned char*)d_ws;
    for (int i = 0; i < 16; ++i) P.inv_freq[i] = (float)pow(10000.0, -(double)i / 16.0);
    (void)hipMemsetAsync((char*)d_ws + WS_CTL, 0, CTL_BYTES, stream);
#if MK_MULTI
    const int grid = 256;
    launch_phase<PH_PREP>(P, 0, grid, stream);
    launch_phase<PH_NORM0>(P, 0, grid, stream);
    for (int l = 0; l < NLAYER; ++l) {
        launch_phase<PH_PREPMOE>(P, l, grid, stream);
        launch_phase<PH_INPROJ>(P, l, grid, stream);
        launch_phase<PH_RS2>(P, l, grid, stream);
        launch_phase<PH_UQ>(P, l, grid, stream);
        launch_phase<PH_UKV>(P, l, grid, stream);
        launch_phase<PH_SB>(P, l, grid, stream);
        launch_phase<PH_MLA>(P, l, grid, stream);
        launch_phase<PH_ONORM>(P, l, grid, stream);
        launch_phase<PH_OUTPROJ>(P, l, grid, stream);
        launch_phase<PH_ROUTE>(P, l, grid, stream);
        launch_phase<PH_MOE1>(P, l, grid, stream);
        launch_phase<PH_MOE2>(P, l, grid, stream);
        launch_phase<PH_NORM2>(P, l, grid, stream);
        launch_phase<PH_PE>(P, l, grid, stream);
        launch_phase<PH_PLE>(P, l, grid, stream);
        if (l + 1 < NLAYER) launch_phase<PH_NORM>(P, l, grid, stream);
    }
    launch_phase<PH_FINAL>(P, 0, grid, stream);
#else
    static int grid = 0;
    if (grid == 0) {
        int dev = 0, cus = 0;
        if (hipGetDevice(&dev) != hipSuccess || hipDeviceGetAttribute(&cus, hipDeviceAttributeMultiprocessorCount, dev) != hipSuccess || cus <= 0) { grid = -1; return; }
        if (hipFuncSetAttribute((const void*)mega_fwd, hipFuncAttributeMaxDynamicSharedMemorySize, LDS_BYTES) != hipSuccess) { fprintf(stderr, "kernel_launch: hipFuncSetAttribute failed\n"); grid = -1; return; }
        grid = cus;
    }
    if (grid < 0) return;
    hipLaunchKernelGGL(mega_fwd, dim3(grid), dim3(NTHREADS), LDS_BYTES, stream, P);
#endif
}
```

```cpp
#include <hip/hip_runtime.h>
#include <cstdio>
#include <cstdint>
#include <cmath>

#define GAS __attribute__((address_space(1)))
#define LAS __attribute__((address_space(3)))
typedef unsigned short bf16_t;
typedef short bf16x8 __attribute__((ext_vector_type(8)));
typedef float f32x4 __attribute__((ext_vector_type(4)));
typedef float f32x2 __attribute__((ext_vector_type(2)));
typedef unsigned u32x4 __attribute__((ext_vector_type(4)));
typedef unsigned u32x2 __attribute__((ext_vector_type(2)));

constexpr int NB = 8, SEQ = 4096, DM = 1024, NLAYER = 4, T = NB * SEQ;
constexpr int DPLE = 256, SBW = 512, MLAW = 512, QRANK = 384, KVRANK = 256, ROPE = 32, QKD = 96;
constexpr int INC = 2208, INP = 2304;
constexpr int NEXP = 32, DEXP = 256;
constexpr float EPS = 1e-6f;
constexpr float LOG2E = 1.4426950408889634f;
constexpr float QS_SB = 0.125f * LOG2E;
constexpr float QS_MLA = 0.10206207261596575f * LOG2E;
constexpr int NWAVES = 8, NTHREADS = 512;

constexpr size_t MiB = 1u << 20;
constexpr size_t WS_CTL = 0, CTL_BYTES = 1 * MiB;
constexpr size_t WS_COS = 1 * MiB, WS_SIN = 3 * MiB;
constexpr size_t WS_RS = 5 * MiB, WS_RSCQ = 6 * MiB, WS_RSCKV = 7 * MiB;
constexpr size_t WS_LISTE = 8 * MiB, WS_LISTW = 12 * MiB;
constexpr size_t WS_WR = 16 * MiB;
constexpr size_t WS_WSM = 18 * MiB, WSM_STRIDE = 11 * MiB;
constexpr size_t WSM_IN = 0, WSM_OUT = 4608 * 1024, WSM_PG = WSM_OUT + 2 * MiB, WSM_UQ = WSM_PG + 2 * MiB, WSM_UKV = WSM_UQ + 576 * 1024, WSM_PE = WSM_UKV + 512 * 1024;
constexpr size_t WS_WG1 = 62 * MiB, WS_WD = 94 * MiB;
constexpr size_t WS_H32 = 110 * MiB, WS_HB = 238 * MiB;
constexpr size_t WS_ATT = 302 * MiB;
constexpr size_t WS_QKV = WS_ATT, WS_CKV = WS_ATT + 96 * MiB, WS_CQ = WS_CKV + 16 * MiB, WS_KR = WS_CQ + 24 * MiB, WS_QM = WS_KR + 2 * MiB,
                 WS_KN = WS_QM + 48 * MiB, WS_VM = WS_KN + 32 * MiB, WS_OA = WS_VM + 32 * MiB, WS_ATT_END = WS_OA + 64 * MiB;
constexpr size_t WS_HID = WS_ATT, WS_Y = WS_ATT + 36 * MiB, WS_PE = WS_Y + 128 * MiB, WS_PB = WS_PE + 64 * MiB, WS_MOE_END = WS_PB + 16 * MiB;
constexpr size_t WS_END = WS_ATT_END > WS_MOE_END ? WS_ATT_END : WS_MOE_END;
static_assert(WSM_PE + 512 * 1024 <= WSM_STRIDE, "small weights");
static_assert(WS_WSM + 4 * WSM_STRIDE <= WS_WG1, "ws map");
constexpr int CW_CNT = 1024;

constexpr int LDS_BYTES = 152 * 1024;

struct Params {
    const float* in[24];
    float* out;
    unsigned char* ws;
    float inv_freq[16];
};

__device__ __forceinline__ float bf2f(unsigned v) { return __uint_as_float(v << 16); }
__device__ __forceinline__ unsigned f2bf(float f) { unsigned u = __float_as_uint(f); return (u + 0x7fffu + ((u >> 16) & 1u)) >> 16; }
__device__ __forceinline__ unsigned pk2(float lo, float hi) { return f2bf(lo) | (f2bf(hi) << 16); }
__device__ __forceinline__ float wave_sum(float v) {
#pragma unroll
    for (int o = 1; o < 64; o <<= 1) v += __shfl_xor(v, o);
    return v;
}
__device__ __forceinline__ float fexp2(float x) { return __builtin_amdgcn_exp2f(x); }
__device__ __forceinline__ float flog2(float x) { return __builtin_amdgcn_logf(x); }
__device__ __forceinline__ float frcp(float x) { return __builtin_amdgcn_rcpf(x); }
__device__ __forceinline__ void unpack8(u32x4 w, float* f) {
    f[0] = __uint_as_float(w.x << 16); f[1] = __uint_as_float(w.x & 0xffff0000u);
    f[2] = __uint_as_float(w.y << 16); f[3] = __uint_as_float(w.y & 0xffff0000u);
    f[4] = __uint_as_float(w.z << 16); f[5] = __uint_as_float(w.z & 0xffff0000u);
    f[6] = __uint_as_float(w.w << 16); f[7] = __uint_as_float(w.w & 0xffff0000u);
}
__device__ __forceinline__ u32x4 pack8(f32x4 a, f32x4 b) { u32x4 w; w.x = pk2(a[0], a[1]); w.y = pk2(a[2], a[3]); w.z = pk2(b[0], b[1]); w.w = pk2(b[2], b[3]); return w; }

namespace pg8 {
constexpr int BM = 256, BK = 64, HALF = 128, HTB = HALF * BK * 2, STAGE_BYTES = 8 * HTB, NXCD = 8, WGM = 8;
__host__ __device__ __forceinline__ int lds_byte(int r, int c) { const int st = (r >> 4) * 2 + (c >> 5), rr = r & 15, cc = c & 31, ob = rr * 64 + cc * 2; return st * 1024 + (ob ^ (((ob >> 9) & 1) << 5)); }
__host__ __device__ __forceinline__ void stage_rc(int b, int& R, int& C) { const int st = b / 1024, sb = b % 1024, swz = sb ^ (((sb >> 9) & 1) << 5); R = (st >> 1) * 16 + swz / 64; C = (st & 1) * 32 + (swz % 64) / 2; }
__host__ __device__ __forceinline__ int perm32(int rho) { const int n = rho >> 4, i = rho & 15; return 8 * (i >> 2) + 4 * n + (i & 3); }

struct Unit { int pm, pn, e, tile, nrows; };

struct StaticOrder {
    int nM, nN, nwg, G, c;
    __device__ void init(int M, int N, int G_, int c_) { nM = M / BM; nN = N / BM; nwg = nM * nN; G = G_; c = c_; }
    __device__ bool next(int i, Unit& u) const {
        const long L = (long)i * G + c; if (L >= nwg) return false;
        int wgid = (int)L; { const int q = nwg / NXCD, r = nwg % NXCD, xcd = wgid % NXCD, off = wgid / NXCD; wgid = (xcd < r ? xcd * (q + 1) : r * (q + 1) + (xcd - r) * q) + off; }
        const int nig = WGM * nN, gid = wgid / nig, fm = gid * WGM, gsz = (nM - fm) < WGM ? (nM - fm) : WGM;
        u.pm = fm + ((wgid % nig) % gsz); u.pn = (wgid % nig) / gsz; u.e = 0; u.tile = 0; u.nrows = 256; return true;
    }
};

template <class Epi, class Sched>
__device__ __forceinline__ void gemm_phase(LAS unsigned char* lds, const int tid, const char* Abase, const int K, const Sched& S, const Epi& E) {
    const int wid = __builtin_amdgcn_readfirstlane(tid >> 6), lane = tid & 63, wr = wid >> 2, wc = wid & 3, fr = lane & 15, fq = lane >> 4;
    const int nt = K / BK;
    unsigned voffB[2];
#pragma unroll
    for (int i = 0; i < 2; ++i) { int R, C; stage_rc(tid * 16 + i * 8192, R, C); const int Rb = (R & ~31) + perm32(R & 31); voffB[i] = (unsigned)(Rb * K + C) * 2u; }
    const size_t kstep = (size_t)(BK * 2);
    const size_t hstep = (size_t)HALF * K * 2;
    const unsigned ldsw = (unsigned)wid * 1024u;
    const int aoff = lds_byte(wr * 64 + fr, fq * 8), boff = lds_byte(wc * 32 + fr, fq * 8);
#define PG8_SA(b, h) (((b) * 2 + (h)) * HTB)
#define PG8_SB(b, h) ((4 + (b) * 2 + (h)) * HTB)
#define PG8_STAGE(bufoff, gbase, voff) do { _Pragma("unroll") for (int _i = 0; _i < 2; ++_i) \
        __builtin_amdgcn_global_load_lds((const unsigned*)((const char*)(gbase) + (voff)[_i]), (LAS unsigned*)(lds + (bufoff) + ldsw + _i * 8192), 16, 0, 0); } while (0)
#define PG8_LDA(dst, b, h) do { _Pragma("unroll") for (int m = 0; m < 4; ++m) _Pragma("unroll") for (int k = 0; k < 2; ++k) dst[m][k] = *(const LAS bf16x8*)(lds + PG8_SA(b, h) + aoff + m * 2048 + k * 1024); } while (0)
#define PG8_LDB(dst, b, h) do { _Pragma("unroll") for (int n = 0; n < 2; ++n) _Pragma("unroll") for (int k = 0; k < 2; ++k) dst[n][k] = *(const LAS bf16x8*)(lds + PG8_SB(b, h) + boff + n * 2048 + k * 1024); } while (0)
#define PG8_MMA(ai, bj, At, Bt) do { __builtin_amdgcn_s_setprio(1); _Pragma("unroll") for (int m = 0; m < 4; ++m) _Pragma("unroll") for (int n = 0; n < 2; ++n) _Pragma("unroll") for (int k = 0; k < 2; ++k) \
        acc[ai][bj][m][n] = __builtin_amdgcn_mfma_f32_16x16x32_bf16(Bt[n][k], At[m][k], acc[ai][bj][m][n], 0, 0, 0); __builtin_amdgcn_s_setprio(0); } while (0)
#define PG8_WAIT_V(n) asm volatile("s_waitcnt vmcnt(" #n ")" ::: "memory")
#define PG8_WAIT_L(n) asm volatile("s_waitcnt lgkmcnt(" #n ")" ::: "memory")
#define PG8_BAR __builtin_amdgcn_s_barrier()
#define PG8_SCHED __builtin_amdgcn_sched_barrier(0)
    Unit cur, nxt; int ui = 0;
    if (!S.next(0, cur)) return;
    f32x4 acc[2][2][4][2];
#pragma unroll
    for (int a = 0; a < 2; ++a)
#pragma unroll
        for (int b = 0; b < 2; ++b)
#pragma unroll
            for (int m = 0; m < 4; ++m)
#pragma unroll
                for (int n = 0; n < 2; ++n) acc[a][b][m][n] = (f32x4){0.f, 0.f, 0.f, 0.f};
    bf16x8 At[4][2], B0[2][2], B1[2][2];
    unsigned vc[2][2];
    LAS u32x4* vslot = (LAS u32x4*)(lds + STAGE_BYTES + 1024) + tid;
#define PG8_AOFFS(dst, U) do { int t2_ = tid; asm volatile("" : "+v"(t2_)); _Pragma("unroll") for (int i = 0; i < 2; ++i) { int R, C; stage_rc(t2_ * 16 + i * 8192, R, C); \
        dst[0][i] = S.a_off(U, R) + (unsigned)C * 2u; dst[1][i] = S.a_off(U, HALF + R) + (unsigned)C * 2u; } } while (0)
    PG8_AOFFS(vc, cur);
    const char* cB = S.b_tile(cur);
    PG8_STAGE(PG8_SB(0, 0), cB, voffB); PG8_STAGE(PG8_SB(0, 1), cB + hstep, voffB); PG8_STAGE(PG8_SA(0, 0), Abase, vc[0]); PG8_STAGE(PG8_SA(0, 1), Abase, vc[1]);
    if (wr == 1) PG8_BAR;
    PG8_WAIT_V(2); PG8_BAR;
    PG8_STAGE(PG8_SB(1, 0), cB + kstep, voffB); PG8_STAGE(PG8_SA(1, 0), Abase + kstep, vc[0]); PG8_STAGE(PG8_SB(1, 1), cB + hstep + kstep, voffB);
    PG8_WAIT_V(6); PG8_BAR;
    for (;;) {
        const bool has_next = S.next(ui + 1, nxt);
        const char* nB = cB;
        { unsigned vn[2][2];
          if (has_next) { PG8_AOFFS(vn, nxt); nB = S.b_tile(nxt); *vslot = (u32x4){vn[0][0], vn[0][1], vn[1][0], vn[1][1]}; }
          else *vslot = (u32x4){vc[0][0], vc[0][1], vc[1][0], vc[1][1]}; }
        for (int t = 0; t < nt; t += 2) {
            const bool last = (t == nt - 2);
            const char* a1 = Abase + (size_t)(t + 1) * kstep;
            const char* a2 = last ? Abase : Abase + (size_t)(t + 2) * kstep; const char* b2 = last ? nB : cB + (size_t)(t + 2) * kstep;
            const char* a3 = a2 + kstep; const char* b3 = b2 + kstep;
            unsigned w2[2][2];
            if (last) { const u32x4 q = *vslot; w2[0][0] = q.x; w2[0][1] = q.y; w2[1][0] = q.z; w2[1][1] = q.w; }
            else { w2[0][0] = vc[0][0]; w2[0][1] = vc[0][1]; w2[1][0] = vc[1][0]; w2[1][1] = vc[1][1]; }
            PG8_LDB(B0, 0, 0); PG8_LDB(B1, 0, 1); PG8_SCHED; PG8_LDA(At, 0, 0); PG8_STAGE(PG8_SA(1, 1), a1, vc[1]);
            PG8_WAIT_V(8); PG8_WAIT_L(0); PG8_BAR; PG8_MMA(0, 0, At, B0); PG8_MMA(0, 1, At, B1); PG8_BAR; PG8_SCHED;
            PG8_LDA(At, 0, 1); PG8_STAGE(PG8_SB(0, 0), b2, voffB); PG8_STAGE(PG8_SB(0, 1), b2 + hstep, voffB); PG8_STAGE(PG8_SA(0, 0), a2, w2[0]);
            PG8_WAIT_V(8); PG8_WAIT_L(0); PG8_BAR; PG8_MMA(1, 0, At, B0); PG8_MMA(1, 1, At, B1); PG8_BAR; PG8_SCHED;
            PG8_LDB(B0, 1, 0); PG8_LDB(B1, 1, 1); PG8_SCHED; PG8_LDA(At, 1, 0); PG8_STAGE(PG8_SA(0, 1), a2, w2[1]);
            PG8_WAIT_V(8); PG8_WAIT_L(0); PG8_BAR; PG8_MMA(0, 0, At, B0); PG8_MMA(0, 1, At, B1); PG8_BAR; PG8_SCHED;
            PG8_LDA(At, 1, 1); PG8_STAGE(PG8_SB(1, 0), b3, voffB); PG8_STAGE(PG8_SB(1, 1), b3 + hstep, voffB); PG8_STAGE(PG8_SA(1, 0), a3, w2[0]);
            PG8_WAIT_V(8); PG8_WAIT_L(0); PG8_BAR; PG8_MMA(1, 0, At, B0); PG8_MMA(1, 1, At, B1); PG8_BAR; PG8_SCHED;
        }
        if (wr == 0) PG8_BAR;
        { int fr2 = fr, fq2 = fq; asm volatile("" : "+v"(fr2), "+v"(fq2));
          E(acc, cur, wr, wc, fr2, fq2); }
        if (!has_next) break;
#pragma unroll
        for (int a = 0; a < 2; ++a)
#pragma unroll
            for (int b = 0; b < 2; ++b)
#pragma unroll
                for (int m = 0; m < 4; ++m)
#pragma unroll
                    for (int n = 0; n < 2; ++n) acc[a][b][m][n] = (f32x4){0.f, 0.f, 0.f, 0.f};
        cur = nxt; cB = nB; ++ui;
        { const u32x4 q = *vslot; vc[0][0] = q.x; vc[0][1] = q.y; vc[1][0] = q.z; vc[1][1] = q.w; }
        if (wr == 1) PG8_BAR;
    }
    PG8_WAIT_V(0);
    PG8_BAR;
#undef PG8_AOFFS
#undef PG8_SA
#undef PG8_SB
#undef PG8_STAGE
#undef PG8_LDA
#undef PG8_LDB
#undef PG8_MMA
#undef PG8_WAIT_V
#undef PG8_WAIT_L
#undef PG8_BAR
#undef PG8_SCHED
}
}
using pg8::Unit;

struct DenseSched {
    pg8::StaticOrder o; const char* Bt; int K;
    __device__ __forceinline__ bool next(int i, Unit& u) const { return o.next(i, u); }
    __device__ __forceinline__ unsigned a_off(const Unit& u, int r) const { return (unsigned)(u.pm * 256 + r) * (unsigned)(K * 2); }
    __device__ __forceinline__ const char* b_tile(const Unit& u) const { return Bt + (size_t)u.pn * 256 * K * 2; }
};
struct MoeSched {
    int G, c, npn, gather; const LAS int* tb; const int* liste; const char* Bt; int K, nB;
    __device__ __forceinline__ bool next(int i, Unit& u) const {
        const int L = i * G + c, ntile = tb[32];
        if (L >= ntile * npn) return false;
        const int ti = L / npn; u.pn = L % npn; u.pm = ti;
        int e = 0;
#pragma unroll 1
        for (; e < 31; ++e) if (ti < tb[e + 1]) break;
        u.e = e; u.tile = ti - tb[e]; const int rem = tb[40 + e] - 256 * u.tile; u.nrows = rem < 256 ? rem : 256; return true;
    }
    __device__ __forceinline__ unsigned a_off(const Unit& u, int r) const {
        if (gather) { int tok = 0; if (r < u.nrows) tok = liste[(size_t)u.e * T + 256 * u.tile + r] >> 1; return (unsigned)tok * (unsigned)(K * 2); }
        return (unsigned)(u.pm * 256 + r) * (unsigned)(K * 2);
    }
    __device__ __forceinline__ const char* b_tile(const Unit& u) const { return Bt + ((size_t)u.e * nB + (size_t)u.pn * 256) * K * 2; }
};

struct EpiIn {
    const float* RS; bf16_t* QKV; bf16_t* CKV; bf16_t* CQ; bf16_t* KR; const float* COS; const float* SIN;
    __device__ __forceinline__ void operator()(const f32x4 (&acc)[2][2][4][2], const Unit& u, int wr, int wc, int fr, int fq) const {
        const int pn = u.pn;
#pragma unroll
        for (int ai = 0; ai < 2; ++ai)
#pragma unroll
            for (int m = 0; m < 4; ++m) {
                const int row = u.pm * 256 + ai * 128 + wr * 64 + m * 16 + fr; const float rs = RS[row];
#pragma unroll
                for (int bj = 0; bj < 2; ++bj) {
                    const int c = bj * 128 + wc * 32 + fq * 8;
                    f32x4 v0 = acc[ai][bj][m][0] * rs, v1 = acc[ai][bj][m][1] * rs;
                    if (pn < 6) { if (pn < 2) { v0 = v0 * QS_SB; v1 = v1 * QS_SB; } *(u32x4*)(QKV + (size_t)row * 1536 + pn * 256 + c) = pack8(v0, v1); }
                    else if (pn == 6) { *(u32x4*)(CKV + (size_t)row * 256 + c) = pack8(v0, v1); }
                    else if (pn == 7) { *(u32x4*)(CQ + (size_t)row * 384 + c) = pack8(v0, v1); }
                    else if (bj == 0) { *(u32x4*)(CQ + (size_t)row * 384 + 256 + c) = pack8(v0, v1); }
                    else if (wc == 0) {
                        const int ib = 8 * (fq & 1);
                        const f32x4 c0 = *(const f32x4*)(COS + (size_t)row * 16 + ib), c1 = *(const f32x4*)(COS + (size_t)row * 16 + ib + 4);
                        const f32x4 s0 = *(const f32x4*)(SIN + (size_t)row * 16 + ib), s1 = *(const f32x4*)(SIN + (size_t)row * 16 + ib + 4);
                        f32x4 p0, p1;
#pragma unroll
                        for (int i = 0; i < 4; ++i) { p0[i] = __shfl_xor(v0[i], 32); p1[i] = __shfl_xor(v1[i], 32); }
                        const float sg = (fq < 2) ? -1.f : 1.f;
                        const f32x4 o0 = v0 * c0 + p0 * s0 * sg, o1 = v1 * c1 + p1 * s1 * sg;
                        *(u32x4*)(KR + (size_t)row * 32 + fq * 8) = pack8(o0, o1);
                    }
                }
                asm volatile("" ::: "memory");
            }
    }
};
struct EpiUq {
    const float* RS; bf16_t* QM; const float* COS; const float* SIN;
    __device__ __forceinline__ void operator()(const f32x4 (&acc)[2][2][4][2], const Unit& u, int wr, int wc, int fr, int fq) const {
#pragma unroll
        for (int ai = 0; ai < 2; ++ai)
#pragma unroll
            for (int m = 0; m < 4; ++m) {
                const int row = u.pm * 256 + ai * 128 + wr * 64 + m * 16 + fr; const float rs = RS[row] * QS_MLA;
#pragma unroll
                for (int bj = 0; bj < 2; ++bj) {
                    const int c = u.pn * 256 + bj * 128 + wc * 32 + fq * 8; const int g32 = u.pn * 8 + bj * 4 + wc;
                    f32x4 v0 = acc[ai][bj][m][0] * rs, v1 = acc[ai][bj][m][1] * rs;
                    if ((g32 % 3) == 2) {
                        const int ib = 8 * (fq & 1);
                        const f32x4 c0 = *(const f32x4*)(COS + (size_t)row * 16 + ib), c1 = *(const f32x4*)(COS + (size_t)row * 16 + ib + 4);
                        const f32x4 s0 = *(const f32x4*)(SIN + (size_t)row * 16 + ib), s1 = *(const f32x4*)(SIN + (size_t)row * 16 + ib + 4);
                        f32x4 p0, p1;
#pragma unroll
                        for (int i = 0; i < 4; ++i) { p0[i] = __shfl_xor(v0[i], 32); p1[i] = __shfl_xor(v1[i], 32); }
                        const float sg = (fq < 2) ? -1.f : 1.f;
                        v0 = v0 * c0 + p0 * s0 * sg; v1 = v1 * c1 + p1 * s1 * sg;
                    }
                    *(u32x4*)(QM + (size_t)row * 768 + c) = pack8(v0, v1);
                }
                asm volatile("" ::: "memory");
            }
    }
};
struct EpiUkv {
    const float* RS; bf16_t* KN; bf16_t* VM;
    __device__ __forceinline__ void operator()(const f32x4 (&acc)[2][2][4][2], const Unit& u, int wr, int wc, int fr, int fq) const {
        bf16_t* dst = u.pn < 2 ? KN : VM; const int cb = (u.pn & 1) * 256;
#pragma unroll
        for (int ai = 0; ai < 2; ++ai)
#pragma unroll
            for (int m = 0; m < 4; ++m) {
                const int row = u.pm * 256 + ai * 128 + wr * 64 + m * 16 + fr; const float rs = RS[row];
#pragma unroll
                for (int bj = 0; bj < 2; ++bj) { const int c = cb + bj * 128 + wc * 32 + fq * 8;
                    *(u32x4*)(dst + (size_t)row * 512 + c) = pack8(acc[ai][bj][m][0] * rs, acc[ai][bj][m][1] * rs); }
            }
    }
};
struct EpiBf {
    bf16_t* O; int ldc;
    __device__ __forceinline__ void operator()(const f32x4 (&acc)[2][2][4][2], const Unit& u, int wr, int wc, int fr, int fq) const {
#pragma unroll
        for (int ai = 0; ai < 2; ++ai)
#pragma unroll
            for (int m = 0; m < 4; ++m) {
                const int row = u.pm * 256 + ai * 128 + wr * 64 + m * 16 + fr;
#pragma unroll
                for (int bj = 0; bj < 2; ++bj) { const int c = u.pn * 256 + bj * 128 + wc * 32 + fq * 8;
                    *(u32x4*)(O + (size_t)row * ldc + c) = pack8(acc[ai][bj][m][0], acc[ai][bj][m][1]); }
            }
    }
};
struct EpiOut {
    const float* hin; float* hout;
    __device__ __forceinline__ void operator()(const f32x4 (&acc)[2][2][4][2], const Unit& u, int wr, int wc, int fr, int fq) const {
#pragma unroll
        for (int ai = 0; ai < 2; ++ai)
#pragma unroll
            for (int m = 0; m < 4; ++m) {
                const int row = u.pm * 256 + ai * 128 + wr * 64 + m * 16 + fr;
#pragma unroll
                for (int bj = 0; bj < 2; ++bj) { const size_t o = (size_t)row * DM + u.pn * 256 + bj * 128 + wc * 32 + fq * 8;
                    const f32x4 a = *(const f32x4*)(hin + o), b = *(const f32x4*)(hin + o + 4);
                    *(f32x4*)(hout + o) = a + acc[ai][bj][m][0]; *(f32x4*)(hout + o + 4) = b + acc[ai][bj][m][1]; }
                asm volatile("" ::: "memory");
            }
    }
};
struct EpiG1 {
    const float* RS; const int* liste; bf16_t* HID;
    __device__ __forceinline__ void operator()(const f32x4 (&acc)[2][2][4][2], const Unit& u, int wr, int wc, int fr, int fq) const {
#pragma unroll
        for (int ai = 0; ai < 2; ++ai)
#pragma unroll
            for (int m = 0; m < 4; ++m) {
                const int r = ai * 128 + wr * 64 + m * 16 + fr;
                if (r < u.nrows) {
                    const int tok = liste[(size_t)u.e * T + 256 * u.tile + r] >> 1; const float rs = RS[tok];
                    f32x4 h[2];
#pragma unroll
                    for (int n = 0; n < 2; ++n) { const f32x4 g = acc[ai][0][m][n] * rs, up = acc[ai][1][m][n] * rs;
#pragma unroll
                        for (int i = 0; i < 4; ++i) h[n][i] = g[i] * frcp(1.f + fexp2(-g[i] * LOG2E)) * up[i]; }
                    *(u32x4*)(HID + (size_t)(u.pm * 256 + r) * 256 + u.pn * 128 + wc * 32 + fq * 8) = pack8(h[0], h[1]);
                }
                asm volatile("" ::: "memory");
            }
    }
};
struct EpiDn {
    const int* liste; const float* listw; bf16_t* Y;
    __device__ __forceinline__ void operator()(const f32x4 (&acc)[2][2][4][2], const Unit& u, int wr, int wc, int fr, int fq) const {
#pragma unroll
        for (int ai = 0; ai < 2; ++ai)
#pragma unroll
            for (int m = 0; m < 4; ++m) {
                const int r = ai * 128 + wr * 64 + m * 16 + fr;
                if (r < u.nrows) {
                    const size_t li = (size_t)u.e * T + 256 * u.tile + r; const int ent = liste[li]; const float w = listw[li];
#pragma unroll
                    for (int bj = 0; bj < 2; ++bj) { const int c = u.pn * 256 + bj * 128 + wc * 32 + fq * 8;
                        *(u32x4*)(Y + (size_t)ent * DM + c) = pack8(acc[ai][bj][m][0] * w, acc[ai][bj][m][1] * w); }
                }
                asm volatile("" ::: "memory");
            }
    }
};
struct EpiPle {
    const float* RS; const bf16_t* PE; float* H;
    __device__ __forceinline__ void operator()(const f32x4 (&acc)[2][2][4][2], const Unit& u, int wr, int wc, int fr, int fq) const {
#pragma unroll
        for (int ai = 0; ai < 2; ++ai)
#pragma unroll
            for (int m = 0; m < 4; ++m) {
                const int row = u.pm * 256 + ai * 128 + wr * 64 + m * 16 + fr; const float rs = RS[row];
#pragma unroll
                for (int bj = 0; bj < 2; ++bj) { const size_t o = (size_t)row * DM + u.pn * 256 + bj * 128 + wc * 32 + fq * 8;
                    float pe[8]; unpack8(*(const u32x4*)(PE + o), pe);
                    f32x4 a = *(const f32x4*)(H + o), b = *(const f32x4*)(H + o + 4);
#pragma unroll
                    for (int i = 0; i < 4; ++i) { a[i] += frcp(1.f + fexp2(-acc[ai][bj][m][0][i] * rs * LOG2E)) * pe[i]; b[i] += frcp(1.f + fexp2(-acc[ai][bj][m][1][i] * rs * LOG2E)) * pe[4 + i]; }
                    *(f32x4*)(H + o) = a; *(f32x4*)(H + o + 4) = b; }
                asm volatile("" ::: "memory");
            }
    }
};


#define XB_TMO      128
#define XB_XCNT(j)  (256  + 64 * (j))
#define XB_XSUB(j)  (1280 + 64 * (j))
#define XB_XGEN(j)  (2304 + 64 * (j))
#define XB_TOP      3328
#define XB_TOPGEN   3392
#define XCD_BAR_WORDS 3456
#define XB_SPIN_CAP (1u << 18)

__device__ __forceinline__ unsigned xb_ld(unsigned* p)              { return __hip_atomic_load(p, __ATOMIC_RELAXED, __HIP_MEMORY_SCOPE_AGENT); }
__device__ __forceinline__ unsigned xb_add(unsigned* p, unsigned v) { return __hip_atomic_fetch_add(p, v, __ATOMIC_RELAXED, __HIP_MEMORY_SCOPE_AGENT); }
__device__ __forceinline__ unsigned xb_xcc_id() { return (unsigned)__builtin_amdgcn_s_getreg((3 << 11) | 20) & 0xFu; }
#define XB_SPIN(cond, bar) do { unsigned _sp = 0; while (cond) { __builtin_amdgcn_s_sleep(1); \
    if ((++_sp & 255u) == 0u) { if (xb_ld(&(bar)[XB_TMO])) break; if (_sp > XB_SPIN_CAP) { atomicAdd(&(bar)[XB_TMO], 1u); break; } } } } while (0)

struct XcdBarrier {
    unsigned* bar; unsigned x;
    volatile LAS unsigned* st;
};

__device__ __forceinline__ XcdBarrier xcd_barrier_post(unsigned* bar, volatile LAS unsigned* st) {
    XcdBarrier b; b.bar = bar; b.x = xb_xcc_id(); b.st = st;
    if (threadIdx.x == 0) (void)xb_add(&bar[XB_XCNT(b.x)], 1u);
    return b;
}
__device__ __forceinline__ void xcd_barrier_complete(unsigned* bar, unsigned x, unsigned& nloc, unsigned& nx) {
    const unsigned G = gridDim.x * gridDim.y * gridDim.z;
    unsigned sum, cnt, mine, sp = 0u;
    for (;;) {
        sum = 0u; cnt = 0u; mine = 0u;
#pragma unroll
        for (unsigned j = 0; j < 16; ++j) { const unsigned c = xb_ld(&bar[XB_XCNT(j)]); sum += c; cnt += (c > 0u) ? 1u : 0u; mine = (j == x) ? c : mine; }
        if (sum == G) break;
        __builtin_amdgcn_s_sleep(1);
        if ((++sp & 255u) == 0u) { if (xb_ld(&bar[XB_TMO])) break; if (sp > XB_SPIN_CAP) { atomicAdd(&bar[XB_TMO], 1u); break; } }
    }
    nloc = mine > 0u ? mine : 1u; nx = cnt > 0u ? cnt : 1u;
}

__device__ __forceinline__ void xcd_barrier(const XcdBarrier& b) {
    asm volatile("s_waitcnt vmcnt(0)" ::: "memory");
    __syncthreads();
    if (threadIdx.x == 0) {
        unsigned* bar = b.bar;
        __builtin_amdgcn_s_waitcnt(0);
        unsigned nloc = b.st[0], nx = b.st[1];
        if (nloc == 0u) { xcd_barrier_complete(bar, b.x, nloc, nx); b.st[0] = nloc; b.st[1] = nx; }
        const unsigned old = xb_add(&bar[XB_XSUB(b.x)], 1u);
        const unsigned gen = old / nloc;
        if (old + 1u == (gen + 1u) * nloc) {
            __builtin_amdgcn_fence(__ATOMIC_RELEASE, "agent");
            asm volatile("s_waitcnt vmcnt(0)" ::: "memory");
            const unsigned og = xb_add(&bar[XB_TOP], 1u);
            const unsigned tg = og / nx;
            if (og + 1u == (tg + 1u) * nx) xb_add(&bar[XB_TOPGEN], 1u);
            else XB_SPIN(xb_ld(&bar[XB_TOPGEN]) == tg, bar);
            __builtin_amdgcn_fence(__ATOMIC_ACQUIRE, "agent");
            xb_add(&bar[XB_XGEN(b.x)], 1u);
            asm volatile("s_waitcnt vmcnt(0)" ::: "memory");
        } else {
            XB_SPIN(xb_ld(&bar[XB_XGEN(b.x)]) == gen, bar);
            __builtin_amdgcn_fence(__ATOMIC_ACQUIRE, "agent");
            asm volatile("s_waitcnt vmcnt(0)" ::: "memory");
        }
    }
    __syncthreads();
}


struct Frame {
    LAS unsigned char* lds; int tid, lane, wave, G, bx;
    const Params* P; unsigned char* ws;
    __device__ __forceinline__ int gw() const { return bx * NWAVES + wave; }
    __device__ __forceinline__ int ngw() const { return G * NWAVES; }
};
template <class Tp> __device__ __forceinline__ Tp* wsp(const Frame& F, size_t off) { return (Tp*)(F.ws + off); }

__device__ __forceinline__ void prep_item(const float* W, int ldw, int srccol0, const float* g, bf16_t* dstrow0, int K, int k0, LAS float* scr, int lane) {
    const int c = lane & 7;
    if (srccol0 < 0) {
#pragma unroll
        for (int j = 0; j < 4; ++j) { const int n = (lane >> 3) + 8 * j; *(u32x4*)(dstrow0 + (size_t)n * K + k0 + 8 * c) = (u32x4){0u, 0u, 0u, 0u}; }
        return;
    }
#pragma unroll 8
    for (int i = 0; i < 32; ++i) { const int kk = 2 * i + (lane >> 5); float v = W[(size_t)(k0 + kk) * ldw + srccol0 + (lane & 31)]; if (g) v *= g[k0 + kk]; scr[kk * 33 + (lane & 31)] = v; }
    asm volatile("s_waitcnt lgkmcnt(0)" ::: "memory");
#pragma unroll
    for (int j = 0; j < 4; ++j) { const int n = (lane >> 3) + 8 * j; const LAS float* s = scr + (8 * c) * 33 + n;
        u32x4 o; o.x = pk2(s[0 * 33], s[1 * 33]); o.y = pk2(s[2 * 33], s[3 * 33]); o.z = pk2(s[4 * 33], s[5 * 33]); o.w = pk2(s[6 * 33], s[7 * 33]);
        *(u32x4*)(dstrow0 + (size_t)n * K + k0 + 8 * c) = o; }
    asm volatile("s_waitcnt lgkmcnt(0)" ::: "memory");
}
__device__ __forceinline__ void phase_prep_small(Frame& F) {
    const Params& P = *F.P;
    LAS float* scr = (LAS float*)(F.lds + F.wave * 16384);
    constexpr int I_IN = 16 * 72, I_UQ = 6 * 24, I_UKV = 4 * 32, I_OUT = 16 * 32, I_PG = 16 * 32, I_PE = 4 * 32, I_L = I_IN + I_UQ + I_UKV + I_OUT + I_PG + I_PE;
    for (int it = F.gw(); it < NLAYER * I_L; it += F.ngw()) {
        const int l = it / I_L; int r = it % I_L;
        unsigned char* wb = F.ws + WS_WSM + (size_t)l * WSM_STRIDE;
        if (r < I_IN) { const int kb = r / 72, gi = r % 72, n0 = gi * 32; int src;
            if (n0 < 1536) src = n0; else if (n0 < 1792) src = 1920 + (n0 - 1536); else if (n0 < 2176) src = 1536 + (n0 - 1792); else if (n0 < 2208) src = n0; else src = -1;
            prep_item(P.in[4] + (size_t)l * DM * INC, INC, src, P.in[3] + l * DM, (bf16_t*)(wb + WSM_IN) + (size_t)n0 * DM, DM, kb * 64, scr, F.lane); continue; }
        r -= I_IN;
        if (r < I_UQ) { const int kb = r / 24, n0 = (r % 24) * 32;
            prep_item(P.in[6] + (size_t)l * QRANK * 768, 768, n0, P.in[5] + l * QRANK, (bf16_t*)(wb + WSM_UQ) + (size_t)n0 * QRANK, QRANK, kb * 64, scr, F.lane); continue; }
        r -= I_UQ;
        if (r < I_UKV) { const int kb = r / 32, n0 = (r % 32) * 32; const int hh = (n0 & 511) >> 6, d = n0 & 63; const int src = hh * 128 + (n0 >= 512 ? 64 : 0) + d;
            prep_item(P.in[8] + (size_t)l * KVRANK * 1024, 1024, src, P.in[7] + l * KVRANK, (bf16_t*)(wb + WSM_UKV) + (size_t)n0 * KVRANK, KVRANK, kb * 64, scr, F.lane); continue; }
        r -= I_UKV;
        if (r < I_OUT) { const int kb = r / 32, n0 = (r % 32) * 32; const int k0 = kb * 64;
            const float* g = k0 < 512 ? P.in[9] + l * 512 : P.in[10] + l * 512 - 512;
            prep_item(P.in[11] + (size_t)l * DM * DM, DM, n0, g, (bf16_t*)(wb + WSM_OUT) + (size_t)n0 * DM, DM, k0, scr, F.lane); continue; }
        r -= I_OUT;
        if (r < I_PG) { const int kb = r / 32, n0 = (r % 32) * 32;
            prep_item(P.in[21] + (size_t)l * DM * DM, DM, n0, P.in[20] + l * DM, (bf16_t*)(wb + WSM_PG) + (size_t)n0 * DM, DM, kb * 64, scr, F.lane); continue; }
        r -= I_PG;
        { const int kb = r / 32, n0 = (r % 32) * 32;
            prep_item(P.in[22] + (size_t)l * DPLE * DM, DM, n0, nullptr, (bf16_t*)(wb + WSM_PE) + (size_t)n0 * DPLE, DPLE, kb * 64, scr, F.lane); }
    }
    float* WR = wsp<float>(F, WS_WR);
    for (int i = F.bx * NTHREADS + F.tid; i < NLAYER * 36 * DM; i += F.G * NTHREADS) {
        const int l = i / (36 * DM), j = (i / DM) % 36, k = i % DM;
        const float w = j < 4 ? P.in[13][((size_t)l * DM + k) * 4 + j] : P.in[15][((size_t)l * DM + k) * 32 + (j - 4)];
        WR[i] = w * P.in[12][l * DM + k];
    }
    float* COS = wsp<float>(F, WS_COS); float* SIN = wsp<float>(F, WS_SIN); const int* pos = (const int*)P.in[2];
    for (int i = F.bx * NTHREADS + F.tid; i < T * 16; i += F.G * NTHREADS) {
        const float ang = (float)pos[i >> 4] * P.inv_freq[i & 15];
        const double a = (double)ang; const double q = __builtin_rint(a * 0.63661977236758134308);
        double r = __builtin_fma(-q, 1.57079632679489655800, a); r = __builtin_fma(-q, 6.12323399573676603587e-17, r);
        const double z = r * r;
        const double sp = r + r * z * (-0.166666666416265235595 + z * (0.0083333293858894631756 + z * (-0.000198393348360966317347 + z * 0.0000027183114939898219064)));
        const double cp = 1.0 + z * (-0.499999997251031003120 + z * (0.0416666233237390631894 + z * (-0.00138867637746099294692 + z * 0.0000243904487962774090654)));
        const int qi = (int)((long long)q & 3);
        const double sv = (qi == 0) ? sp : (qi == 1) ? cp : (qi == 2) ? -sp : -cp;
        const double cv = (qi == 0) ? cp : (qi == 1) ? -sp : (qi == 2) ? -cp : sp;
        COS[i] = (float)cv; SIN[i] = (float)sv;
    }
}
__device__ __forceinline__ void phase_prep_moe(Frame& F, int l) {
    const Params& P = *F.P;
    LAS float* scr = (LAS float*)(F.lds + F.wave * 16384);
    constexpr int I_G1 = 16 * 16, I_DN = 4 * 32, I_E = I_G1 + I_DN;
    bf16_t* WG1 = wsp<bf16_t>(F, WS_WG1); bf16_t* WD = wsp<bf16_t>(F, WS_WD);
    for (int it = F.gw(); it < NEXP * I_E; it += F.ngw()) {
        const int e = it / I_E; int r = it % I_E;
        if (r < I_G1) { const int kb = r / 16, n0 = (r % 16) * 32; const int pn = n0 >> 8, c = n0 & 255;
            const float* W = (c < 128 ? P.in[17] : P.in[18]) + ((size_t)l * NEXP + e) * DM * DEXP; const int src = pn * 128 + (c & 127);
            prep_item(W, DEXP, src, P.in[12] + l * DM, WG1 + ((size_t)e * 512 + n0) * DM, DM, kb * 64, scr, F.lane); }
        else { r -= I_G1; const int kb = r / 32, n0 = (r % 32) * 32;
            prep_item(P.in[19] + ((size_t)l * NEXP + e) * DEXP * DM, DM, n0, nullptr, WD + ((size_t)e * DM + n0) * DEXP, DEXP, kb * 64, scr, F.lane); }
    }
}

__device__ __forceinline__ void phase_norm(Frame& F, const float* hin) {
    bf16_t* HB = wsp<bf16_t>(F, WS_HB); float* RS = wsp<float>(F, WS_RS);
    for (int row = F.gw(); row < T; row += F.ngw()) {
        const f32x4* xr = (const f32x4*)(hin + (size_t)row * DM) + F.lane; f32x4 v[4]; float s = 0.f;
#pragma unroll
        for (int j = 0; j < 4; ++j) { v[j] = xr[64 * j]; s += (v[j][0] * v[j][0] + v[j][1] * v[j][1]) + (v[j][2] * v[j][2] + v[j][3] * v[j][3]); }
        s = wave_sum(s);
        u32x2* o = (u32x2*)(HB + (size_t)row * DM) + F.lane;
#pragma unroll
        for (int j = 0; j < 4; ++j) o[64 * j] = (u32x2){pk2(v[j][0], v[j][1]), pk2(v[j][2], v[j][3])};
        if (F.lane == 0) RS[row] = 1.0f / sqrtf(s * (1.f / DM) + EPS);
    }
}
__device__ __forceinline__ void phase_rs2(Frame& F) {
    const bf16_t* CQ = wsp<bf16_t>(F, WS_CQ); const bf16_t* CKV = wsp<bf16_t>(F, WS_CKV); float* RQ = wsp<float>(F, WS_RSCQ); float* RK = wsp<float>(F, WS_RSCKV);
    for (int row = F.gw(); row < T; row += F.ngw()) {
        float sq = 0.f, sk = 0.f, f[8];
        if (F.lane < 48) { unpack8(*(const u32x4*)(CQ + (size_t)row * QRANK + F.lane * 8), f);
#pragma unroll
            for (int i = 0; i < 8; ++i) sq += f[i] * f[i]; }
        if (F.lane < 32) { unpack8(*(const u32x4*)(CKV + (size_t)row * KVRANK + F.lane * 8), f);
#pragma unroll
            for (int i = 0; i < 8; ++i) sk += f[i] * f[i]; }
        sq = wave_sum(sq); sk = wave_sum(sk);
        if (F.lane == 0) { RQ[row] = 1.0f / sqrtf(sq * (1.f / QRANK) + EPS); RK[row] = 1.0f / sqrtf(sk * (1.f / KVRANK) + EPS); }
    }
}
__device__ __forceinline__ void phase_onorm(Frame& F) {
    bf16_t* OA = wsp<bf16_t>(F, WS_OA);
    for (int row = F.gw(); row < T; row += F.ngw()) {
        u32x4* p = (u32x4*)(OA + (size_t)row * DM + F.lane * 16); float f[16]; unpack8(p[0], f); unpack8(p[1], f + 8);
        float s = 0.f;
#pragma unroll
        for (int i = 0; i < 16; ++i) s += f[i] * f[i];
#pragma unroll
        for (int o = 1; o < 32; o <<= 1) s += __shfl_xor(s, o);
        const float rs = 1.0f / sqrtf(s * (1.f / 512.f) + EPS);
#pragma unroll
        for (int i = 0; i < 16; ++i) f[i] *= rs;
        p[0] = (u32x4){pk2(f[0], f[1]), pk2(f[2], f[3]), pk2(f[4], f[5]), pk2(f[6], f[7])};
        p[1] = (u32x4){pk2(f[8], f[9]), pk2(f[10], f[11]), pk2(f[12], f[13]), pk2(f[14], f[15])};
    }
}
__device__ __forceinline__ void phase_route(Frame& F, int l) {
    const Params& P = *F.P;
    LAS float* WL = (LAS float*)F.lds;
    const float* WR = wsp<float>(F, WS_WR) + (size_t)l * 36 * DM;
    for (int i = F.tid; i < 36 * DM / 4; i += NTHREADS) ((LAS f32x4*)WL)[i] = ((const f32x4*)WR)[i];
    __syncthreads();
    const float* H = wsp<float>(F, WS_H32); bf16_t* HB = wsp<bf16_t>(F, WS_HB); float* RS = wsp<float>(F, WS_RS);
    unsigned* cnt = wsp<unsigned>(F, WS_CTL) + CW_CNT + 64 * l; int* liste = wsp<int>(F, WS_LISTE); float* listw = wsp<float>(F, WS_LISTW);
    const float* brg = P.in[14] + l * 4; const float* bre = P.in[16] + l * 32;
    for (int row = F.gw(); row < T; row += F.ngw()) {
        const f32x4* xr = (const f32x4*)(H + (size_t)row * DM) + F.lane; f32x4 v[4]; float s = 0.f;
#pragma unroll
        for (int j = 0; j < 4; ++j) { v[j] = xr[64 * j]; s += (v[j][0] * v[j][0] + v[j][1] * v[j][1]) + (v[j][2] * v[j][2] + v[j][3] * v[j][3]); }
        s = wave_sum(s); const float rs = 1.0f / sqrtf(s * (1.f / DM) + EPS);
        u32x2* o = (u32x2*)(HB + (size_t)row * DM) + F.lane;
#pragma unroll
        for (int j = 0; j < 4; ++j) o[64 * j] = (u32x2){pk2(v[j][0], v[j][1]), pk2(v[j][2], v[j][3])};
        float gl[4];
#pragma unroll
        for (int q = 0; q < 4; ++q) { float a = 0.f;
#pragma unroll
            for (int j = 0; j < 4; ++j) { const f32x4 w = ((const LAS f32x4*)(WL + q * DM))[F.lane + 64 * j]; a += (v[j][0] * w[0] + v[j][1] * w[1]) + (v[j][2] * w[2] + v[j][3] * w[3]); }
            gl[q] = wave_sum(a) * rs; }
        const float g0 = gl[0] + brg[0], g1 = gl[1] + brg[1], g2 = gl[2] + brg[2], g3 = gl[3] + brg[3];
        int g = 0; float gm = g0; if (g1 > gm) { gm = g1; g = 1; } if (g2 > gm) { gm = g2; g = 2; } if (g3 > gm) { gm = g3; g = 3; }
        g = __builtin_amdgcn_readfirstlane(g);
        const float gp = 1.0f / (fexp2((g0 - gm) * LOG2E) + fexp2((g1 - gm) * LOG2E) + fexp2((g2 - gm) * LOG2E) + fexp2((g3 - gm) * LOG2E));
        float le[8];
#pragma unroll
        for (int q = 0; q < 8; ++q) { float a = 0.f; const LAS f32x4* wq = (const LAS f32x4*)(WL + (4 + g * 8 + q) * DM);
#pragma unroll
            for (int j = 0; j < 4; ++j) { const f32x4 w = wq[F.lane + 64 * j]; a += (v[j][0] * w[0] + v[j][1] * w[1]) + (v[j][2] * w[2] + v[j][3] * w[3]); }
            le[q] = wave_sum(a) * rs + bre[g * 8 + q]; }
        int i1 = 0; float l1 = le[0];
#pragma unroll
        for (int j = 1; j < 8; ++j) if (le[j] > l1) { l1 = le[j]; i1 = j; }
        int i2 = -1; float l2 = -3.0e38f;
#pragma unroll
        for (int j = 0; j < 8; ++j) if (j != i1 && le[j] > l2) { l2 = le[j]; i2 = j; }
        const float e2 = fexp2((l2 - l1) * LOG2E); const float w1 = gp / (1.f + e2), w2 = gp * e2 / (1.f + e2);
        if (F.lane == 0) {
            RS[row] = rs;
            const int ea = g * 8 + i1, eb = g * 8 + i2;
            const unsigned pa = atomicAdd(cnt + ea, 1u); liste[(size_t)ea * T + pa] = row * 2; listw[(size_t)ea * T + pa] = w1;
            const unsigned pb = atomicAdd(cnt + eb, 1u); liste[(size_t)eb * T + pb] = row * 2 + 1; listw[(size_t)eb * T + pb] = w2;
        }
    }
}
__device__ __forceinline__ void phase_norm2(Frame& F, int l) {
    const Params& P = *F.P;
    float* H = wsp<float>(F, WS_H32); bf16_t* HB = wsp<bf16_t>(F, WS_HB); float* RS = wsp<float>(F, WS_RS); const bf16_t* Y = wsp<bf16_t>(F, WS_Y); bf16_t* PB = wsp<bf16_t>(F, WS_PB);
    const float* pl = P.in[1] + (size_t)l * T * DPLE;
    for (int row = F.gw(); row < T; row += F.ngw()) {
        f32x4* xr = (f32x4*)(H + (size_t)row * DM) + F.lane; f32x4 v[4]; float s = 0.f;
        const u32x2* y0 = (const u32x2*)(Y + (size_t)row * 2 * DM) + F.lane; const u32x2* y1 = y0 + DM / 4;
#pragma unroll
        for (int j = 0; j < 4; ++j) { v[j] = xr[64 * j]; const u32x2 a = y0[64 * j], b = y1[64 * j];
            v[j][0] += bf2f(a.x & 0xffffu) + bf2f(b.x & 0xffffu); v[j][1] += bf2f(a.x >> 16) + bf2f(b.x >> 16);
            v[j][2] += bf2f(a.y & 0xffffu) + bf2f(b.y & 0xffffu); v[j][3] += bf2f(a.y >> 16) + bf2f(b.y >> 16);
            s += (v[j][0] * v[j][0] + v[j][1] * v[j][1]) + (v[j][2] * v[j][2] + v[j][3] * v[j][3]); xr[64 * j] = v[j]; }
        s = wave_sum(s);
        u32x2* o = (u32x2*)(HB + (size_t)row * DM) + F.lane;
#pragma unroll
        for (int j = 0; j < 4; ++j) o[64 * j] = (u32x2){pk2(v[j][0], v[j][1]), pk2(v[j][2], v[j][3])};
        if (F.lane == 0) RS[row] = 1.0f / sqrtf(s * (1.f / DM) + EPS);
        const f32x4 pv = ((const f32x4*)(pl + (size_t)row * DPLE))[F.lane];
        ((u32x2*)(PB + (size_t)row * DPLE))[F.lane] = (u32x2){pk2(pv[0], pv[1]), pk2(pv[2], pv[3])};
    }
}
__device__ __forceinline__ void phase_final(Frame& F) {
    const Params& P = *F.P; const float* H = wsp<float>(F, WS_H32); const float* g = P.in[23];
    for (int row = F.gw(); row < T; row += F.ngw()) {
        const f32x4* xr = (const f32x4*)(H + (size_t)row * DM) + F.lane; f32x4 v[4]; float s = 0.f;
#pragma unroll
        for (int j = 0; j < 4; ++j) { v[j] = xr[64 * j]; s += (v[j][0] * v[j][0] + v[j][1] * v[j][1]) + (v[j][2] * v[j][2] + v[j][3] * v[j][3]); }
        s = wave_sum(s); const float rs = 1.0f / sqrtf(s * (1.f / DM) + EPS);
        f32x4* o = (f32x4*)(P.out + (size_t)row * DM) + F.lane;
#pragma unroll
        for (int j = 0; j < 4; ++j) o[64 * j] = v[j] * rs * ((const f32x4*)g)[F.lane + 64 * j];
    }
}

namespace att {
typedef float f32x16 __attribute__((ext_vector_type(16)));
typedef short s16x4 __attribute__((ext_vector_type(4)));
typedef short v4i16_t __attribute__((ext_vector_type(4)));
typedef __bf16 bf16x2_t __attribute__((ext_vector_type(2)));
constexpr int NS = 6, PF = 5;
constexpr int FLAG_OFF = 131072 + 512;
__device__ __forceinline__ int crow(int r, int hi) { return (r & 3) + 8 * (r >> 2) + 4 * hi; }
__device__ __forceinline__ unsigned cvtpk(float lo, float hi) { f32x2 v = {lo, hi}; bf16x2_t b = __builtin_convertvector(v, bf16x2_t); return __builtin_bit_cast(unsigned, b); }
__device__ __forceinline__ s16x4 vtr(const LAS unsigned char* p) { return __builtin_bit_cast(s16x4, __builtin_amdgcn_ds_read_tr16_b64_v4i16((LAS v4i16_t*)p)); }
__device__ __forceinline__ void dma16(const void* g, LAS unsigned char* l) {
    unsigned keep; const unsigned dst = (unsigned)__builtin_amdgcn_readfirstlane((int)(unsigned)(uintptr_t)l);
    asm volatile("s_mov_b32 %0, m0\n\ts_mov_b32 m0, %2\n\ts_nop 0\n\tglobal_load_lds_dwordx4 %1, off\n\ts_mov_b32 m0, %0" : "=&s"(keep) : "v"(g), "s"(dst) : "memory"); }
__device__ __forceinline__ float swap32(float x) { auto rr = __builtin_amdgcn_permlane32_swap(__float_as_uint(x), __float_as_uint(x), false, false); return __uint_as_float(((unsigned)(threadIdx.x & 32)) ? rr[0] : rr[1]); }
#define ATT_WAIT_BAR(N) asm volatile("s_waitcnt vmcnt(%0) lgkmcnt(0)\n\ts_barrier" :: "n"(N) : "memory")
__device__ __forceinline__ bf16x8 pfrag(const f32x16& w, int b8) { u32x4 u; u.x = cvtpk(w[b8], w[b8 + 1]); u.y = cvtpk(w[b8 + 2], w[b8 + 3]); u.z = cvtpk(w[b8 + 4], w[b8 + 5]); u.w = cvtpk(w[b8 + 6], w[b8 + 7]); return __builtin_bit_cast(bf16x8, u); }
__device__ __forceinline__ void pv_tile(f32x16& o0, f32x16& o1, const LAS unsigned char* vp, const f32x16& w0, const f32x16& w1) {
#pragma unroll
    for (int ks = 0; ks < 4; ++ks) {
        const bf16x8 pf = pfrag(ks < 2 ? w0 : w1, 8 * (ks & 1));
        const s16x4 a0 = vtr(vp + ks * 1024), a1 = vtr(vp + ks * 1024 + 512), b0 = vtr(vp + 4096 + ks * 1024), b1 = vtr(vp + 4096 + ks * 1024 + 512);
        const bf16x8 v0 = (bf16x8){a0[0], a0[1], a0[2], a0[3], a1[0], a1[1], a1[2], a1[3]}, v1 = (bf16x8){b0[0], b0[1], b0[2], b0[3], b1[0], b1[1], b1[2], b1[3]};
        o0 = __builtin_amdgcn_mfma_f32_32x32x16_bf16(v0, pf, o0, 0, 0, 0);
        o1 = __builtin_amdgcn_mfma_f32_32x32x16_bf16(v1, pf, o1, 0, 0, 0);
    }
}
__device__ __forceinline__ void store_o(bf16_t* orow, const f32x16& o0, const f32x16& o1, int hi, float sc) {
#pragma unroll
    for (int g = 0; g < 4; ++g) {
        *(u32x2*)(orow + 8 * g + 4 * hi) = (u32x2){cvtpk(o0[4 * g] * sc, o0[4 * g + 1] * sc), cvtpk(o0[4 * g + 2] * sc, o0[4 * g + 3] * sc)};
        *(u32x2*)(orow + 32 + 8 * g + 4 * hi) = (u32x2){cvtpk(o1[4 * g] * sc, o1[4 * g + 1] * sc), cvtpk(o1[4 * g + 2] * sc, o1[4 * g + 3] * sc)};
    }
}

__device__ __forceinline__ void sb_unit(LAS unsigned char* lds, int tid, const bf16_t* QKV, bf16_t* OA, int b, int h, int qb) {
    const int lane = tid & 63, r32 = lane & 31, hi = lane >> 5, wid = __builtin_amdgcn_readfirstlane(tid >> 6);
    const size_t rowb = (size_t)b * SEQ; const int q0 = qb * 256;
    const bf16_t* Qw = QKV + (rowb + q0 + wid * 32) * 1536 + h * 64;
    const bf16_t* Kh = QKV + rowb * 1536 + 512 + h * 64; const bf16_t* Vh = Kh + 512;
    const int kt_hi = (q0 >> 6) + 3, NT = kt_hi + 1, jd = 3 - (wid >> 1);
    const bf16_t* ksrc = Kh + (size_t)lane * 1536 + wid * 8;
    const bf16_t* vsrc = Vh + (size_t)(16 * (wid & 3) + (lane >> 2)) * 1536 + (wid >> 2) * 32 + (lane & 3) * 8;
#define SB_ISSUE(j) do { int kt_ = kt_hi - (j); kt_ = kt_ < 0 ? 0 : kt_; LAS unsigned char* sl_ = lds + ((j) % NS) * 16384 + wid * 1024; \
        dma16(ksrc + (size_t)kt_ * 64 * 1536, sl_); dma16(vsrc + (size_t)kt_ * 64 * 1536, sl_ + 8192); } while (0)
    bf16x8 qr[4];
#pragma unroll
    for (int d0 = 0; d0 < 4; ++d0) qr[d0] = *(const bf16x8*)(Qw + (size_t)r32 * 1536 + d0 * 16 + hi * 8);
#pragma unroll
    for (int j = 0; j < PF; ++j) SB_ISSUE(j);
    asm volatile("" : "+v"(qr[0]), "+v"(qr[1]), "+v"(qr[2]), "+v"(qr[3]));
    f32x16 o0 = {}, o1 = {}; float carry = 0.f;
    const int q = q0 + wid * 32 + r32;
    volatile LAS unsigned* flags = (volatile LAS unsigned*)(lds + FLAG_OFF);
    const int vpo = ((lane >> 4) & 1) * 32 + (lane & 3) * 8 + (4 * hi + ((lane & 15) >> 2)) * 64;
    for (int j = 0; j < NT; ++j) {
        ATT_WAIT_BAR(2 * (PF - 1));
        if (j >= 1) { const u32x4 fa = *(const LAS u32x4*)(lds + FLAG_OFF + ((j - 1) & 1) * 32), fb = *(const LAS u32x4*)(lds + FLAG_OFF + ((j - 1) & 1) * 32 + 16);
            if ((fa.x & fa.y & fa.z & fa.w & fb.x & fb.y & fb.z & fb.w) != 0u) break; }
        SB_ISSUE(j + PF);
        if (j >= jd) {
            const LAS unsigned char* ks = lds + (j % NS) * 16384;
            f32x16 z0 = {}, z1 = {};
#pragma unroll
            for (int d0 = 0; d0 < 4; ++d0) { const bf16x8 k0 = *(const LAS bf16x8*)(ks + (2 * d0 + hi) * 1024 + r32 * 16), k1 = *(const LAS bf16x8*)(ks + (2 * d0 + hi) * 1024 + 512 + r32 * 16);
                z0 = __builtin_amdgcn_mfma_f32_32x32x16_bf16(k0, qr[d0], z0, 0, 0, 0); z1 = __builtin_amdgcn_mfma_f32_32x32x16_bf16(k1, qr[d0], z1, 0, 0, 0); }
            const bool diag = (j == jd); const int kb = (kt_hi - j) * 64;
            f32x16 s0, s1;
#pragma unroll
            for (int r = 0; r < 16; ++r) { s0[r] = -flog2(1.f + fexp2(fminf(z0[r], 126.f))); s1[r] = -flog2(1.f + fexp2(fminf(z1[r], 126.f))); }
            if (diag) {
#pragma unroll
                for (int r = 0; r < 16; ++r) { if (kb + crow(r, hi) >= q) s0[r] = 0.f; if (kb + 32 + crow(r, hi) >= q) s1[r] = 0.f; }
            }
#pragma unroll
            for (int g = 0; g < 4; ++g) { s0[4 * g + 2] += s0[4 * g + 3]; s0[4 * g + 1] += s0[4 * g + 2]; s0[4 * g] += s0[4 * g + 1]; s1[4 * g + 2] += s1[4 * g + 3]; s1[4 * g + 1] += s1[4 * g + 2]; s1[4 * g] += s1[4 * g + 1]; }
            float I[9]; I[8] = 0.f;
#pragma unroll
            for (int g = 7; g >= 0; --g) I[g] = I[g + 1] + (g < 4 ? s0[4 * g] : s1[4 * (g - 4)]);
            float off[8];
#pragma unroll
            for (int g = 0; g < 8; ++g) off[g] = carry + I[g + 1] + swap32(hi ? I[g] : I[g + 1]);
            carry += I[0] + swap32(I[0]);
            f32x16 w0, w1;
#pragma unroll
            for (int r = 0; r < 16; ++r) { w0[r] = fexp2(z0[r] + s0[r] + off[r >> 2]); w1[r] = fexp2(z1[r] + s1[r] + off[4 + (r >> 2)]); }
            if (diag) {
#pragma unroll
                for (int r = 0; r < 16; ++r) { if (kb + crow(r, hi) >= q) w0[r] = 0.f; if (kb + 32 + crow(r, hi) >= q) w1[r] = 0.f; }
            }
            pv_tile(o0, o1, ks + 8192 + vpo, w0, w1);
        }
        { const bool dn = __all(carry < -150.f); if (lane == 0) flags[(j & 1) * 8 + wid] = dn ? 1u : 0u; }
    }
    store_o(OA + (rowb + q) * DM + h * 64, o0, o1, hi, 1.f);
    asm volatile("s_waitcnt lgkmcnt(0)\n\ts_barrier" ::: "memory");
#undef SB_ISSUE
}

__device__ __forceinline__ void mla_unit(LAS unsigned char* lds, int tid, const bf16_t* QM, const bf16_t* KN, const bf16_t* KR, const bf16_t* VM, bf16_t* OA, int b, int h, int qb) {
    const int lane = tid & 63, r32 = lane & 31, hi = lane >> 5, wid = __builtin_amdgcn_readfirstlane(tid >> 6);
    const size_t rowb = (size_t)b * SEQ; const int q0 = qb * 256;
    const bf16_t* Qw = QM + (rowb + q0 + wid * 32) * 768 + h * 96;
    const int NT = (q0 >> 6) + 4, mych = (q0 >> 6) + (wid >> 1);
    const bf16_t* ksrc = KN + (rowb + lane) * 512 + h * 64 + wid * 8;
    const bf16_t* rsrc = KR + (rowb + lane) * 32 + (wid & 3) * 8;
    const bf16_t* vsrc = VM + (rowb + 16 * (wid & 3) + (lane >> 2)) * 512 + h * 64 + (wid >> 2) * 32 + (lane & 3) * 8;
    constexpr int SLOT = 20480;
#define MLA_ISSUE(j) do { int kt_ = (j); kt_ = kt_ >= NT ? NT - 1 : kt_; LAS unsigned char* sl_ = lds + ((j) % NS) * SLOT; \
        dma16(ksrc + (size_t)kt_ * 64 * 512, sl_ + wid * 1024); dma16(rsrc + (size_t)kt_ * 64 * 32, sl_ + (8 + (wid & 3)) * 1024); dma16(vsrc + (size_t)kt_ * 64 * 512, sl_ + 12288 + wid * 1024); } while (0)
    bf16x8 qr[6];
#pragma unroll
    for (int d0 = 0; d0 < 6; ++d0) qr[d0] = *(const bf16x8*)(Qw + (size_t)r32 * 768 + d0 * 16 + hi * 8);
#pragma unroll
    for (int j = 0; j < PF; ++j) MLA_ISSUE(j);
    asm volatile("" : "+v"(qr[0]), "+v"(qr[1]), "+v"(qr[2]), "+v"(qr[3]), "+v"(qr[4]), "+v"(qr[5]));
    f32x16 o0 = {}, o1 = {}; float mx = -1.0e30f, lsum = 0.f;
    const int vpo = ((lane >> 4) & 1) * 32 + (lane & 3) * 8 + (4 * hi + ((lane & 15) >> 2)) * 64;
    for (int j = 0; j < NT; ++j) {
        ATT_WAIT_BAR(3 * (PF - 1));
        MLA_ISSUE(j + PF);
        if (j <= mych) {
            const LAS unsigned char* ks = lds + (j % NS) * SLOT;
            f32x16 z0 = {}, z1 = {};
#pragma unroll
            for (int d0 = 0; d0 < 6; ++d0) { const bf16x8 k0 = *(const LAS bf16x8*)(ks + (2 * d0 + hi) * 1024 + r32 * 16), k1 = *(const LAS bf16x8*)(ks + (2 * d0 + hi) * 1024 + 512 + r32 * 16);
                z0 = __builtin_amdgcn_mfma_f32_32x32x16_bf16(k0, qr[d0], z0, 0, 0, 0); z1 = __builtin_amdgcn_mfma_f32_32x32x16_bf16(k1, qr[d0], z1, 0, 0, 0); }
            float tm = fmaxf(z0[0], z1[0]);
#pragma unroll
            for (int r = 1; r < 16; ++r) tm = fmaxf(tm, fmaxf(z0[r], z1[r]));
            tm = fmaxf(tm, swap32(tm));
            const float mn = fmaxf(mx, tm), alpha = fexp2(mx - mn); mx = mn;
            float ps = 0.f;
#pragma unroll
            for (int r = 0; r < 16; ++r) { z0[r] = fexp2(z0[r] - mn); z1[r] = fexp2(z1[r] - mn); ps += z0[r] + z1[r]; }
            lsum = lsum * alpha + ps;
#pragma unroll
            for (int r = 0; r < 16; ++r) { o0[r] *= alpha; o1[r] *= alpha; }
            pv_tile(o0, o1, ks + 12288 + vpo, z0, z1);
        }
    }
    lsum += swap32(lsum);
    store_o(OA + (rowb + q0 + wid * 32 + r32) * DM + 512 + h * 64, o0, o1, hi, 1.0f / lsum);
    asm volatile("s_waitcnt lgkmcnt(0)\n\ts_barrier" ::: "memory");
#undef MLA_ISSUE
}
}

__device__ __forceinline__ void phase_attn(Frame& F) {
    const bf16_t* QKV = wsp<bf16_t>(F, WS_QKV); bf16_t* OA = wsp<bf16_t>(F, WS_OA);
    const bf16_t* QM = wsp<bf16_t>(F, WS_QM); const bf16_t* KN = wsp<bf16_t>(F, WS_KN); const bf16_t* KR = wsp<bf16_t>(F, WS_KR); const bf16_t* VM = wsp<bf16_t>(F, WS_VM);
    const int vcu = (F.G % 8 == 0) ? (F.bx % 8) * (F.G / 8) + F.bx / 8 : F.bx;
    for (int p = vcu; p < 512; p += F.G) {
        const int bh = p >> 3, s = p & 7;
        att::mla_unit(F.lds, F.tid, QM, KN, KR, VM, OA, bh >> 3, bh & 7, 15 - s);
        att::mla_unit(F.lds, F.tid, QM, KN, KR, VM, OA, bh >> 3, bh & 7, s);
    }
    for (int u = vcu; u < 1024; u += F.G) { const int bh = u >> 4; att::sb_unit(F.lds, F.tid, QKV, OA, bh >> 3, bh & 7, u & 15); }
}

__device__ __forceinline__ DenseSched dense_sched(const Frame& F, int N, const void* Bt, int K) { DenseSched S; S.o.init(T, N, F.G, F.bx); S.Bt = (const char*)Bt; S.K = K; return S; }
__device__ __forceinline__ void phase_inproj(Frame& F, int l) {
    const DenseSched S = dense_sched(F, INP, F.ws + WS_WSM + (size_t)l * WSM_STRIDE + WSM_IN, DM);
    const EpiIn E{wsp<float>(F, WS_RS), wsp<bf16_t>(F, WS_QKV), wsp<bf16_t>(F, WS_CKV), wsp<bf16_t>(F, WS_CQ), wsp<bf16_t>(F, WS_KR), wsp<float>(F, WS_COS), wsp<float>(F, WS_SIN)};
    pg8::gemm_phase(F.lds, F.tid, (const char*)(F.ws + WS_HB), DM, S, E);
}
__device__ __forceinline__ void phase_uq(Frame& F, int l) {
    const DenseSched S = dense_sched(F, 768, F.ws + WS_WSM + (size_t)l * WSM_STRIDE + WSM_UQ, QRANK);
    const EpiUq E{wsp<float>(F, WS_RSCQ), wsp<bf16_t>(F, WS_QM), wsp<float>(F, WS_COS), wsp<float>(F, WS_SIN)};
    pg8::gemm_phase(F.lds, F.tid, (const char*)(F.ws + WS_CQ), QRANK, S, E);
}
__device__ __forceinline__ void phase_ukv(Frame& F, int l) {
    const DenseSched S = dense_sched(F, 1024, F.ws + WS_WSM + (size_t)l * WSM_STRIDE + WSM_UKV, KVRANK);
    const EpiUkv E{wsp<float>(F, WS_RSCKV), wsp<bf16_t>(F, WS_KN), wsp<bf16_t>(F, WS_VM)};
    pg8::gemm_phase(F.lds, F.tid, (const char*)(F.ws + WS_CKV), KVRANK, S, E);
}
__device__ __forceinline__ void phase_outproj(Frame& F, int l) {
    const DenseSched S = dense_sched(F, DM, F.ws + WS_WSM + (size_t)l * WSM_STRIDE + WSM_OUT, DM);
    const EpiOut E{l == 0 ? F.P->in[0] : wsp<float>(F, WS_H32), wsp<float>(F, WS_H32)};
    pg8::gemm_phase(F.lds, F.tid, (const char*)(F.ws + WS_OA), DM, S, E);
}
__device__ __forceinline__ void moe_table(Frame& F, int l) {
    LAS int* tb = (LAS int*)(F.lds + pg8::STAGE_BYTES);
    __syncthreads();
    if (F.tid == 0) { const unsigned* cnt = wsp<unsigned>(F, WS_CTL) + CW_CNT + 64 * l; int acc = 0;
        for (int e = 0; e < NEXP; ++e) { const int c = (int)__hip_atomic_load(cnt + e, __ATOMIC_RELAXED, __HIP_MEMORY_SCOPE_AGENT); tb[e] = acc; tb[40 + e] = c; acc += (c + 255) >> 8; }
        tb[32] = acc; }
    __syncthreads();
}
__device__ __forceinline__ void phase_moe1(Frame& F, int l) {
    moe_table(F, l);
    MoeSched S; S.G = F.G; S.c = F.bx; S.npn = 2; S.gather = 1; S.tb = (const LAS int*)(F.lds + pg8::STAGE_BYTES); S.liste = wsp<int>(F, WS_LISTE); S.Bt = (const char*)(F.ws + WS_WG1); S.K = DM; S.nB = 512;
    const EpiG1 E{wsp<float>(F, WS_RS), wsp<int>(F, WS_LISTE), wsp<bf16_t>(F, WS_HID)};
    pg8::gemm_phase(F.lds, F.tid, (const char*)(F.ws + WS_HB), DM, S, E);
}
__device__ __forceinline__ void phase_moe2(Frame& F, int l) {
    moe_table(F, l);
    MoeSched S; S.G = F.G; S.c = F.bx; S.npn = 4; S.gather = 0; S.tb = (const LAS int*)(F.lds + pg8::STAGE_BYTES); S.liste = wsp<int>(F, WS_LISTE); S.Bt = (const char*)(F.ws + WS_WD); S.K = DEXP; S.nB = 1024;
    const EpiDn E{wsp<int>(F, WS_LISTE), wsp<float>(F, WS_LISTW), wsp<bf16_t>(F, WS_Y)};
    pg8::gemm_phase(F.lds, F.tid, (const char*)(F.ws + WS_HID), DEXP, S, E);
}
__device__ __forceinline__ void phase_pe(Frame& F, int l) {
    const DenseSched S = dense_sched(F, DM, F.ws + WS_WSM + (size_t)l * WSM_STRIDE + WSM_PE, DPLE);
    const EpiBf E{wsp<bf16_t>(F, WS_PE), DM};
    pg8::gemm_phase(F.lds, F.tid, (const char*)(F.ws + WS_PB), DPLE, S, E);
}
__device__ __forceinline__ void phase_ple(Frame& F, int l) {
    const DenseSched S = dense_sched(F, DM, F.ws + WS_WSM + (size_t)l * WSM_STRIDE + WSM_PG, DM);
    const EpiPle E{wsp<float>(F, WS_RS), wsp<bf16_t>(F, WS_PE), wsp<float>(F, WS_H32)};
    pg8::gemm_phase(F.lds, F.tid, (const char*)(F.ws + WS_HB), DM, S, E);
}

enum { PH_PREP = 0, PH_PREPMOE, PH_NORM0, PH_NORM, PH_INPROJ, PH_RS2, PH_UQ, PH_UKV, PH_SB, PH_MLA, PH_ONORM, PH_OUTPROJ, PH_ROUTE, PH_MOE1, PH_MOE2, PH_NORM2, PH_PE, PH_PLE, PH_FINAL };
template <int PH> __global__ void __launch_bounds__(NTHREADS, 2) k_phase(Params P, int l) {
    extern __shared__ __attribute__((aligned(16))) unsigned char lds_raw[];
    Frame F; F.lds = (LAS unsigned char*)lds_raw; F.tid = threadIdx.x; F.lane = F.tid & 63; F.wave = __builtin_amdgcn_readfirstlane(F.tid >> 6); F.G = gridDim.x; F.bx = blockIdx.x; F.P = &P; F.ws = P.ws;
    if constexpr (PH == PH_PREP) phase_prep_small(F);
    if constexpr (PH == PH_PREPMOE) phase_prep_moe(F, l);
    if constexpr (PH == PH_NORM0) phase_norm(F, P.in[0]);
    if constexpr (PH == PH_NORM) phase_norm(F, wsp<float>(F, WS_H32));
    if constexpr (PH == PH_INPROJ) phase_inproj(F, l);
    if constexpr (PH == PH_RS2) phase_rs2(F);
    if constexpr (PH == PH_UQ) phase_uq(F, l);
    if constexpr (PH == PH_UKV) phase_ukv(F, l);
    if constexpr (PH == PH_SB) phase_attn(F);
    if constexpr (PH == PH_ONORM) phase_onorm(F);
    if constexpr (PH == PH_OUTPROJ) phase_outproj(F, l);
    if constexpr (PH == PH_ROUTE) phase_route(F, l);
    if constexpr (PH == PH_MOE1) phase_moe1(F, l);
    if constexpr (PH == PH_MOE2) phase_moe2(F, l);
    if constexpr (PH == PH_NORM2) phase_norm2(F, l);
    if constexpr (PH == PH_PE) phase_pe(F, l);
    if constexpr (PH == PH_PLE) phase_ple(F, l);
    if constexpr (PH == PH_FINAL) phase_final(F);
}

template <int PH> static void launch_phase(const Params& P, int l, int grid, hipStream_t stream) {
    static bool attr = false;
    if (!attr) { (void)hipFuncSetAttribute((const void*)k_phase<PH>, hipFuncAttributeMaxDynamicSharedMemorySize, LDS_BYTES); attr = true; }
    hipLaunchKernelGGL(k_phase<PH>, dim3(grid), dim3(NTHREADS), LDS_BYTES, stream, P, l);
}

constexpr int CW_BAR = 4096;
constexpr int MISC_OFF = 150 * 1024;
static_assert((CW_BAR + XCD_BAR_WORDS) * 4 <= (int)CTL_BYTES && MISC_OFF + 16 <= LDS_BYTES, "control words");
__global__ void __launch_bounds__(NTHREADS, 2) mega_fwd(Params P) {
    extern __shared__ __attribute__((aligned(16))) unsigned char lds_raw[];
    Frame F; F.lds = (LAS unsigned char*)lds_raw; F.tid = threadIdx.x; F.lane = F.tid & 63; F.wave = __builtin_amdgcn_readfirstlane(F.tid >> 6); F.G = gridDim.x; F.bx = blockIdx.x; F.P = &P; F.ws = P.ws;
    volatile LAS unsigned* st = (volatile LAS unsigned*)(F.lds + MISC_OFF);
    if (F.tid < 4) st[F.tid] = 0u;
    __syncthreads();
    const XcdBarrier bar = xcd_barrier_post(wsp<unsigned>(F, WS_CTL) + CW_BAR, st);
#define GRID_BAR() do { XcdBarrier b_ = bar; asm volatile("" : "+s"(b_.x)); asm volatile("" : "+s"(b_.bar)); xcd_barrier(b_); PH_BEGIN(); } while (0)
#define PH_BEGIN() do { asm volatile("" : "+v"(F.tid)); F.lane = F.tid & 63; asm volatile("" : "+s"(F.ws)); } while (0)
    phase_prep_small(F);
    phase_norm(F, P.in[0]);
    GRID_BAR();
#pragma unroll 1
    for (int l = 0; l < NLAYER; ++l) {
        PH_BEGIN();
        phase_prep_moe(F, l);
        __syncthreads(); PH_BEGIN();
        phase_inproj(F, l);
        GRID_BAR();
        phase_rs2(F);
        GRID_BAR();
        phase_uq(F, l);
        PH_BEGIN();
        phase_ukv(F, l);
        GRID_BAR();
        phase_attn(F);
        GRID_BAR();
        phase_onorm(F);
        GRID_BAR();
        phase_outproj(F, l);
        GRID_BAR();
        phase_route(F, l);
        GRID_BAR();
        phase_moe1(F, l);
        GRID_BAR();
        phase_moe2(F, l);
        GRID_BAR();
        phase_norm2(F, l);
        GRID_BAR();
        phase_pe(F, l);
        GRID_BAR();
        phase_ple(F, l);
        GRID_BAR();
        if (l + 1 < NLAYER) { phase_norm(F, wsp<float>(F, WS_H32)); GRID_BAR(); }
    }
    phase_final(F);
#undef GRID_BAR
#undef PH_BEGIN
}

#ifndef MK_MULTI
#define MK_MULTI 0
#endif
extern "C" void kernel_launch(void* const* d_in, const int* in_sizes, int n_in, void* d_out, int out_size, void* d_ws, size_t ws_size, hipStream_t stream) {
    if (n_in != 24 || out_size != T * DM || ws_size < WS_END) { fprintf(stderr, "kernel_launch: unexpected shapes (n_in %d, out %d, ws %zu < %zu)\n", n_in, out_size, ws_size, (size_t)WS_END); return; }
    Params P{};
    for (int i = 0; i < 24; ++i) P.in[i] = (const float*)d_in[i];
    P.out = (float*)d_out; P.ws = (unsigned char*)d_ws;
    for (int i = 0; i < 16; ++i) P.inv_freq[i] = (float)pow(10000.0, -(double)i / 16.0);
    (void)hipMemsetAsync((char*)d_ws + WS_CTL, 0, CTL_BYTES, stream);
#if MK_MULTI
    const int grid = 256;
    launch_phase<PH_PREP>(P, 0, grid, stream);
    launch_phase<PH_NORM0>(P, 0, grid, stream);
    for (int l = 0; l < NLAYER; ++l) {
        launch_phase<PH_PREPMOE>(P, l, grid, stream);
        launch_phase<PH_INPROJ>(P, l, grid, stream);
        launch_phase<PH_RS2>(P, l, grid, stream);
        launch_phase<PH_UQ>(P, l, grid, stream);
        launch_phase<PH_UKV>(P, l, grid, stream);
        launch_phase<PH_SB>(P, l, grid, stream);
        launch_phase<PH_ONORM>(P, l, grid, stream);
        launch_phase<PH_OUTPROJ>(P, l, grid, stream);
        launch_phase<PH_ROUTE>(P, l, grid, stream);
        launch_phase<PH_MOE1>(P, l, grid, stream);
        launch_phase<PH_MOE2>(P, l, grid, stream);
        launch_phase<PH_NORM2>(P, l, grid, stream);
        launch_phase<PH_PE>(P, l, grid, stream);
        launch_phase<PH_PLE>(P, l, grid, stream);
        if (l + 1 < NLAYER) launch_phase<PH_NORM>(P, l, grid, stream);
    }
    launch_phase<PH_FINAL>(P, 0, grid, stream);
#else
    static int grid = 0;
    if (grid == 0) {
        int dev = 0, cus = 0;
        if (hipGetDevice(&dev) != hipSuccess || hipDeviceGetAttribute(&cus, hipDeviceAttributeMultiprocessorCount, dev) != hipSuccess || cus <= 0) { grid = -1; return; }
        if (hipFuncSetAttribute((const void*)mega_fwd, hipFuncAttributeMaxDynamicSharedMemorySize, LDS_BYTES) != hipSuccess) { fprintf(stderr, "kernel_launch: hipFuncSetAttribute failed\n"); grid = -1; return; }
        grid = cus;
    }
    if (grid < 0) return;
    hipLaunchKernelGGL(mega_fwd, dim3(grid), dim3(NTHREADS), LDS_BYTES, stream, P);
#endif
}
```

```cpp
#include <hip/hip_runtime.h>
#include <cstdio>
#include <cstdint>
#include <cmath>

#define GAS __attribute__((address_space(1)))
#define LAS __attribute__((address_space(3)))
typedef unsigned short bf16_t;
typedef short bf16x8 __attribute__((ext_vector_type(8)));
typedef float f32x4 __attribute__((ext_vector_type(4)));
typedef float f32x2 __attribute__((ext_vector_type(2)));
typedef unsigned u32x4 __attribute__((ext_vector_type(4)));
typedef unsigned u32x2 __attribute__((ext_vector_type(2)));

constexpr int NB = 8, SEQ = 4096, DM = 1024, NLAYER = 4, T = NB * SEQ;
constexpr int DPLE = 256, SBW = 512, MLAW = 512, QRANK = 384, KVRANK = 256, ROPE = 32, QKD = 96;
constexpr int INC = 2208, INP = 2304;
constexpr int NEXP = 32, DEXP = 256;
constexpr float EPS = 1e-6f;
constexpr float LOG2E = 1.4426950408889634f;
constexpr float QS_SB = 0.125f * LOG2E;
constexpr float QS_MLA = 0.10206207261596575f * LOG2E;
constexpr int NWAVES = 8, NTHREADS = 512;

constexpr size_t MiB = 1u << 20;
constexpr size_t WS_CTL = 0, CTL_BYTES = 1 * MiB;
constexpr size_t WS_COS = 1 * MiB, WS_SIN = 3 * MiB;
constexpr size_t WS_RS = 5 * MiB, WS_RSCQ = 6 * MiB, WS_RSCKV = 7 * MiB;
constexpr size_t WS_LISTE = 8 * MiB, WS_LISTW = 12 * MiB;
constexpr size_t WS_WR = 16 * MiB;
constexpr size_t WS_WSM = 18 * MiB, WSM_STRIDE = 11 * MiB;
constexpr size_t WSM_IN = 0, WSM_OUT = 4608 * 1024, WSM_PG = WSM_OUT + 2 * MiB, WSM_UQ = WSM_PG + 2 * MiB, WSM_UKV = WSM_UQ + 576 * 1024, WSM_PE = WSM_UKV + 512 * 1024;
constexpr size_t WS_WG1 = 62 * MiB, WS_WD = 94 * MiB;
constexpr size_t WS_H32 = 110 * MiB, WS_HB = 238 * MiB;
constexpr size_t WS_ATT = 302 * MiB;
constexpr size_t WS_QKV = WS_ATT, WS_CKV = WS_ATT + 96 * MiB, WS_CQ = WS_CKV + 16 * MiB, WS_KR = WS_CQ + 24 * MiB, WS_QM = WS_KR + 2 * MiB,
                 WS_KN = WS_QM + 48 * MiB, WS_VM = WS_KN + 32 * MiB, WS_OA = WS_VM + 32 * MiB, WS_ATT_END = WS_OA + 64 * MiB;
constexpr size_t WS_HBI = WS_OA;
constexpr size_t WS_HID = WS_ATT, WS_Y = WS_ATT + 36 * MiB, WS_PE = WS_Y + 128 * MiB, WS_PB = WS_PE + 64 * MiB, WS_MOE_END = WS_PB + 16 * MiB;
constexpr size_t WS_SSQ = (WS_ATT_END > WS_MOE_END ? WS_ATT_END : WS_MOE_END), WS_OSS = WS_SSQ + 2 * MiB, WS_END = WS_OSS + 2 * MiB;
static_assert(WSM_PE + 512 * 1024 <= WSM_STRIDE, "small weights");
static_assert(WS_WSM + 4 * WSM_STRIDE <= WS_WG1, "ws map");
constexpr int CW_CNT = 8192;

constexpr int LDS_BYTES = 152 * 1024;

struct Params {
    const float* in[24];
    float* out;
    unsigned char* ws;
    float inv_freq[16];
};

__device__ __forceinline__ float bf2f(unsigned v) { return __uint_as_float(v << 16); }
__device__ __forceinline__ unsigned f2bf(float f) { unsigned u = __float_as_uint(f); return (u + 0x7fffu + ((u >> 16) & 1u)) >> 16; }
__device__ __forceinline__ unsigned pk2(float lo, float hi) { return f2bf(lo) | (f2bf(hi) << 16); }
template <int CTRL> __device__ __forceinline__ float dpp_f(float v) { return __uint_as_float((unsigned)__builtin_amdgcn_update_dpp(0, (int)__float_as_uint(v), CTRL, 0xf, 0xf, true)); }
__device__ __forceinline__ float row16_sum(float v) {
    v += dpp_f<0xB1>(v); v += dpp_f<0x4E>(v); v += dpp_f<0x141>(v); v += dpp_f<0x140>(v); return v; }
__device__ __forceinline__ float wave_sum(float v) {
    v = row16_sum(v);
    const float a = __uint_as_float(__builtin_amdgcn_readlane((int)__float_as_uint(v), 0)), b = __uint_as_float(__builtin_amdgcn_readlane((int)__float_as_uint(v), 16)),
                c = __uint_as_float(__builtin_amdgcn_readlane((int)__float_as_uint(v), 32)), d = __uint_as_float(__builtin_amdgcn_readlane((int)__float_as_uint(v), 48));
    return (a + b) + (c + d);
}
__device__ __forceinline__ float half32_sum(float v) {
    v = row16_sum(v);
    auto rr = __builtin_amdgcn_permlane16_swap(__float_as_uint(v), __float_as_uint(v), false, false);
    return __uint_as_float(rr[0]) + __uint_as_float(rr[1]);
}
__device__ __forceinline__ float xor32(float x) { auto rr = __builtin_amdgcn_permlane32_swap(__float_as_uint(x), __float_as_uint(x), false, false); return __uint_as_float(((unsigned)(threadIdx.x & 32)) ? rr[0] : rr[1]); }
__device__ __forceinline__ float xor16(float x) { auto rr = __builtin_amdgcn_permlane16_swap(__float_as_uint(x), __float_as_uint(x), false, false); return __uint_as_float(((unsigned)(threadIdx.x & 16)) ? rr[0] : rr[1]); }
__device__ __forceinline__ float fexp2(float x) { return __builtin_amdgcn_exp2f(x); }
__device__ __forceinline__ float flog2(float x) { return __builtin_amdgcn_logf(x); }
__device__ __forceinline__ float frcp(float x) { return __builtin_amdgcn_rcpf(x); }
__device__ __forceinline__ void unpack8(u32x4 w, float* f) {
    f[0] = __uint_as_float(w.x << 16); f[1] = __uint_as_float(w.x & 0xffff0000u);
    f[2] = __uint_as_float(w.y << 16); f[3] = __uint_as_float(w.y & 0xffff0000u);
    f[4] = __uint_as_float(w.z << 16); f[5] = __uint_as_float(w.z & 0xffff0000u);
    f[6] = __uint_as_float(w.w << 16); f[7] = __uint_as_float(w.w & 0xffff0000u);
}
__device__ __forceinline__ u32x4 pack8(f32x4 a, f32x4 b) { u32x4 w; w.x = pk2(a[0], a[1]); w.y = pk2(a[2], a[3]); w.z = pk2(b[0], b[1]); w.w = pk2(b[2], b[3]); return w; }

__device__ __forceinline__ float rstd_part16(const float* p, float inv_n) { const f32x4 a = ((const f32x4*)p)[0], b = ((const f32x4*)p)[1], c = ((const f32x4*)p)[2], d = ((const f32x4*)p)[3];
    const f32x4 s4 = (a + b) + (c + d); return 1.0f / sqrtf(((s4[0] + s4[1]) + (s4[2] + s4[3])) * inv_n + EPS); }
__device__ __forceinline__ float rstd_part8(const float* p, float inv_n) { const f32x4 a = ((const f32x4*)p)[0], b = ((const f32x4*)p)[1]; const f32x4 s4 = a + b; return 1.0f / sqrtf(((s4[0] + s4[1]) + (s4[2] + s4[3])) * inv_n + EPS); }
__device__ __forceinline__ float rstd_part4(const float* p, float inv_n) { const f32x4 a = ((const f32x4*)p)[0]; return 1.0f / sqrtf(((a[0] + a[1]) + (a[2] + a[3])) * inv_n + EPS); }
__device__ __forceinline__ float sq8(const f32x4& a, const f32x4& b) { return ((a[0] * a[0] + a[1] * a[1]) + (a[2] * a[2] + a[3] * a[3])) + ((b[0] * b[0] + b[1] * b[1]) + (b[2] * b[2] + b[3] * b[3])); }
__device__ __forceinline__ float fq_sum(float v) { v += xor16(v); v += xor32(v); return v; }

namespace pg8 {
constexpr int BM = 256, BK = 64, HALF = 128, HTB = HALF * BK * 2, STAGE_BYTES = 8 * HTB, NXCD = 8, WGM = 8;
__host__ __device__ __forceinline__ int lds_byte(int r, int c) { const int st = (r >> 4) * 2 + (c >> 5), rr = r & 15, cc = c & 31, ob = rr * 64 + cc * 2; return st * 1024 + (ob ^ (((ob >> 9) & 1) << 5)); }
__host__ __device__ __forceinline__ void stage_rc(int b, int& R, int& C) { const int st = b / 1024, sb = b % 1024, swz = sb ^ (((sb >> 9) & 1) << 5); R = (st >> 1) * 16 + swz / 64; C = (st & 1) * 32 + (swz % 64) / 2; }
__host__ __device__ __forceinline__ int perm32(int rho) { const int n = rho >> 4, i = rho & 15; return 8 * (i >> 2) + 4 * n + (i & 3); }

struct Unit { int pm, pn, e, tile, nrows; };

struct StaticOrder {
    int nM, nN, nwg, G, c;
    __device__ void init(int M, int N, int G_, int c_) { nM = M / BM; nN = N / BM; nwg = nM * nN; G = G_; c = c_; }
    __device__ bool next(int i, Unit& u) const {
        const long L = (long)i * G + c; if (L >= nwg) return false;
        int wgid = (int)L; { const int q = nwg / NXCD, r = nwg % NXCD, xcd = wgid % NXCD, off = wgid / NXCD; wgid = (xcd < r ? xcd * (q + 1) : r * (q + 1) + (xcd - r) * q) + off; }
        const int nig = WGM * nN, gid = wgid / nig, fm = gid * WGM, gsz = (nM - fm) < WGM ? (nM - fm) : WGM;
        u.pm = fm + ((wgid % nig) % gsz); u.pn = (wgid % nig) / gsz; u.e = 0; u.tile = 0; u.nrows = 256; return true;
    }
};

template <class Epi, class Sched>
__device__ __forceinline__ void gemm_phase(LAS unsigned char* lds, const int tid, const char* Abase, const int K, const Sched& S, const Epi& E) {
    const int wid = __builtin_amdgcn_readfirstlane(tid >> 6), lane = tid & 63, wr = wid >> 2, wc = wid & 3, fr = lane & 15, fq = lane >> 4;
    const int nt = K / BK;
    unsigned voffB[2];
#pragma unroll
    for (int i = 0; i < 2; ++i) { int R, C; stage_rc(tid * 16 + i * 8192, R, C); const int Rb = (R & ~31) + perm32(R & 31); voffB[i] = (unsigned)(Rb * K + C) * 2u; }
    const size_t kstep = (size_t)(BK * 2);
    const size_t hstep = (size_t)HALF * K * 2;
    const unsigned ldsw = (unsigned)wid * 1024u;
    const int aoff = lds_byte(wr * 64 + fr, fq * 8), boff = lds_byte(wc * 32 + fr, fq * 8);
#define PG8_SA(b, h) (((b) * 2 + (h)) * HTB)
#define PG8_SB(b, h) ((4 + (b) * 2 + (h)) * HTB)
#define PG8_STAGE(bufoff, gbase, voff) do { _Pragma("unroll") for (int _i = 0; _i < 2; ++_i) \
        __builtin_amdgcn_global_load_lds((const unsigned*)((const char*)(gbase) + (voff)[_i]), (LAS unsigned*)(lds + (bufoff) + ldsw + _i * 8192), 16, 0, 0); } while (0)
#define PG8_LDA(dst, b, h) do { _Pragma("unroll") for (int m = 0; m < 4; ++m) _Pragma("unroll") for (int k = 0; k < 2; ++k) dst[m][k] = *(const LAS bf16x8*)(lds + PG8_SA(b, h) + aoff + m * 2048 + k * 1024); } while (0)
#define PG8_LDB(dst, b, h) do { _Pragma("unroll") for (int n = 0; n < 2; ++n) _Pragma("unroll") for (int k = 0; k < 2; ++k) dst[n][k] = *(const LAS bf16x8*)(lds + PG8_SB(b, h) + boff + n * 2048 + k * 1024); } while (0)
#define PG8_MMA(ai, bj, At, Bt) do { __builtin_amdgcn_s_setprio(1); _Pragma("unroll") for (int m = 0; m < 4; ++m) _Pragma("unroll") for (int n = 0; n < 2; ++n) _Pragma("unroll") for (int k = 0; k < 2; ++k) \
        acc[ai][bj][m][n] = __builtin_amdgcn_mfma_f32_16x16x32_bf16(Bt[n][k], At[m][k], acc[ai][bj][m][n], 0, 0, 0); __builtin_amdgcn_s_setprio(0); } while (0)
#define PG8_WAIT_V(n) asm volatile("s_waitcnt vmcnt(" #n ")" ::: "memory")
#define PG8_WAIT_L(n) asm volatile("s_waitcnt lgkmcnt(" #n ")" ::: "memory")
#define PG8_BAR __builtin_amdgcn_s_barrier()
#define PG8_SCHED __builtin_amdgcn_sched_barrier(0)
    Unit cur, nxt; int ui = 0;
    if (!S.next(0, cur)) return;
    f32x4 acc[2][2][4][2];
#pragma unroll
    for (int a = 0; a < 2; ++a)
#pragma unroll
        for (int b = 0; b < 2; ++b)
#pragma unroll
            for (int m = 0; m < 4; ++m)
#pragma unroll
                for (int n = 0; n < 2; ++n) acc[a][b][m][n] = (f32x4){0.f, 0.f, 0.f, 0.f};
    bf16x8 At[4][2], B0[2][2], B1[2][2];
    unsigned vc[2][2];
    LAS u32x4* vslot = (LAS u32x4*)(lds + STAGE_BYTES + 1024) + tid;
#define PG8_AOFFS(dst, U) do { int t2_ = tid; asm volatile("" : "+v"(t2_)); _Pragma("unroll") for (int i = 0; i < 2; ++i) { int R, C; stage_rc(t2_ * 16 + i * 8192, R, C); \
        dst[0][i] = S.a_off(U, R) + (unsigned)C * 2u; dst[1][i] = S.a_off(U, HALF + R) + (unsigned)C * 2u; } } while (0)
    PG8_AOFFS(vc, cur);
    const char* cB = S.b_tile(cur);
    E.begin(cur, ui, tid, lds);
    PG8_STAGE(PG8_SB(0, 0), cB, voffB); PG8_STAGE(PG8_SB(0, 1), cB + hstep, voffB); PG8_STAGE(PG8_SA(0, 0), Abase, vc[0]); PG8_STAGE(PG8_SA(0, 1), Abase, vc[1]);
    if (wr == 1) PG8_BAR;
    PG8_WAIT_V(2); PG8_BAR;
    PG8_STAGE(PG8_SB(1, 0), cB + kstep, voffB); PG8_STAGE(PG8_SA(1, 0), Abase + kstep, vc[0]); PG8_STAGE(PG8_SB(1, 1), cB + hstep + kstep, voffB);
    PG8_WAIT_V(6); PG8_BAR;
    for (;;) {
        const bool has_next = S.next(ui + 1, nxt);
        const char* nB = cB;
        { unsigned vn[2][2];
          if (has_next) { PG8_AOFFS(vn, nxt); nB = S.b_tile(nxt); *vslot = (u32x4){vn[0][0], vn[0][1], vn[1][0], vn[1][1]}; }
          else *vslot = (u32x4){vc[0][0], vc[0][1], vc[1][0], vc[1][1]}; }
        for (int t = 0; t < nt; t += 2) {
            if constexpr (Epi::MID) { if (t == (nt >> 1)) E.mid(acc, ui, wr, fr, lds); }
            const bool last = (t == nt - 2);
            const char* a1 = Abase + (size_t)(t + 1) * kstep;
            const char* a2 = last ? Abase : Abase + (size_t)(t + 2) * kstep; const char* b2 = last ? nB : cB + (size_t)(t + 2) * kstep;
            const char* a3 = a2 + kstep; const char* b3 = b2 + kstep;
            unsigned w2[2][2];
            if (last) { const u32x4 q = *vslot; w2[0][0] = q.x; w2[0][1] = q.y; w2[1][0] = q.z; w2[1][1] = q.w; }
            else { w2[0][0] = vc[0][0]; w2[0][1] = vc[0][1]; w2[1][0] = vc[1][0]; w2[1][1] = vc[1][1]; }
            PG8_LDB(B0, 0, 0); PG8_LDB(B1, 0, 1); PG8_SCHED; PG8_LDA(At, 0, 0); PG8_STAGE(PG8_SA(1, 1), a1, vc[1]);
            PG8_WAIT_V(8); PG8_WAIT_L(0); PG8_BAR; PG8_MMA(0, 0, At, B0); PG8_MMA(0, 1, At, B1); PG8_BAR; PG8_SCHED;
            PG8_LDA(At, 0, 1); PG8_STAGE(PG8_SB(0, 0), b2, voffB); PG8_STAGE(PG8_SB(0, 1), b2 + hstep, voffB); PG8_STAGE(PG8_SA(0, 0), a2, w2[0]);
            PG8_WAIT_V(8); PG8_WAIT_L(0); PG8_BAR; PG8_MMA(1, 0, At, B0); PG8_MMA(1, 1, At, B1); PG8_BAR; PG8_SCHED;
            PG8_LDB(B0, 1, 0); PG8_LDB(B1, 1, 1); PG8_SCHED; PG8_LDA(At, 1, 0); PG8_STAGE(PG8_SA(0, 1), a2, w2[1]);
            PG8_WAIT_V(8); PG8_WAIT_L(0); PG8_BAR; PG8_MMA(0, 0, At, B0); PG8_MMA(0, 1, At, B1); PG8_BAR; PG8_SCHED;
            PG8_LDA(At, 1, 1); PG8_STAGE(PG8_SB(1, 0), b3, voffB); PG8_STAGE(PG8_SB(1, 1), b3 + hstep, voffB); PG8_STAGE(PG8_SA(1, 0), a3, w2[0]);
            PG8_WAIT_V(8); PG8_WAIT_L(0); PG8_BAR; PG8_MMA(1, 0, At, B0); PG8_MMA(1, 1, At, B1); PG8_BAR; PG8_SCHED;
        }
        if (wr == 0) PG8_BAR;
        { int fr2 = fr, fq2 = fq; asm volatile("" : "+v"(fr2), "+v"(fq2));
          E(acc, cur, ui, wr, wc, fr2, fq2, lds); }
        if (!has_next) break;
#pragma unroll
        for (int a = 0; a < 2; ++a)
#pragma unroll
            for (int b = 0; b < 2; ++b)
#pragma unroll
                for (int m = 0; m < 4; ++m)
#pragma unroll
                    for (int n = 0; n < 2; ++n) acc[a][b][m][n] = (f32x4){0.f, 0.f, 0.f, 0.f};
        cur = nxt; cB = nB; ++ui;
        E.begin(cur, ui, tid, lds);
        { const u32x4 q = *vslot; vc[0][0] = q.x; vc[0][1] = q.y; vc[1][0] = q.z; vc[1][1] = q.w; }
        if (wr == 1) PG8_BAR;
    }
    PG8_WAIT_V(0);
    PG8_BAR;
#undef PG8_AOFFS
#undef PG8_SA
#undef PG8_SB
#undef PG8_STAGE
#undef PG8_LDA
#undef PG8_LDB
#undef PG8_MMA
#undef PG8_WAIT_V
#undef PG8_WAIT_L
#undef PG8_BAR
#undef PG8_SCHED
}
}
using pg8::Unit;

struct DenseSched {
    pg8::StaticOrder o; const char* Bt; int K;
    __device__ __forceinline__ bool next(int i, Unit& u) const { return o.next(i, u); }
    __device__ __forceinline__ unsigned a_off(const Unit& u, int r) const { return (unsigned)(u.pm * 256 + r) * (unsigned)(K * 2); }
    __device__ __forceinline__ const char* b_tile(const Unit& u) const { return Bt + (size_t)u.pn * 256 * K * 2; }
};
struct MoeSched {
    int G, c, npn, gather; const LAS int* tb; const int* liste; const char* Bt; int K, nB;
    __device__ __forceinline__ bool next(int i, Unit& u) const {
        const int L = i * G + c, ntile = tb[32];
        if (L >= ntile * npn) return false;
        const int ti = L / npn; u.pn = L % npn; u.pm = ti;
        int e = 0;
#pragma unroll 1
        for (; e < 31; ++e) if (ti < tb[e + 1]) break;
        u.e = e; u.tile = ti - tb[e]; const int rem = tb[40 + e] - 256 * u.tile; u.nrows = rem < 256 ? rem : 256; return true;
    }
    __device__ __forceinline__ unsigned a_off(const Unit& u, int r) const {
        if (gather) { int tok = 0; if (r < u.nrows) tok = liste[(size_t)u.e * T + 256 * u.tile + r] >> 1; return (unsigned)tok * (unsigned)(K * 2); }
        return (unsigned)(u.pm * 256 + r) * (unsigned)(K * 2);
    }
    __device__ __forceinline__ const char* b_tile(const Unit& u) const { return Bt + ((size_t)u.e * nB + (size_t)u.pn * 256) * K * 2; }
};

#define EPI_DEFAULTS static constexpr bool MID = false; __device__ __forceinline__ void begin(const Unit&, int, int, LAS unsigned char*) const {}
struct EpiIn {
    EPI_DEFAULTS
    const float* SSQ; bf16_t* QKV; bf16_t* CKV; bf16_t* CQ; bf16_t* KR; const float* COS; const float* SIN; float* SQQ; float* SQK;
    __device__ __forceinline__ void operator()(const f32x4 (&acc)[2][2][4][2], const Unit& u, int ui, int wr, int wc, int fr, int fq, LAS unsigned char* lds) const {
        const int pn = u.pn;
#pragma unroll
        for (int ai = 0; ai < 2; ++ai)
#pragma unroll
            for (int m = 0; m < 4; ++m) {
                const int row = u.pm * 256 + ai * 128 + wr * 64 + m * 16 + fr; const float rs = rstd_part16(SSQ + (size_t)row * 16, 1.f / DM);
                float sq = 0.f;
#pragma unroll
                for (int bj = 0; bj < 2; ++bj) {
                    const int c = bj * 128 + wc * 32 + fq * 8;
                    f32x4 v0 = acc[ai][bj][m][0] * rs, v1 = acc[ai][bj][m][1] * rs;
                    if (pn < 6) { if (pn < 2) { v0 = v0 * QS_SB; v1 = v1 * QS_SB; } *(u32x4*)(QKV + (size_t)row * 1536 + pn * 256 + c) = pack8(v0, v1); }
                    else if (pn == 6) { *(u32x4*)(CKV + (size_t)row * 256 + c) = pack8(v0, v1); sq += sq8(v0, v1); }
                    else if (pn == 7) { *(u32x4*)(CQ + (size_t)row * 384 + c) = pack8(v0, v1); sq += sq8(v0, v1); }
                    else if (bj == 0) { *(u32x4*)(CQ + (size_t)row * 384 + 256 + c) = pack8(v0, v1); sq += sq8(v0, v1); }
                    else if (wc == 0) {
                        const int ib = 8 * (fq & 1);
                        const f32x4 c0 = *(const f32x4*)(COS + (size_t)row * 16 + ib), c1 = *(const f32x4*)(COS + (size_t)row * 16 + ib + 4);
                        const f32x4 s0 = *(const f32x4*)(SIN + (size_t)row * 16 + ib), s1 = *(const f32x4*)(SIN + (size_t)row * 16 + ib + 4);
                        f32x4 p0, p1;
#pragma unroll
                        for (int i = 0; i < 4; ++i) { p0[i] = xor32(v0[i]); p1[i] = xor32(v1[i]); }
                        const float sg = (fq < 2) ? -1.f : 1.f;
                        const f32x4 o0 = v0 * c0 + p0 * s0 * sg, o1 = v1 * c1 + p1 * s1 * sg;
                        *(u32x4*)(KR + (size_t)row * 32 + fq * 8) = pack8(o0, o1);
                    }
                }
                if (pn >= 6) {
                    sq = fq_sum(sq);
                    if (fq == 0) { if (pn == 6) SQK[(size_t)row * 4 + wc] = sq; else SQQ[(size_t)row * 8 + (pn - 7) * 4 + wc] = sq; }
                }
                asm volatile("" ::: "memory");
            }
    }
};
struct EpiUq {
    EPI_DEFAULTS
    const float* RS; bf16_t* QM; const float* COS; const float* SIN;
    __device__ __forceinline__ void operator()(const f32x4 (&acc)[2][2][4][2], const Unit& u, int ui, int wr, int wc, int fr, int fq, LAS unsigned char* lds) const {
#pragma unroll
        for (int ai = 0; ai < 2; ++ai)
#pragma unroll
            for (int m = 0; m < 4; ++m) {
                const int row = u.pm * 256 + ai * 128 + wr * 64 + m * 16 + fr; const float rs = rstd_part8(RS + (size_t)row * 8, 1.f / QRANK) * QS_MLA;
#pragma unroll
                for (int bj = 0; bj < 2; ++bj) {
                    const int c = u.pn * 256 + bj * 128 + wc * 32 + fq * 8; const int g32 = u.pn * 8 + bj * 4 + wc;
                    f32x4 v0 = acc[ai][bj][m][0] * rs, v1 = acc[ai][bj][m][1] * rs;
                    if ((g32 % 3) == 2) {
                        const int ib = 8 * (fq & 1);
                        const f32x4 c0 = *(const f32x4*)(COS + (size_t)row * 16 + ib), c1 = *(const f32x4*)(COS + (size_t)row * 16 + ib + 4);
                        const f32x4 s0 = *(const f32x4*)(SIN + (size_t)row * 16 + ib), s1 = *(const f32x4*)(SIN + (size_t)row * 16 + ib + 4);
                        f32x4 p0, p1;
#pragma unroll
                        for (int i = 0; i < 4; ++i) { p0[i] = xor32(v0[i]); p1[i] = xor32(v1[i]); }
                        const float sg = (fq < 2) ? -1.f : 1.f;
                        v0 = v0 * c0 + p0 * s0 * sg; v1 = v1 * c1 + p1 * s1 * sg;
                    }
                    *(u32x4*)(QM + (size_t)row * 768 + c) = pack8(v0, v1);
                }
                asm volatile("" ::: "memory");
            }
    }
};
struct EpiUkv {
    EPI_DEFAULTS
    const float* RS; bf16_t* KN; bf16_t* VM;
    __device__ __forceinline__ void operator()(const f32x4 (&acc)[2][2][4][2], const Unit& u, int ui, int wr, int wc, int fr, int fq, LAS unsigned char* lds) const {
        bf16_t* dst = u.pn < 2 ? KN : VM; const int cb = (u.pn & 1) * 256;
#pragma unroll
        for (int ai = 0; ai < 2; ++ai)
#pragma unroll
            for (int m = 0; m < 4; ++m) {
                const int row = u.pm * 256 + ai * 128 + wr * 64 + m * 16 + fr; const float rs = rstd_part4(RS + (size_t)row * 4, 1.f / KVRANK);
#pragma unroll
                for (int bj = 0; bj < 2; ++bj) { const int c = cb + bj * 128 + wc * 32 + fq * 8;
                    *(u32x4*)(dst + (size_t)row * 512 + c) = pack8(acc[ai][bj][m][0] * rs, acc[ai][bj][m][1] * rs); }
            }
    }
};
struct EpiBf {
    EPI_DEFAULTS
    bf16_t* O; int ldc;
    __device__ __forceinline__ void operator()(const f32x4 (&acc)[2][2][4][2], const Unit& u, int ui, int wr, int wc, int fr, int fq, LAS unsigned char* lds) const {
#pragma unroll
        for (int ai = 0; ai < 2; ++ai)
#pragma unroll
            for (int m = 0; m < 4; ++m) {
                const int row = u.pm * 256 + ai * 128 + wr * 64 + m * 16 + fr;
#pragma unroll
                for (int bj = 0; bj < 2; ++bj) { const int c = u.pn * 256 + bj * 128 + wc * 32 + fq * 8;
                    *(u32x4*)(O + (size_t)row * ldc + c) = pack8(acc[ai][bj][m][0], acc[ai][bj][m][1]); }
            }
    }
};
constexpr int OTAB_OFF = pg8::STAGE_BYTES + 1024 + 8192;
struct EpiOut {
    static constexpr bool MID = true;
    const float* hin; float* hout; const float* OSS;
    __device__ __forceinline__ void begin(const Unit& u, int ui, int tid, LAS unsigned char* lds) const {
        if (tid < 256) { const float* p = OSS + (size_t)(u.pm * 256 + tid) * 16; const f32x4 a = ((const f32x4*)p)[0], b = ((const f32x4*)p)[1], c = ((const f32x4*)p)[2], d = ((const f32x4*)p)[3];
            const f32x4 s1 = a + b, s2 = c + d; const float rs = 1.0f / sqrtf(((s1[0] + s1[1]) + (s1[2] + s1[3])) * (1.f / 512.f) + EPS), rm = 1.0f / sqrtf(((s2[0] + s2[1]) + (s2[2] + s2[3])) * (1.f / 512.f) + EPS);
            ((LAS f32x2*)(lds + OTAB_OFF))[(ui & 1) * 256 + tid] = (f32x2){rs / rm, rm}; }
    }
    __device__ __forceinline__ void mid(f32x4 (&acc)[2][2][4][2], int ui, int wr, int fr, LAS unsigned char* lds) const {
#pragma unroll
        for (int ai = 0; ai < 2; ++ai)
#pragma unroll
            for (int m = 0; m < 4; ++m) { const float f = ((const LAS f32x2*)(lds + OTAB_OFF))[(ui & 1) * 256 + ai * 128 + wr * 64 + m * 16 + fr][0];
#pragma unroll
                for (int bj = 0; bj < 2; ++bj)
#pragma unroll
                    for (int n = 0; n < 2; ++n) acc[ai][bj][m][n] = acc[ai][bj][m][n] * f; }
    }
    __device__ __forceinline__ void operator()(const f32x4 (&acc)[2][2][4][2], const Unit& u, int ui, int wr, int wc, int fr, int fq, LAS unsigned char* lds) const {
#pragma unroll
        for (int ai = 0; ai < 2; ++ai)
#pragma unroll
            for (int m = 0; m < 4; ++m) {
                const int r = ai * 128 + wr * 64 + m * 16 + fr, row = u.pm * 256 + r; const float rm = ((const LAS f32x2*)(lds + OTAB_OFF))[(ui & 1) * 256 + r][1];
#pragma unroll
                for (int bj = 0; bj < 2; ++bj) { const size_t o = (size_t)row * DM + u.pn * 256 + bj * 128 + wc * 32 + fq * 8;
                    const f32x4 a = *(const f32x4*)(hin + o), b = *(const f32x4*)(hin + o + 4);
                    *(f32x4*)(hout + o) = a + acc[ai][bj][m][0] * rm; *(f32x4*)(hout + o + 4) = b + acc[ai][bj][m][1] * rm; }
                asm volatile("" ::: "memory");
            }
    }
};
struct EpiG1 {
    EPI_DEFAULTS
    const float* RS; const int* liste; bf16_t* HID;
    __device__ __forceinline__ void operator()(const f32x4 (&acc)[2][2][4][2], const Unit& u, int ui, int wr, int wc, int fr, int fq, LAS unsigned char* lds) const {
#pragma unroll
        for (int ai = 0; ai < 2; ++ai)
#pragma unroll
            for (int m = 0; m < 4; ++m) {
                const int r = ai * 128 + wr * 64 + m * 16 + fr;
                if (r < u.nrows) {
                    const int tok = liste[(size_t)u.e * T + 256 * u.tile + r] >> 1; const float rs = RS[tok];
                    f32x4 h[2];
#pragma unroll
                    for (int n = 0; n < 2; ++n) { const f32x4 g = acc[ai][0][m][n] * rs, up = acc[ai][1][m][n] * rs;
#pragma unroll
                        for (int i = 0; i < 4; ++i) h[n][i] = g[i] * frcp(1.f + fexp2(-g[i] * LOG2E)) * up[i]; }
                    *(u32x4*)(HID + (size_t)(u.pm * 256 + r) * 256 + u.pn * 128 + wc * 32 + fq * 8) = pack8(h[0], h[1]);
                }
                asm volatile("" ::: "memory");
            }
    }
};
struct EpiDn {
    EPI_DEFAULTS
    const int* liste; const float* listw; bf16_t* Y;
    __device__ __forceinline__ void operator()(const f32x4 (&acc)[2][2][4][2], const Unit& u, int ui, int wr, int wc, int fr, int fq, LAS unsigned char* lds) const {
#pragma unroll
        for (int ai = 0; ai < 2; ++ai)
#pragma unroll
            for (int m = 0; m < 4; ++m) {
                const int r = ai * 128 + wr * 64 + m * 16 + fr;
                if (r < u.nrows) {
                    const size_t li = (size_t)u.e * T + 256 * u.tile + r; const int ent = liste[li]; const float w = listw[li];
#pragma unroll
                    for (int bj = 0; bj < 2; ++bj) { const int c = u.pn * 256 + bj * 128 + wc * 32 + fq * 8;
                        *(u32x4*)(Y + (size_t)ent * DM + c) = pack8(acc[ai][bj][m][0] * w, acc[ai][bj][m][1] * w); }
                }
                asm volatile("" ::: "memory");
            }
    }
};
struct EpiPle {
    EPI_DEFAULTS
    const float* RS; const bf16_t* PE; const float* H; float* HO; bf16_t* HB; float* SSQ;
    __device__ __forceinline__ void operator()(const f32x4 (&acc)[2][2][4][2], const Unit& u, int ui, int wr, int wc, int fr, int fq, LAS unsigned char* lds) const {
#pragma unroll
        for (int ai = 0; ai < 2; ++ai)
#pragma unroll
            for (int m = 0; m < 4; ++m) {
                const int row = u.pm * 256 + ai * 128 + wr * 64 + m * 16 + fr; const float rs = RS[row];
                float sq = 0.f;
#pragma unroll
                for (int bj = 0; bj < 2; ++bj) { const size_t o = (size_t)row * DM + u.pn * 256 + bj * 128 + wc * 32 + fq * 8;
                    float pe[8]; unpack8(*(const u32x4*)(PE + o), pe);
                    f32x4 a = *(const f32x4*)(H + o), b = *(const f32x4*)(H + o + 4);
#pragma unroll
                    for (int i = 0; i < 4; ++i) { a[i] += frcp(1.f + fexp2(-acc[ai][bj][m][0][i] * rs * LOG2E)) * pe[i]; b[i] += frcp(1.f + fexp2(-acc[ai][bj][m][1][i] * rs * LOG2E)) * pe[4 + i]; }
                    *(f32x4*)(HO + o) = a; *(f32x4*)(HO + o + 4) = b; *(u32x4*)(HB + o) = pack8(a, b); sq += sq8(a, b); }
                sq = fq_sum(sq);
                if (fq == 0) SSQ[(size_t)row * 16 + u.pn * 4 + wc] = sq;
                asm volatile("" ::: "memory");
            }
    }
};


#define XB_TMO      128
#define XB_XCNT(j)  (256  + 64 * (j))
#define XB_XSUB(j)  (1280 + 64 * (j))
#define XB_XGEN(j)  (2304 + 64 * (j))
#define XB_TOP      3328
#define XB_TOPGEN   3392
#define XCD_BAR_WORDS 3456
#define XB_SPIN_CAP (1u << 18)

__device__ __forceinline__ unsigned xb_ld(unsigned* p)              { return __hip_atomic_load(p, __ATOMIC_RELAXED, __HIP_MEMORY_SCOPE_AGENT); }
__device__ __forceinline__ unsigned xb_add(unsigned* p, unsigned v) { return __hip_atomic_fetch_add(p, v, __ATOMIC_RELAXED, __HIP_MEMORY_SCOPE_AGENT); }
__device__ __forceinline__ unsigned xb_xcc_id() { return (unsigned)__builtin_amdgcn_s_getreg((3 << 11) | 20) & 0xFu; }
#define XB_SPIN(cond, bar) do { unsigned _sp = 0; while (cond) { __builtin_amdgcn_s_sleep(1); \
    if ((++_sp & 255u) == 0u) { if (xb_ld(&(bar)[XB_TMO])) break; if (_sp > XB_SPIN_CAP) { atomicAdd(&(bar)[XB_TMO], 1u); break; } } } } while (0)

struct XcdBarrier {
    unsigned* bar; unsigned x;
    volatile LAS unsigned* st;
};

__device__ __forceinline__ XcdBarrier xcd_barrier_post(unsigned* bar, volatile LAS unsigned* st) {
    XcdBarrier b; b.bar = bar; b.x = xb_xcc_id(); b.st = st;
    if (threadIdx.x == 0) (void)xb_add(&bar[XB_XCNT(b.x)], 1u);
    return b;
}
__device__ __forceinline__ void xcd_barrier_complete(unsigned* bar, unsigned x, unsigned& nloc, unsigned& nx) {
    const unsigned G = gridDim.x * gridDim.y * gridDim.z;
    unsigned sum, cnt, mine, sp = 0u;
    for (;;) {
        sum = 0u; cnt = 0u; mine = 0u;
#pragma unroll
        for (unsigned j = 0; j < 16; ++j) { const unsigned c = xb_ld(&bar[XB_XCNT(j)]); sum += c; cnt += (c > 0u) ? 1u : 0u; mine = (j == x) ? c : mine; }
        if (sum == G) break;
        __builtin_amdgcn_s_sleep(1);
        if ((++sp & 255u) == 0u) { if (xb_ld(&bar[XB_TMO])) break; if (sp > XB_SPIN_CAP) { atomicAdd(&bar[XB_TMO], 1u); break; } }
    }
    nloc = mine > 0u ? mine : 1u; nx = cnt > 0u ? cnt : 1u;
}

__device__ __forceinline__ void xcd_barrier(const XcdBarrier& b) {
    asm volatile("s_waitcnt vmcnt(0)" ::: "memory");
    __syncthreads();
    if (threadIdx.x == 0) {
        unsigned* bar = b.bar;
        __builtin_amdgcn_s_waitcnt(0);
        unsigned nloc = b.st[0], nx = b.st[1];
        if (nloc == 0u) { xcd_barrier_complete(bar, b.x, nloc, nx); b.st[0] = nloc; b.st[1] = nx; }
        const unsigned old = xb_add(&bar[XB_XSUB(b.x)], 1u);
        const unsigned gen = old / nloc;
        if (old + 1u == (gen + 1u) * nloc) {
            __builtin_amdgcn_fence(__ATOMIC_RELEASE, "agent");
            asm volatile("s_waitcnt vmcnt(0)" ::: "memory");
            const unsigned og = xb_add(&bar[XB_TOP], 1u);
            const unsigned tg = og / nx;
            if (og + 1u == (tg + 1u) * nx) xb_add(&bar[XB_TOPGEN], 1u);
            else XB_SPIN(xb_ld(&bar[XB_TOPGEN]) == tg, bar);
            __builtin_amdgcn_fence(__ATOMIC_ACQUIRE, "agent");
            xb_add(&bar[XB_XGEN(b.x)], 1u);
            asm volatile("s_waitcnt vmcnt(0)" ::: "memory");
        } else {
            XB_SPIN(xb_ld(&bar[XB_XGEN(b.x)]) == gen, bar);
            __builtin_amdgcn_fence(__ATOMIC_ACQUIRE, "agent");
            asm volatile("s_waitcnt vmcnt(0)" ::: "memory");
        }
    }
    __syncthreads();
}


struct Frame {
    LAS unsigned char* lds; int tid, lane, wave, G, bx;
    const Params* P; unsigned char* ws;
    __device__ __forceinline__ int gw() const { return bx * NWAVES + wave; }
    __device__ __forceinline__ int ngw() const { return G * NWAVES; }
};
template <class Tp> __device__ __forceinline__ Tp* wsp(const Frame& F, size_t off) { return (Tp*)(F.ws + off); }

__device__ __forceinline__ void prep_item(const float* W, int ldw, int srccol0, const float* g, bf16_t* dstrow0, int K, int k0, LAS float* scr, int lane) {
    const int c = lane & 7;
    if (srccol0 < 0) {
#pragma unroll
        for (int j = 0; j < 4; ++j) { const int n = (lane >> 3) + 8 * j; *(u32x4*)(dstrow0 + (size_t)n * K + k0 + 8 * c) = (u32x4){0u, 0u, 0u, 0u}; }
        return;
    }
#pragma unroll 8
    for (int i = 0; i < 32; ++i) { const int kk = 2 * i + (lane >> 5); float v = W[(size_t)(k0 + kk) * ldw + srccol0 + (lane & 31)]; if (g) v *= g[k0 + kk]; scr[kk * 33 + (lane & 31)] = v; }
    asm volatile("s_waitcnt lgkmcnt(0)" ::: "memory");
#pragma unroll
    for (int j = 0; j < 4; ++j) { const int n = (lane >> 3) + 8 * j; const LAS float* s = scr + (8 * c) * 33 + n;
        u32x4 o; o.x = pk2(s[0 * 33], s[1 * 33]); o.y = pk2(s[2 * 33], s[3 * 33]); o.z = pk2(s[4 * 33], s[5 * 33]); o.w = pk2(s[6 * 33], s[7 * 33]);
        *(u32x4*)(dstrow0 + (size_t)n * K + k0 + 8 * c) = o; }
    asm volatile("s_waitcnt lgkmcnt(0)" ::: "memory");
}
__device__ __forceinline__ void phase_prep_small(Frame& F) {
    const Params& P = *F.P;
    LAS float* scr = (LAS float*)(F.lds + F.wave * 16384);
    constexpr int I_IN = 16 * 72, I_UQ = 6 * 24, I_UKV = 4 * 32, I_OUT = 16 * 32, I_PG = 16 * 32, I_PE = 4 * 32, I_L = I_IN + I_UQ + I_UKV + I_OUT + I_PG + I_PE;
    for (int it = F.gw(); it < NLAYER * I_L; it += F.ngw()) {
        const int l = it / I_L; int r = it % I_L;
        unsigned char* wb = F.ws + WS_WSM + (size_t)l * WSM_STRIDE;
        if (r < I_IN) { const int kb = r / 72, gi = r % 72, n0 = gi * 32; int src;
            if (n0 < 1536) src = n0; else if (n0 < 1792) src = 1920 + (n0 - 1536); else if (n0 < 2176) src = 1536 + (n0 - 1792); else if (n0 < 2208) src = n0; else src = -1;
            prep_item(P.in[4] + (size_t)l * DM * INC, INC, src, P.in[3] + l * DM, (bf16_t*)(wb + WSM_IN) + (size_t)n0 * DM, DM, kb * 64, scr, F.lane); continue; }
        r -= I_IN;
        if (r < I_UQ) { const int kb = r / 24, n0 = (r % 24) * 32;
            prep_item(P.in[6] + (size_t)l * QRANK * 768, 768, n0, P.in[5] + l * QRANK, (bf16_t*)(wb + WSM_UQ) + (size_t)n0 * QRANK, QRANK, kb * 64, scr, F.lane); continue; }
        r -= I_UQ;
        if (r < I_UKV) { const int kb = r / 32, n0 = (r % 32) * 32; const int hh = (n0 & 511) >> 6, d = n0 & 63; const int src = hh * 128 + (n0 >= 512 ? 64 : 0) + d;
            prep_item(P.in[8] + (size_t)l * KVRANK * 1024, 1024, src, P.in[7] + l * KVRANK, (bf16_t*)(wb + WSM_UKV) + (size_t)n0 * KVRANK, KVRANK, kb * 64, scr, F.lane); continue; }
        r -= I_UKV;
        if (r < I_OUT) { const int kb = r / 32, n0 = (r % 32) * 32; const int k0 = kb * 64;
            const float* g = k0 < 512 ? P.in[9] + l * 512 : P.in[10] + l * 512 - 512;
            prep_item(P.in[11] + (size_t)l * DM * DM, DM, n0, g, (bf16_t*)(wb + WSM_OUT) + (size_t)n0 * DM, DM, k0, scr, F.lane); continue; }
        r -= I_OUT;
        if (r < I_PG) { const int kb = r / 32, n0 = (r % 32) * 32;
            prep_item(P.in[21] + (size_t)l * DM * DM, DM, n0, P.in[20] + l * DM, (bf16_t*)(wb + WSM_PG) + (size_t)n0 * DM, DM, kb * 64, scr, F.lane); continue; }
        r -= I_PG;
        { const int kb = r / 32, n0 = (r % 32) * 32;
            prep_item(P.in[22] + (size_t)l * DPLE * DM, DM, n0, nullptr, (bf16_t*)(wb + WSM_PE) + (size_t)n0 * DPLE, DPLE, kb * 64, scr, F.lane); }
    }
    float* WR = wsp<float>(F, WS_WR);
    for (int i = F.bx * NTHREADS + F.tid; i < NLAYER * 36 * DM; i += F.G * NTHREADS) {
        const int l = i / (36 * DM), j = (i / DM) % 36, k = i % DM;
        const float w = j < 4 ? P.in[13][((size_t)l * DM + k) * 4 + j] : P.in[15][((size_t)l * DM + k) * 32 + (j - 4)];
        WR[i] = w * P.in[12][l * DM + k];
    }
    float* COS = wsp<float>(F, WS_COS); float* SIN = wsp<float>(F, WS_SIN); const int* pos = (const int*)P.in[2];
    for (int i = F.bx * NTHREADS + F.tid; i < T * 16; i += F.G * NTHREADS) {
        const float ang = (float)pos[i >> 4] * P.inv_freq[i & 15];
        const double a = (double)ang; const double q = __builtin_rint(a * 0.63661977236758134308);
        double r = __builtin_fma(-q, 1.57079632679489655800, a); r = __builtin_fma(-q, 6.12323399573676603587e-17, r);
        const double z = r * r;
        const double sp = r + r * z * (-0.166666666416265235595 + z * (0.0083333293858894631756 + z * (-0.000198393348360966317347 + z * 0.0000027183114939898219064)));
        const double cp = 1.0 + z * (-0.499999997251031003120 + z * (0.0416666233237390631894 + z * (-0.00138867637746099294692 + z * 0.0000243904487962774090654)));
        const int qi = (int)((long long)q & 3);
        const double sv = (qi == 0) ? sp : (qi == 1) ? cp : (qi == 2) ? -sp : -cp;
        const double cv = (qi == 0) ? cp : (qi == 1) ? -sp : (qi == 2) ? -cp : sp;
        COS[i] = (float)cv; SIN[i] = (float)sv;
    }
}
__device__ __forceinline__ void prep_item64(const float* W, int ldw, int srccol0, const float* g, bf16_t* dstrow0, int K, int k0, LAS float* scr, int lane) {
    f32x4 v[16];
    const int kq = lane >> 4, n4 = (lane & 15) * 4;
#pragma unroll
    for (int i = 0; i < 16; ++i) v[i] = *(const f32x4*)(W + (size_t)(k0 + 4 * i + kq) * ldw + srccol0 + n4);
#pragma unroll
    for (int i = 0; i < 16; ++i) { const float gg = g ? g[k0 + 4 * i + kq] : 1.f; LAS float* d = scr + (4 * i + kq) * 65 + n4; d[0] = v[i][0] * gg; d[1] = v[i][1] * gg; d[2] = v[i][2] * gg; d[3] = v[i][3] * gg; }
    asm volatile("s_waitcnt lgkmcnt(0)" ::: "memory");
    const int c = lane & 7;
#pragma unroll
    for (int j = 0; j < 8; ++j) { const int n = (lane >> 3) + 8 * j; const LAS float* s = scr + (8 * c) * 65 + n;
        u32x4 o; o.x = pk2(s[0 * 65], s[1 * 65]); o.y = pk2(s[2 * 65], s[3 * 65]); o.z = pk2(s[4 * 65], s[5 * 65]); o.w = pk2(s[6 * 65], s[7 * 65]);
        *(u32x4*)(dstrow0 + (size_t)n * K + k0 + 8 * c) = o; }
    asm volatile("s_waitcnt lgkmcnt(0)" ::: "memory");
}
__device__ __forceinline__ void phase_prep_moe(Frame& F, int l) {
    const Params& P = *F.P;
    LAS float* scr = (LAS float*)(F.lds + F.wave * 16640);
    constexpr int I_G1 = 16 * 8, I_DN = 4 * 16, I_E = I_G1 + I_DN;
    bf16_t* WG1 = wsp<bf16_t>(F, WS_WG1); bf16_t* WD = wsp<bf16_t>(F, WS_WD);
    for (int it = F.gw(); it < NEXP * I_E; it += F.ngw()) {
        const int e = it / I_E; int r = it % I_E;
        if (r < I_G1) { const int kb = r >> 3, n0 = (r & 7) * 64; const int pn = n0 >> 8, c = n0 & 255;
            const float* W = (c < 128 ? P.in[17] : P.in[18]) + ((size_t)l * NEXP + e) * DM * DEXP; const int src = pn * 128 + (c & 127);
            prep_item64(W, DEXP, src, P.in[12] + l * DM, WG1 + ((size_t)e * 512 + n0) * DM, DM, kb * 64, scr, F.lane); }
        else { r -= I_G1; const int kb = r >> 4, n0 = (r & 15) * 64;
            prep_item64(P.in[19] + ((size_t)l * NEXP + e) * DEXP * DM, DM, n0, nullptr, WD + ((size_t)e * DM + n0) * DEXP, DEXP, kb * 64, scr, F.lane); }
    }
}

__device__ __forceinline__ void phase_norm(Frame& F, const float* hin) {
    bf16_t* HB = wsp<bf16_t>(F, WS_HBI); float* SSQ = wsp<float>(F, WS_SSQ);
    for (int row = F.gw(); row < T; row += F.ngw()) {
        const f32x4* xr = (const f32x4*)(hin + (size_t)row * DM) + F.lane; f32x4 v[4]; float s = 0.f;
#pragma unroll
        for (int j = 0; j < 4; ++j) { v[j] = xr[64 * j]; s += (v[j][0] * v[j][0] + v[j][1] * v[j][1]) + (v[j][2] * v[j][2] + v[j][3] * v[j][3]); }
        s = wave_sum(s);
        u32x2* o = (u32x2*)(HB + (size_t)row * DM) + F.lane;
#pragma unroll
        for (int j = 0; j < 4; ++j) o[64 * j] = (u32x2){pk2(v[j][0], v[j][1]), pk2(v[j][2], v[j][3])};
        if (F.lane < 16) SSQ[(size_t)row * 16 + F.lane] = F.lane == 0 ? s : 0.f;
    }
}
__device__ __forceinline__ void phase_route(Frame& F, int l, bool dummy = false) {
    const Params& P = *F.P; bf16_t* PB = wsp<bf16_t>(F, WS_PB); const float* pl = P.in[1] + (size_t)l * T * DPLE;
    LAS float* WL = (LAS float*)F.lds;
    const float* WR = wsp<float>(F, WS_WR) + (size_t)l * 36 * DM;
    for (int i = F.tid; i < 36 * DM / 4; i += NTHREADS) ((LAS f32x4*)WL)[i] = ((const f32x4*)WR)[i];
    __syncthreads();
    const float* H = wsp<float>(F, WS_H32); bf16_t* HB = wsp<bf16_t>(F, WS_HB); float* RS = wsp<float>(F, WS_RS);
    unsigned* cnt = wsp<unsigned>(F, WS_CTL) + CW_CNT + 64 * 32 * (dummy ? NLAYER + l : l); int* liste = dummy ? wsp<int>(F, WS_Y) : wsp<int>(F, WS_LISTE); float* listw = dummy ? wsp<float>(F, WS_Y + 4 * MiB) : wsp<float>(F, WS_LISTW);
    const float* brg = P.in[14] + l * 4; const float* bre = P.in[16] + l * 32;
    LAS unsigned* lcnt = (LAS unsigned*)(F.lds + 147456); LAS unsigned* lbase = lcnt + 32; LAS unsigned* ent = lcnt + 64;
    if (F.tid < 32) lcnt[F.tid] = 0u;
    __syncthreads();
    int nent = 0;
    for (int row = F.gw(); row < T; row += F.ngw()) {
        const f32x4* xr = (const f32x4*)(H + (size_t)row * DM) + F.lane; f32x4 v[4]; float s = 0.f;
#pragma unroll
        for (int j = 0; j < 4; ++j) { v[j] = xr[64 * j]; s += (v[j][0] * v[j][0] + v[j][1] * v[j][1]) + (v[j][2] * v[j][2] + v[j][3] * v[j][3]); }
        s = wave_sum(s); const float rs = 1.0f / sqrtf(s * (1.f / DM) + EPS);
        u32x2* o = (u32x2*)(HB + (size_t)row * DM) + F.lane;
#pragma unroll
        for (int j = 0; j < 4; ++j) o[64 * j] = (u32x2){pk2(v[j][0], v[j][1]), pk2(v[j][2], v[j][3])};
        { const f32x4 pv = ((const f32x4*)(pl + (size_t)row * DPLE))[F.lane]; ((u32x2*)(PB + (size_t)row * DPLE))[F.lane] = (u32x2){pk2(pv[0], pv[1]), pk2(pv[2], pv[3])}; }
        float gl[4];
#pragma unroll
        for (int q = 0; q < 4; ++q) { float a = 0.f;
#pragma unroll
            for (int j = 0; j < 4; ++j) { const f32x4 w = ((const LAS f32x4*)(WL + q * DM))[F.lane + 64 * j]; a += (v[j][0] * w[0] + v[j][1] * w[1]) + (v[j][2] * w[2] + v[j][3] * w[3]); }
            gl[q] = wave_sum(a) * rs; }
        const float g0 = gl[0] + brg[0], g1 = gl[1] + brg[1], g2 = gl[2] + brg[2], g3 = gl[3] + brg[3];
        int g = 0; float gm = g0; if (g1 > gm) { gm = g1; g = 1; } if (g2 > gm) { gm = g2; g = 2; } if (g3 > gm) { gm = g3; g = 3; }
        g = __builtin_amdgcn_readfirstlane(g);
        const float gp = 1.0f / (fexp2((g0 - gm) * LOG2E) + fexp2((g1 - gm) * LOG2E) + fexp2((g2 - gm) * LOG2E) + fexp2((g3 - gm) * LOG2E));
        float le[8];
#pragma unroll
        for (int q = 0; q < 8; ++q) { float a = 0.f; const LAS f32x4* wq = (const LAS f32x4*)(WL + (4 + g * 8 + q) * DM);
#pragma unroll
            for (int j = 0; j < 4; ++j) { const f32x4 w = wq[F.lane + 64 * j]; a += (v[j][0] * w[0] + v[j][1] * w[1]) + (v[j][2] * w[2] + v[j][3] * w[3]); }
            le[q] = wave_sum(a) * rs + bre[g * 8 + q]; }
        int i1 = 0; float l1 = le[0];
#pragma unroll
        for (int j = 1; j < 8; ++j) if (le[j] > l1) { l1 = le[j]; i1 = j; }
        int i2 = (i1 == 0) ? 1 : 0; float l2 = (i1 == 0) ? le[1] : le[0];
#pragma unroll
        for (int j = 1; j < 8; ++j) if (j != i1 && le[j] > l2) { l2 = le[j]; i2 = j; }
        const float e2 = fexp2((l2 - l1) * LOG2E); const float w1 = gp / (1.f + e2), w2 = gp * e2 / (1.f + e2);
        if (F.lane == 0) {
            RS[row] = rs;
            const int ea = g * 8 + i1, eb = g * 8 + i2;
            if (nent < 16) {
                const unsigned pa = atomicAdd((unsigned*)(lcnt + ea), 1u), pb = atomicAdd((unsigned*)(lcnt + eb), 1u);
                LAS unsigned* en = ent + (size_t)(F.wave * 32 + nent * 2) * 4;
                en[0] = (unsigned)ea; en[1] = pa; en[2] = (unsigned)(row * 2); en[3] = __float_as_uint(w1);
                en[4] = (unsigned)eb; en[5] = pb; en[6] = (unsigned)(row * 2 + 1); en[7] = __float_as_uint(w2);
            } else {
                const unsigned pa = atomicAdd(cnt + 64 * ea, 1u); liste[(size_t)ea * T + pa] = row * 2; listw[(size_t)ea * T + pa] = w1;
                const unsigned pb = atomicAdd(cnt + 64 * eb, 1u); liste[(size_t)eb * T + pb] = row * 2 + 1; listw[(size_t)eb * T + pb] = w2;
            }
        }
        if (nent < 16) ++nent;
    }
    __syncthreads();
    if (F.tid < 32) lbase[F.tid] = lcnt[F.tid] ? atomicAdd(cnt + 64 * F.tid, lcnt[F.tid]) : 0u;
    __syncthreads();
    if (F.lane < 2 * nent) {
        const LAS unsigned* en = ent + (size_t)(F.wave * 32 + F.lane) * 4;
        const size_t li = (size_t)en[0] * T + lbase[en[0]] + en[1];
        liste[li] = (int)en[2]; listw[li] = __uint_as_float(en[3]);
    }
}
__device__ __forceinline__ void phase_norm2(Frame& F, int l, float ysc) {
    const Params& P = *F.P;
    const float* H = wsp<float>(F, WS_H32); float* HO = wsp<float>(F, WS_H32); bf16_t* HB = wsp<bf16_t>(F, WS_HB); float* RS = wsp<float>(F, WS_RS); const bf16_t* Y = wsp<bf16_t>(F, WS_Y); bf16_t* PB = wsp<bf16_t>(F, WS_PB);
    const float* pl = P.in[1] + (size_t)l * T * DPLE;
    for (int row = F.gw(); row < T; row += F.ngw()) {
        const f32x4* xr = (const f32x4*)(H + (size_t)row * DM) + F.lane; f32x4* xo = (f32x4*)(HO + (size_t)row * DM) + F.lane; f32x4 v[4]; float s = 0.f;
        const u32x2* y0 = (const u32x2*)(Y + (size_t)row * 2 * DM) + F.lane; const u32x2* y1 = y0 + DM / 4;
#pragma unroll
        for (int j = 0; j < 4; ++j) { v[j] = xr[64 * j]; const u32x2 a = y0[64 * j], b = y1[64 * j];
            v[j][0] += ysc * (bf2f(a.x & 0xffffu) + bf2f(b.x & 0xffffu)); v[j][1] += ysc * (bf2f(a.x >> 16) + bf2f(b.x >> 16));
            v[j][2] += ysc * (bf2f(a.y & 0xffffu) + bf2f(b.y & 0xffffu)); v[j][3] += ysc * (bf2f(a.y >> 16) + bf2f(b.y >> 16));
            s += (v[j][0] * v[j][0] + v[j][1] * v[j][1]) + (v[j][2] * v[j][2] + v[j][3] * v[j][3]); xo[64 * j] = v[j]; }
        s = wave_sum(s);
        u32x2* o = (u32x2*)(HB + (size_t)row * DM) + F.lane;
#pragma unroll
        for (int j = 0; j < 4; ++j) o[64 * j] = (u32x2){pk2(v[j][0], v[j][1]), pk2(v[j][2], v[j][3])};
        if (F.lane == 0) RS[row] = 1.0f / sqrtf(s * (1.f / DM) + EPS);
    }
}
__device__ __forceinline__ void phase_final(Frame& F) {
    const Params& P = *F.P; const float* H = wsp<float>(F, WS_H32); const float* g = P.in[23];
    for (int row = F.gw(); row < T; row += F.ngw()) {
        const f32x4* xr = (const f32x4*)(H + (size_t)row * DM) + F.lane; f32x4 v[4]; float s = 0.f;
#pragma unroll
        for (int j = 0; j < 4; ++j) { v[j] = xr[64 * j]; s += (v[j][0] * v[j][0] + v[j][1] * v[j][1]) + (v[j][2] * v[j][2] + v[j][3] * v[j][3]); }
        s = wave_sum(s); const float rs = 1.0f / sqrtf(s * (1.f / DM) + EPS);
        f32x4* o = (f32x4*)(P.out + (size_t)row * DM) + F.lane;
#pragma unroll
        for (int j = 0; j < 4; ++j) o[64 * j] = v[j] * rs * ((const f32x4*)g)[F.lane + 64 * j];
    }
}

namespace att {
typedef float f32x16 __attribute__((ext_vector_type(16)));
typedef short s16x4 __attribute__((ext_vector_type(4)));
typedef short v4i16_t __attribute__((ext_vector_type(4)));
typedef __bf16 bf16x2_t __attribute__((ext_vector_type(2)));
constexpr int NS = 6, PF = 5;
constexpr int FLAG_OFF = 131072 + 512;
__device__ __forceinline__ int crow(int r, int hi) { return (r & 3) + 8 * (r >> 2) + 4 * hi; }
__device__ __forceinline__ unsigned cvtpk(float lo, float hi) { f32x2 v = {lo, hi}; bf16x2_t b = __builtin_convertvector(v, bf16x2_t); return __builtin_bit_cast(unsigned, b); }
__device__ __forceinline__ s16x4 vtr(const LAS unsigned char* p) { return __builtin_bit_cast(s16x4, __builtin_amdgcn_ds_read_tr16_b64_v4i16((LAS v4i16_t*)p)); }
__device__ __forceinline__ void dma16(const void* g, LAS unsigned char* l) {
    unsigned keep; const unsigned dst = (unsigned)__builtin_amdgcn_readfirstlane((int)(unsigned)(uintptr_t)l);
    asm volatile("s_mov_b32 %0, m0\n\ts_mov_b32 m0, %2\n\ts_nop 0\n\tglobal_load_lds_dwordx4 %1, off\n\ts_mov_b32 m0, %0" : "=&s"(keep) : "v"(g), "s"(dst) : "memory"); }
__device__ __forceinline__ float swap32(float x) { auto rr = __builtin_amdgcn_permlane32_swap(__float_as_uint(x), __float_as_uint(x), false, false); return __uint_as_float(((unsigned)(threadIdx.x & 32)) ? rr[0] : rr[1]); }
#define ATT_WAIT_BAR(N) asm volatile("s_waitcnt vmcnt(%0) lgkmcnt(0)\n\ts_barrier" :: "n"(N) : "memory")
__device__ __forceinline__ bf16x8 pfrag(const f32x16& w, int b8) { u32x4 u; u.x = cvtpk(w[b8], w[b8 + 1]); u.y = cvtpk(w[b8 + 2], w[b8 + 3]); u.z = cvtpk(w[b8 + 4], w[b8 + 5]); u.w = cvtpk(w[b8 + 6], w[b8 + 7]); return __builtin_bit_cast(bf16x8, u); }
__device__ __forceinline__ void v_load(bf16x8 (&vf)[8], const LAS unsigned char* vp) {
#pragma unroll
    for (int ks = 0; ks < 4; ++ks) {
        const s16x4 a0 = vtr(vp + ks * 1024), a1 = vtr(vp + ks * 1024 + 512), b0 = vtr(vp + 4096 + ks * 1024), b1 = vtr(vp + 4096 + ks * 1024 + 512);
        vf[2 * ks] = (bf16x8){a0[0], a0[1], a0[2], a0[3], a1[0], a1[1], a1[2], a1[3]}; vf[2 * ks + 1] = (bf16x8){b0[0], b0[1], b0[2], b0[3], b1[0], b1[1], b1[2], b1[3]};
    }
}
__device__ __forceinline__ void pv_tile(f32x16& o0, f32x16& o1, const bf16x8 (&vf)[8], const f32x16& w0, const f32x16& w1) {
#pragma unroll
    for (int ks = 0; ks < 4; ++ks) {
        const bf16x8 pf = pfrag(ks < 2 ? w0 : w1, 8 * (ks & 1));
        o0 = __builtin_amdgcn_mfma_f32_32x32x16_bf16(vf[2 * ks], pf, o0, 0, 0, 0);
        o1 = __builtin_amdgcn_mfma_f32_32x32x16_bf16(vf[2 * ks + 1], pf, o1, 0, 0, 0);
    }
}
__device__ __forceinline__ void store_o(bf16_t* orow, const f32x16& o0, const f32x16& o1, int hi, float sc, float* oss) {
    float sq = 0.f;
#pragma unroll
    for (int r = 0; r < 16; ++r) sq += o0[r] * o0[r] + o1[r] * o1[r];
    sq = (sq + xor32(sq)) * (sc * sc);
    if (hi == 0) *oss = sq;
#pragma unroll
    for (int g = 0; g < 4; ++g) {
        *(u32x2*)(orow + 8 * g + 4 * hi) = (u32x2){cvtpk(o0[4 * g] * sc, o0[4 * g + 1] * sc), cvtpk(o0[4 * g + 2] * sc, o0[4 * g + 3] * sc)};
        *(u32x2*)(orow + 32 + 8 * g + 4 * hi) = (u32x2){cvtpk(o1[4 * g] * sc, o1[4 * g + 1] * sc), cvtpk(o1[4 * g + 2] * sc, o1[4 * g + 3] * sc)};
    }
}

__device__ __forceinline__ void sb_unit(LAS unsigned char* lds, int tid, const bf16_t* QKV, bf16_t* OA, float* OSS, int b, int h, int qb) {
    asm volatile("" : "+v"(tid));
    const int lane = tid & 63, r32 = lane & 31, hi = lane >> 5, wid = __builtin_amdgcn_readfirstlane(tid >> 6);
    const size_t rowb = (size_t)b * SEQ; const int q0 = qb * 256;
    const bf16_t* Qw = QKV + (rowb + q0 + wid * 32) * 1536 + h * 64;
    const bf16_t* Kh = QKV + rowb * 1536 + 512 + h * 64; const bf16_t* Vh = Kh + 512;
    const int kt_hi = (q0 >> 6) + 3, NT = kt_hi + 1, jd = 3 - (wid >> 1);
    const bf16_t* ksrc = Kh + (size_t)lane * 1536 + wid * 8;
    const bf16_t* vsrc = Vh + (size_t)(16 * (wid & 3) + (lane >> 2)) * 1536 + (wid >> 2) * 32 + (lane & 3) * 8;
#define SB_ISSUE(j) do { int kt_ = kt_hi - (j); kt_ = kt_ < 0 ? 0 : kt_; LAS unsigned char* sl_ = lds + ((j) % NS) * 16384 + wid * 1024; \
        dma16(ksrc + (size_t)kt_ * 64 * 1536, sl_); dma16(vsrc + (size_t)kt_ * 64 * 1536, sl_ + 8192); } while (0)
    bf16x8 qr[4];
#pragma unroll
    for (int d0 = 0; d0 < 4; ++d0) qr[d0] = *(const bf16x8*)(Qw + (size_t)r32 * 1536 + d0 * 16 + hi * 8);
#pragma unroll
    for (int j = 0; j < PF; ++j) SB_ISSUE(j);
    asm volatile("" : "+v"(qr[0]), "+v"(qr[1]), "+v"(qr[2]), "+v"(qr[3]));
    f32x16 o0 = {}, o1 = {}; float carry = 0.f; bool mydone = false;
    const int q = q0 + wid * 32 + r32;
    volatile LAS unsigned* flags = (volatile LAS unsigned*)(lds + FLAG_OFF);
    const int vpo = ((lane >> 4) & 1) * 32 + (lane & 3) * 8 + (4 * hi + ((lane & 15) >> 2)) * 64;
    for (int j = 0; j < NT; ++j) {
        ATT_WAIT_BAR(2 * (PF - 1));
        if (j >= 1) { const u32x4 fa = *(const LAS u32x4*)(lds + FLAG_OFF + ((j - 1) & 1) * 32), fb = *(const LAS u32x4*)(lds + FLAG_OFF + ((j - 1) & 1) * 32 + 16);
            if ((fa.x & fa.y & fa.z & fa.w & fb.x & fb.y & fb.z & fb.w) != 0u) break; }
        SB_ISSUE(j + PF);
        if (j >= jd && !mydone) {
            const LAS unsigned char* ks = lds + (j % NS) * 16384;
            f32x16 z0 = {}, z1 = {};
            bf16x8 kf[8], vf[8];
#pragma unroll
            for (int d0 = 0; d0 < 4; ++d0) { kf[2 * d0] = *(const LAS bf16x8*)(ks + (2 * d0 + hi) * 1024 + r32 * 16); kf[2 * d0 + 1] = *(const LAS bf16x8*)(ks + (2 * d0 + hi) * 1024 + 512 + r32 * 16); }
            __builtin_amdgcn_sched_barrier(0);
#pragma unroll
            for (int d0 = 0; d0 < 4; ++d0) { z0 = __builtin_amdgcn_mfma_f32_32x32x16_bf16(kf[2 * d0], qr[d0], z0, 0, 0, 0); z1 = __builtin_amdgcn_mfma_f32_32x32x16_bf16(kf[2 * d0 + 1], qr[d0], z1, 0, 0, 0); }
            v_load(vf, ks + 8192 + vpo);
            __builtin_amdgcn_sched_barrier(0);
            const bool diag = (j == jd); const int kb = (kt_hi - j) * 64;
            f32x16 s0, s1;
#pragma unroll
            for (int r = 0; r < 16; ++r) { s0[r] = -flog2(1.f + fexp2(fminf(z0[r], 126.f))); s1[r] = -flog2(1.f + fexp2(fminf(z1[r], 126.f))); }
            if (diag) {
#pragma unroll
                for (int r = 0; r < 16; ++r) { if (kb + crow(r, hi) >= q) s0[r] = 0.f; if (kb + 32 + crow(r, hi) >= q) s1[r] = 0.f; }
            }
#pragma unroll
            for (int g = 0; g < 4; ++g) { s0[4 * g + 2] += s0[4 * g + 3]; s0[4 * g + 1] += s0[4 * g + 2]; s0[4 * g] += s0[4 * g + 1]; s1[4 * g + 2] += s1[4 * g + 3]; s1[4 * g + 1] += s1[4 * g + 2]; s1[4 * g] += s1[4 * g + 1]; }
            float I[9]; I[8] = 0.f;
#pragma unroll
            for (int g = 7; g >= 0; --g) I[g] = I[g + 1] + (g < 4 ? s0[4 * g] : s1[4 * (g - 4)]);
            float off[8];
#pragma unroll
            for (int g = 0; g < 8; ++g) off[g] = carry + I[g + 1] + swap32(hi ? I[g] : I[g + 1]);
            carry += I[0] + swap32(I[0]);
            f32x16 w0, w1;
#pragma unroll
            for (int r = 0; r < 16; ++r) { w0[r] = fexp2(z0[r] + s0[r] + off[r >> 2]); w1[r] = fexp2(z1[r] + s1[r] + off[4 + (r >> 2)]); }
            if (diag) {
#pragma unroll
                for (int r = 0; r < 16; ++r) { if (kb + crow(r, hi) >= q) w0[r] = 0.f; if (kb + 32 + crow(r, hi) >= q) w1[r] = 0.f; }
            }
            pv_tile(o0, o1, vf, w0, w1);
        }
        mydone = __all(carry < -150.f); if (lane == 0) flags[(j & 1) * 8 + wid] = mydone ? 1u : 0u;
    }
    store_o(OA + (rowb + q) * DM + h * 64, o0, o1, hi, 1.f, OSS + (rowb + q) * 16 + h);
    asm volatile("s_waitcnt lgkmcnt(0)\n\ts_barrier" ::: "memory");
#undef SB_ISSUE
}

__device__ __forceinline__ void mla_unit(LAS unsigned char* lds, int tid, const bf16_t* QM, const bf16_t* KN, const bf16_t* KR, const bf16_t* VM, bf16_t* OA, float* OSS, int b, int h, int qb) {
    asm volatile("" : "+v"(tid));
    const int lane = tid & 63, r32 = lane & 31, hi = lane >> 5, wid = __builtin_amdgcn_readfirstlane(tid >> 6);
    const size_t rowb = (size_t)b * SEQ; const int q0 = qb * 256;
    const bf16_t* Qw = QM + (rowb + q0 + wid * 32) * 768 + h * 96;
    const int NT = (q0 >> 6) + 4, mych = (q0 >> 6) + (wid >> 1);
    const bf16_t* ksrc = KN + (rowb + lane) * 512 + h * 64 + wid * 8;
    const bf16_t* rsrc = KR + (rowb + lane) * 32 + (wid & 3) * 8;
    const bf16_t* vsrc = VM + (rowb + 16 * (wid & 3) + (lane >> 2)) * 512 + h * 64 + (wid >> 2) * 32 + (lane & 3) * 8;
    constexpr int SLOT = 20480;
#define MLA_ISSUE(j) do { int kt_ = (j); kt_ = kt_ >= NT ? NT - 1 : kt_; LAS unsigned char* sl_ = lds + ((j) % NS) * SLOT; \
        dma16(ksrc + (size_t)kt_ * 64 * 512, sl_ + wid * 1024); dma16(rsrc + (size_t)kt_ * 64 * 32, sl_ + (8 + (wid & 3)) * 1024); dma16(vsrc + (size_t)kt_ * 64 * 512, sl_ + 12288 + wid * 1024); } while (0)
    bf16x8 qr[6];
#pragma unroll
    for (int d0 = 0; d0 < 6; ++d0) qr[d0] = *(const bf16x8*)(Qw + (size_t)r32 * 768 + d0 * 16 + hi * 8);
#pragma unroll
    for (int j = 0; j < PF; ++j) MLA_ISSUE(j);
    asm volatile("" : "+v"(qr[0]), "+v"(qr[1]), "+v"(qr[2]), "+v"(qr[3]), "+v"(qr[4]), "+v"(qr[5]));
    f32x16 o0 = {}, o1 = {}; float mx = -1.0e30f, lsum = 0.f;
    const int vpo = ((lane >> 4) & 1) * 32 + (lane & 3) * 8 + (4 * hi + ((lane & 15) >> 2)) * 64;
    for (int j = 0; j < NT; ++j) {
        ATT_WAIT_BAR(3 * (PF - 1));
        MLA_ISSUE(j + PF);
        if (j <= mych) {
            const LAS unsigned char* ks = lds + (j % NS) * SLOT;
            f32x16 z0 = {}, z1 = {};
            bf16x8 kf[12], vf[8];
#pragma unroll
            for (int d0 = 0; d0 < 6; ++d0) { kf[2 * d0] = *(const LAS bf16x8*)(ks + (2 * d0 + hi) * 1024 + r32 * 16); kf[2 * d0 + 1] = *(const LAS bf16x8*)(ks + (2 * d0 + hi) * 1024 + 512 + r32 * 16); }
            __builtin_amdgcn_sched_barrier(0);
#pragma unroll
            for (int d0 = 0; d0 < 6; ++d0) { z0 = __builtin_amdgcn_mfma_f32_32x32x16_bf16(kf[2 * d0], qr[d0], z0, 0, 0, 0); z1 = __builtin_amdgcn_mfma_f32_32x32x16_bf16(kf[2 * d0 + 1], qr[d0], z1, 0, 0, 0); }
            v_load(vf, ks + 12288 + vpo);
            __builtin_amdgcn_sched_barrier(0);
            float tm = fmaxf(z0[0], z1[0]);
#pragma unroll
            for (int r = 1; r < 16; ++r) tm = fmaxf(tm, fmaxf(z0[r], z1[r]));
            tm = fmaxf(tm, swap32(tm));
            const float mn = fmaxf(mx, tm), alpha = fexp2(mx - mn); mx = mn;
            float ps = 0.f;
#pragma unroll
            for (int r = 0; r < 16; ++r) { z0[r] = fexp2(z0[r] - mn); z1[r] = fexp2(z1[r] - mn); ps += z0[r] + z1[r]; }
            lsum = lsum * alpha + ps;
#pragma unroll
            for (int r = 0; r < 16; ++r) { o0[r] *= alpha; o1[r] *= alpha; }
            pv_tile(o0, o1, vf, z0, z1);
        }
    }
    lsum += swap32(lsum);
    store_o(OA + (rowb + q0 + wid * 32 + r32) * DM + 512 + h * 64, o0, o1, hi, 1.0f / lsum, OSS + (rowb + q0 + wid * 32 + r32) * 16 + 8 + h);
    asm volatile("s_waitcnt lgkmcnt(0)\n\ts_barrier" ::: "memory");
#undef MLA_ISSUE
}
}

__device__ __forceinline__ void phase_attn(Frame& F) {
    const bf16_t* QKV = wsp<bf16_t>(F, WS_QKV); bf16_t* OA = wsp<bf16_t>(F, WS_OA); float* OSS = wsp<float>(F, WS_OSS);
    const bf16_t* QM = wsp<bf16_t>(F, WS_QM); const bf16_t* KN = wsp<bf16_t>(F, WS_KN); const bf16_t* KR = wsp<bf16_t>(F, WS_KR); const bf16_t* VM = wsp<bf16_t>(F, WS_VM);
    const int vcu = (F.G % 8 == 0) ? (F.bx % 8) * (F.G / 8) + F.bx / 8 : F.bx;
    for (int p = vcu; p < 512; p += F.G) {
        const int bh = p >> 3, s = p & 7;
        att::mla_unit(F.lds, F.tid, QM, KN, KR, VM, OA, OSS, bh >> 3, bh & 7, 15 - s);
        att::mla_unit(F.lds, F.tid, QM, KN, KR, VM, OA, OSS, bh >> 3, bh & 7, s);
    }
    for (int u = vcu; u < 1024; u += F.G) { const int bh = u >> 4; att::sb_unit(F.lds, F.tid, QKV, OA, OSS, bh >> 3, bh & 7, u & 15); }
}

__device__ __forceinline__ DenseSched dense_sched(const Frame& F, int N, const void* Bt, int K) { DenseSched S; S.o.init(T, N, F.G, F.bx); S.Bt = (const char*)Bt; S.K = K; return S; }
__device__ __forceinline__ void phase_inproj(Frame& F, int l) {
    const DenseSched S = dense_sched(F, INP, F.ws + WS_WSM + (size_t)l * WSM_STRIDE + WSM_IN, DM);
    const EpiIn E{wsp<float>(F, WS_SSQ), wsp<bf16_t>(F, WS_QKV), wsp<bf16_t>(F, WS_CKV), wsp<bf16_t>(F, WS_CQ), wsp<bf16_t>(F, WS_KR), wsp<float>(F, WS_COS), wsp<float>(F, WS_SIN), wsp<float>(F, WS_RSCQ), wsp<float>(F, WS_RSCKV)};
    pg8::gemm_phase(F.lds, F.tid, (const char*)(F.ws + WS_HBI), DM, S, E);
}
__device__ __forceinline__ void phase_uq(Frame& F, int l) {
    const DenseSched S = dense_sched(F, 768, F.ws + WS_WSM + (size_t)l * WSM_STRIDE + WSM_UQ, QRANK);
    const EpiUq E{wsp<float>(F, WS_RSCQ), wsp<bf16_t>(F, WS_QM), wsp<float>(F, WS_COS), wsp<float>(F, WS_SIN)};
    pg8::gemm_phase(F.lds, F.tid, (const char*)(F.ws + WS_CQ), QRANK, S, E);
}
__device__ __forceinline__ void phase_ukv(Frame& F, int l) {
    const DenseSched S = dense_sched(F, 1024, F.ws + WS_WSM + (size_t)l * WSM_STRIDE + WSM_UKV, KVRANK);
    const EpiUkv E{wsp<float>(F, WS_RSCKV), wsp<bf16_t>(F, WS_KN), wsp<bf16_t>(F, WS_VM)};
    pg8::gemm_phase(F.lds, F.tid, (const char*)(F.ws + WS_CKV), KVRANK, S, E);
}
__device__ __forceinline__ void phase_outproj(Frame& F, int l, float* hout) {
    const DenseSched S = dense_sched(F, DM, F.ws + WS_WSM + (size_t)l * WSM_STRIDE + WSM_OUT, DM);
    EpiOut E; E.hin = l == 0 ? F.P->in[0] : wsp<float>(F, WS_H32); E.hout = hout; E.OSS = wsp<float>(F, WS_OSS);
    pg8::gemm_phase(F.lds, F.tid, (const char*)(F.ws + WS_OA), DM, S, E);
}
__device__ __forceinline__ void moe_table(Frame& F, int l) {
    LAS int* tb = (LAS int*)(F.lds + pg8::STAGE_BYTES);
    __syncthreads();
    if (F.tid == 0) { const unsigned* cnt = wsp<unsigned>(F, WS_CTL) + CW_CNT + 64 * 32 * l; int acc = 0;
        for (int e = 0; e < NEXP; ++e) { const int c = (int)__hip_atomic_load(cnt + 64 * e, __ATOMIC_RELAXED, __HIP_MEMORY_SCOPE_AGENT); tb[e] = acc; tb[40 + e] = c; acc += (c + 255) >> 8; }
        tb[32] = acc; }
    __syncthreads();
}
__device__ __forceinline__ void phase_moe1(Frame& F, int l) {
    moe_table(F, l);
    MoeSched S; S.G = F.G; S.c = F.bx; S.npn = 2; S.gather = 1; S.tb = (const LAS int*)(F.lds + pg8::STAGE_BYTES); S.liste = wsp<int>(F, WS_LISTE); S.Bt = (const char*)(F.ws + WS_WG1); S.K = DM; S.nB = 512;
    const EpiG1 E{wsp<float>(F, WS_RS), wsp<int>(F, WS_LISTE), wsp<bf16_t>(F, WS_HID)};
    pg8::gemm_phase(F.lds, F.tid, (const char*)(F.ws + WS_HB), DM, S, E);
}
__device__ __forceinline__ void phase_moe2(Frame& F, int l) {
    moe_table(F, l);
    MoeSched S; S.G = F.G; S.c = F.bx; S.npn = 4; S.gather = 0; S.tb = (const LAS int*)(F.lds + pg8::STAGE_BYTES); S.liste = wsp<int>(F, WS_LISTE); S.Bt = (const char*)(F.ws + WS_WD); S.K = DEXP; S.nB = 1024;
    const EpiDn E{wsp<int>(F, WS_LISTE), wsp<float>(F, WS_LISTW), wsp<bf16_t>(F, WS_Y)};
    pg8::gemm_phase(F.lds, F.tid, (const char*)(F.ws + WS_HID), DEXP, S, E);
}
__device__ __forceinline__ void phase_pe(Frame& F, int l) {
    const DenseSched S = dense_sched(F, DM, F.ws + WS_WSM + (size_t)l * WSM_STRIDE + WSM_PE, DPLE);
    const EpiBf E{wsp<bf16_t>(F, WS_PE), DM};
    pg8::gemm_phase(F.lds, F.tid, (const char*)(F.ws + WS_PB), DPLE, S, E);
}
__device__ __forceinline__ void phase_ple(Frame& F, int l, float* hout) {
    const DenseSched S = dense_sched(F, DM, F.ws + WS_WSM + (size_t)l * WSM_STRIDE + WSM_PG, DM);
    const EpiPle E{wsp<float>(F, WS_RS), wsp<bf16_t>(F, WS_PE), wsp<float>(F, WS_H32), hout, wsp<bf16_t>(F, WS_HBI), wsp<float>(F, WS_SSQ)};
    pg8::gemm_phase(F.lds, F.tid, (const char*)(F.ws + WS_HB), DM, S, E);
}

#ifndef PROBE
#define PROBE 0
#endif
constexpr int CW_BAR = 4096;
constexpr int MISC_OFF = 150 * 1024;
static_assert(CW_BAR + XCD_BAR_WORDS <= CW_CNT && (CW_CNT + 64 * 32 * 2 * NLAYER) * 4 <= (int)CTL_BYTES && (CW_BAR + XCD_BAR_WORDS) * 4 <= (int)CTL_BYTES && MISC_OFF + 16 <= LDS_BYTES, "control words");
__global__ void __launch_bounds__(NTHREADS, 2) mega_fwd(Params P) {
    extern __shared__ __attribute__((aligned(16))) unsigned char lds_raw[];
    Frame F; F.lds = (LAS unsigned char*)lds_raw; F.tid = threadIdx.x; F.lane = F.tid & 63; F.wave = __builtin_amdgcn_readfirstlane(F.tid >> 6); F.G = gridDim.x; F.bx = blockIdx.x; F.P = &P; F.ws = P.ws;
    volatile LAS unsigned* st = (volatile LAS unsigned*)(F.lds + MISC_OFF);
    if (F.tid < 4) st[F.tid] = 0u;
    __syncthreads();
    const XcdBarrier bar = xcd_barrier_post(wsp<unsigned>(F, WS_CTL) + CW_BAR, st);
#define GRID_BAR() do { XcdBarrier b_ = bar; asm volatile("" : "+s"(b_.x)); asm volatile("" : "+s"(b_.bar)); xcd_barrier(b_); PH_BEGIN(); } while (0)
#define PH_BEGIN() do { asm volatile("" : "+v"(F.tid)); F.lane = F.tid & 63; asm volatile("" : "+s"(F.ws)); } while (0)
    phase_prep_small(F);
    phase_norm(F, P.in[0]);
#if PROBE == 11
    __syncthreads(); PH_BEGIN(); phase_prep_small(F); phase_norm(F, P.in[0]);
#endif
    GRID_BAR();
#if PROBE == 13
    GRID_BAR(); GRID_BAR(); GRID_BAR(); GRID_BAR(); GRID_BAR(); GRID_BAR(); GRID_BAR(); GRID_BAR(); GRID_BAR(); GRID_BAR();
    GRID_BAR(); GRID_BAR(); GRID_BAR(); GRID_BAR(); GRID_BAR(); GRID_BAR(); GRID_BAR(); GRID_BAR(); GRID_BAR(); GRID_BAR();
#endif
#pragma unroll 1
    for (int l = 0; l < NLAYER; ++l) {
        PH_BEGIN();
        phase_inproj(F, l);
        PH_BEGIN();
        phase_prep_moe(F, l);
        GRID_BAR();
        phase_uq(F, l);
        PH_BEGIN();
        phase_ukv(F, l);
        GRID_BAR();
        phase_attn(F);
        GRID_BAR();
        phase_outproj(F, l, wsp<float>(F, WS_H32));
        GRID_BAR();
        phase_route(F, l);
        GRID_BAR();
        phase_moe1(F, l);
        PH_BEGIN();
        phase_pe(F, l);
        GRID_BAR();
        phase_moe2(F, l);
        GRID_BAR();
        phase_norm2(F, l, 1.f);
        GRID_BAR();
        phase_ple(F, l, wsp<float>(F, WS_H32));
        GRID_BAR();
    }
    phase_final(F);
#undef GRID_BAR
#undef PH_BEGIN
}

extern "C" void kernel_launch(void* const* d_in, const int* in_sizes, int n_in, void* d_out, int out_size, void* d_ws, size_t ws_size, hipStream_t stream) {
    if (n_in != 24 || out_size != T * DM || ws_size < WS_END) { fprintf(stderr, "kernel_launch: unexpected shapes (n_in %d, out %d, ws %zu < %zu)\n", n_in, out_size, ws_size, (size_t)WS_END); return; }
    Params P{};
    for (int i = 0; i < 24; ++i) P.in[i] = (const float*)d_in[i];
    P.out = (float*)d_out; P.ws = (unsigned char*)d_ws;
    for (int i = 0; i < 16; ++i) P.inv_freq[i] = (float)pow(10000.0, -(double)i / 16.0);
    (void)hipMemsetAsync((char*)d_ws + WS_CTL, 0, CTL_BYTES, stream);
    static int grid = 0;
    if (grid == 0) {
        int dev = 0, cus = 0;
        if (hipGetDevice(&dev) != hipSuccess || hipDeviceGetAttribute(&cus, hipDeviceAttributeMultiprocessorCount, dev) != hipSuccess || cus <= 0) { grid = -1; return; }
        if (hipFuncSetAttribute((const void*)mega_fwd, hipFuncAttributeMaxDynamicSharedMemorySize, LDS_BYTES) != hipSuccess) { fprintf(stderr, "kernel_launch: hipFuncSetAttribute failed\n"); grid = -1; return; }
        grid = cus;
    }
    if (grid < 0) return;
    hipLaunchKernelGGL(mega_fwd, dim3(grid), dim3(NTHREADS), LDS_BYTES, stream, P);
}
```

```cpp
#include <hip/hip_runtime.h>
#include <cstdio>
#include <cstdint>
#include <cmath>

#define GAS __attribute__((address_space(1)))
#define LAS __attribute__((address_space(3)))
typedef unsigned short bf16_t;
typedef short bf16x8 __attribute__((ext_vector_type(8)));
typedef float f32x4 __attribute__((ext_vector_type(4)));
typedef float f32x2 __attribute__((ext_vector_type(2)));
typedef unsigned u32x4 __attribute__((ext_vector_type(4)));
typedef unsigned u32x2 __attribute__((ext_vector_type(2)));

constexpr int NB = 8, SEQ = 4096, DM = 1024, NLAYER = 4, T = NB * SEQ;
constexpr int DPLE = 256, SBW = 512, MLAW = 512, QRANK = 384, KVRANK = 256, ROPE = 32, QKD = 96;
constexpr int INC = 2208, INP = 2304;
constexpr int NEXP = 32, DEXP = 256;
constexpr float EPS = 1e-6f;
constexpr float LOG2E = 1.4426950408889634f;
constexpr float QS_SB = 0.125f * LOG2E;
constexpr float QS_MLA = 0.10206207261596575f * LOG2E;
constexpr int NWAVES = 8, NTHREADS = 512;

constexpr size_t MiB = 1u << 20;
constexpr size_t WS_CTL = 0, CTL_BYTES = 1 * MiB;
constexpr size_t WS_COS = 1 * MiB, WS_SIN = 3 * MiB;
constexpr size_t WS_RS = 5 * MiB, WS_RSCQ = 6 * MiB, WS_RSCKV = 7 * MiB;
constexpr size_t WS_LISTE = 8 * MiB, WS_LISTW = 12 * MiB;
constexpr size_t WS_WR = 16 * MiB;
constexpr size_t WS_WSM = 18 * MiB, WSM_STRIDE = 11 * MiB;
constexpr size_t WSM_IN = 0, WSM_OUT = 4608 * 1024, WSM_PG = WSM_OUT + 2 * MiB, WSM_UQ = WSM_PG + 2 * MiB, WSM_UKV = WSM_UQ + 576 * 1024, WSM_PE = WSM_UKV + 512 * 1024;
constexpr size_t WS_WG1 = 62 * MiB, WS_WD = 94 * MiB;
constexpr size_t WS_H32 = 110 * MiB, WS_HB = 238 * MiB;
constexpr size_t WS_ATT = 302 * MiB;
constexpr size_t WS_QKV = WS_ATT, WS_CKV = WS_ATT + 96 * MiB, WS_CQ = WS_CKV + 16 * MiB, WS_KR = WS_CQ + 24 * MiB, WS_QM = WS_KR + 2 * MiB,
                 WS_KN = WS_QM + 48 * MiB, WS_VM = WS_KN + 32 * MiB, WS_OA = WS_VM + 32 * MiB, WS_ATT_END = WS_OA + 64 * MiB;
constexpr size_t WS_HBI = WS_H32;
constexpr size_t WS_HID = WS_ATT, WS_Y = WS_ATT + 36 * MiB, WS_PE = WS_Y + 128 * MiB, WS_PB = WS_PE + 64 * MiB, WS_MOE_END = WS_PB + 16 * MiB;
constexpr size_t WS_SSQ = (WS_ATT_END > WS_MOE_END ? WS_ATT_END : WS_MOE_END), WS_OSS = WS_SSQ + 2 * MiB, WS_END = WS_OSS + 2 * MiB;
static_assert(WSM_PE + 512 * 1024 <= WSM_STRIDE, "small weights");
static_assert(WS_WSM + 4 * WSM_STRIDE <= WS_WG1, "ws map");
constexpr int CW_CNT = 8192;

constexpr int LDS_BYTES = 152 * 1024;

struct Params {
    const float* in[24];
    float* out;
    unsigned char* ws;
    float inv_freq[16];
};

__device__ __forceinline__ float bf2f(unsigned v) { return __uint_as_float(v << 16); }
__device__ __forceinline__ unsigned f2bf(float f) { unsigned u = __float_as_uint(f); return (u + 0x7fffu + ((u >> 16) & 1u)) >> 16; }
__device__ __forceinline__ unsigned pk2(float lo, float hi) { return f2bf(lo) | (f2bf(hi) << 16); }
template <int CTRL> __device__ __forceinline__ float dpp_f(float v) { return __uint_as_float((unsigned)__builtin_amdgcn_update_dpp(0, (int)__float_as_uint(v), CTRL, 0xf, 0xf, true)); }
__device__ __forceinline__ float row16_sum(float v) {
    v += dpp_f<0xB1>(v); v += dpp_f<0x4E>(v); v += dpp_f<0x141>(v); v += dpp_f<0x140>(v); return v; }
__device__ __forceinline__ float wave_sum(float v) {
    v = row16_sum(v);
    const float a = __uint_as_float(__builtin_amdgcn_readlane((int)__float_as_uint(v), 0)), b = __uint_as_float(__builtin_amdgcn_readlane((int)__float_as_uint(v), 16)),
                c = __uint_as_float(__builtin_amdgcn_readlane((int)__float_as_uint(v), 32)), d = __uint_as_float(__builtin_amdgcn_readlane((int)__float_as_uint(v), 48));
    return (a + b) + (c + d);
}
__device__ __forceinline__ float half32_sum(float v) {
    v = row16_sum(v);
    auto rr = __builtin_amdgcn_permlane16_swap(__float_as_uint(v), __float_as_uint(v), false, false);
    return __uint_as_float(rr[0]) + __uint_as_float(rr[1]);
}
__device__ __forceinline__ float xor32(float x) { auto rr = __builtin_amdgcn_permlane32_swap(__float_as_uint(x), __float_as_uint(x), false, false); return __uint_as_float(((unsigned)(threadIdx.x & 32)) ? rr[0] : rr[1]); }
__device__ __forceinline__ float xor16(float x) { auto rr = __builtin_amdgcn_permlane16_swap(__float_as_uint(x), __float_as_uint(x), false, false); return __uint_as_float(((unsigned)(threadIdx.x & 16)) ? rr[0] : rr[1]); }
__device__ __forceinline__ float fexp2(float x) { return __builtin_amdgcn_exp2f(x); }
__device__ __forceinline__ float flog2(float x) { return __builtin_amdgcn_logf(x); }
__device__ __forceinline__ float frcp(float x) { return __builtin_amdgcn_rcpf(x); }
__device__ __forceinline__ void unpack8(u32x4 w, float* f) {
    f[0] = __uint_as_float(w.x << 16); f[1] = __uint_as_float(w.x & 0xffff0000u);
    f[2] = __uint_as_float(w.y << 16); f[3] = __uint_as_float(w.y & 0xffff0000u);
    f[4] = __uint_as_float(w.z << 16); f[5] = __uint_as_float(w.z & 0xffff0000u);
    f[6] = __uint_as_float(w.w << 16); f[7] = __uint_as_float(w.w & 0xffff0000u);
}
__device__ __forceinline__ u32x4 pack8(f32x4 a, f32x4 b) { u32x4 w; w.x = pk2(a[0], a[1]); w.y = pk2(a[2], a[3]); w.z = pk2(b[0], b[1]); w.w = pk2(b[2], b[3]); return w; }

__device__ __forceinline__ float rstd_part16(const float* p, float inv_n) { const f32x4 a = ((const f32x4*)p)[0], b = ((const f32x4*)p)[1], c = ((const f32x4*)p)[2], d = ((const f32x4*)p)[3];
    const f32x4 s4 = (a + b) + (c + d); return 1.0f / sqrtf(((s4[0] + s4[1]) + (s4[2] + s4[3])) * inv_n + EPS); }
__device__ __forceinline__ float rstd_part8(const float* p, float inv_n) { const f32x4 a = ((const f32x4*)p)[0], b = ((const f32x4*)p)[1]; const f32x4 s4 = a + b; return 1.0f / sqrtf(((s4[0] + s4[1]) + (s4[2] + s4[3])) * inv_n + EPS); }
__device__ __forceinline__ float rstd_part4(const float* p, float inv_n) { const f32x4 a = ((const f32x4*)p)[0]; return 1.0f / sqrtf(((a[0] + a[1]) + (a[2] + a[3])) * inv_n + EPS); }
__device__ __forceinline__ float sq8(const f32x4& a, const f32x4& b) { return ((a[0] * a[0] + a[1] * a[1]) + (a[2] * a[2] + a[3] * a[3])) + ((b[0] * b[0] + b[1] * b[1]) + (b[2] * b[2] + b[3] * b[3])); }
__device__ __forceinline__ float fq_sum(float v) { v += xor16(v); v += xor32(v); return v; }

namespace pg8 {
constexpr int BM = 256, BK = 64, HALF = 128, HTB = HALF * BK * 2, STAGE_BYTES = 8 * HTB, NXCD = 8, WGM = 8;
__host__ __device__ __forceinline__ int lds_byte(int r, int c) { const int st = (r >> 4) * 2 + (c >> 5), rr = r & 15, cc = c & 31, ob = rr * 64 + cc * 2; return st * 1024 + (ob ^ (((ob >> 9) & 1) << 5)); }
__host__ __device__ __forceinline__ void stage_rc(int b, int& R, int& C) { const int st = b / 1024, sb = b % 1024, swz = sb ^ (((sb >> 9) & 1) << 5); R = (st >> 1) * 16 + swz / 64; C = (st & 1) * 32 + (swz % 64) / 2; }
__host__ __device__ __forceinline__ int perm32(int rho) { const int n = rho >> 4, i = rho & 15; return 8 * (i >> 2) + 4 * n + (i & 3); }

struct Unit { int pm, pn, e, tile, nrows; };

struct StaticOrder {
    int nM, nN, nwg, G, c;
    __device__ void init(int M, int N, int G_, int c_) { nM = M / BM; nN = N / BM; nwg = nM * nN; G = G_; c = c_; }
    __device__ bool next(int i, Unit& u) const {
        const long L = (long)i * G + c; if (L >= nwg) return false;
        int wgid = (int)L; { const int q = nwg / NXCD, r = nwg % NXCD, xcd = wgid % NXCD, off = wgid / NXCD; wgid = (xcd < r ? xcd * (q + 1) : r * (q + 1) + (xcd - r) * q) + off; }
        const int nig = WGM * nN, gid = wgid / nig, fm = gid * WGM, gsz = (nM - fm) < WGM ? (nM - fm) : WGM;
        u.pm = fm + ((wgid % nig) % gsz); u.pn = (wgid % nig) / gsz; u.e = 0; u.tile = 0; u.nrows = 256; return true;
    }
};

template <class Epi, class Sched>
__device__ __forceinline__ void gemm_phase(LAS unsigned char* lds, const int tid, const char* Abase, const int K, const Sched& S, const Epi& E) {
    const int wid = __builtin_amdgcn_readfirstlane(tid >> 6), lane = tid & 63, wr = wid >> 2, wc = wid & 3, fr = lane & 15, fq = lane >> 4;
    const int nt = K / BK;
    unsigned voffB[2];
#pragma unroll
    for (int i = 0; i < 2; ++i) { int R, C; stage_rc(tid * 16 + i * 8192, R, C); const int Rb = (R & ~31) + perm32(R & 31); voffB[i] = (unsigned)(Rb * K + C) * 2u; }
    const size_t kstep = (size_t)(BK * 2);
    const size_t hstep = (size_t)HALF * K * 2;
    const unsigned ldsw = (unsigned)wid * 1024u;
    const int aoff = lds_byte(wr * 64 + fr, fq * 8), boff = lds_byte(wc * 32 + fr, fq * 8);
#define PG8_SA(b, h) (((b) * 2 + (h)) * HTB)
#define PG8_SB(b, h) ((4 + (b) * 2 + (h)) * HTB)
#define PG8_STAGE(bufoff, gbase, voff) do { _Pragma("unroll") for (int _i = 0; _i < 2; ++_i) \
        __builtin_amdgcn_global_load_lds((const unsigned*)((const char*)(gbase) + (voff)[_i]), (LAS unsigned*)(lds + (bufoff) + ldsw + _i * 8192), 16, 0, 0); } while (0)
#define PG8_LDA(dst, b, h) do { _Pragma("unroll") for (int m = 0; m < 4; ++m) _Pragma("unroll") for (int k = 0; k < 2; ++k) dst[m][k] = *(const LAS bf16x8*)(lds + PG8_SA(b, h) + aoff + m * 2048 + k * 1024); } while (0)
#define PG8_LDB(dst, b, h) do { _Pragma("unroll") for (int n = 0; n < 2; ++n) _Pragma("unroll") for (int k = 0; k < 2; ++k) dst[n][k] = *(const LAS bf16x8*)(lds + PG8_SB(b, h) + boff + n * 2048 + k * 1024); } while (0)
#define PG8_MMA(ai, bj, At, Bt) do { __builtin_amdgcn_s_setprio(1); _Pragma("unroll") for (int m = 0; m < 4; ++m) _Pragma("unroll") for (int n = 0; n < 2; ++n) _Pragma("unroll") for (int k = 0; k < 2; ++k) \
        acc[ai][bj][m][n] = __builtin_amdgcn_mfma_f32_16x16x32_bf16(Bt[n][k], At[m][k], acc[ai][bj][m][n], 0, 0, 0); __builtin_amdgcn_s_setprio(0); } while (0)
#define PG8_WAIT_V(n) asm volatile("s_waitcnt vmcnt(" #n ")" ::: "memory")
#define PG8_WAIT_L(n) asm volatile("s_waitcnt lgkmcnt(" #n ")" ::: "memory")
#define PG8_BAR __builtin_amdgcn_s_barrier()
#define PG8_SCHED __builtin_amdgcn_sched_barrier(0)
    Unit cur, nxt; int ui = 0;
    if (!S.next(0, cur)) return;
    f32x4 acc[2][2][4][2];
#pragma unroll
    for (int a = 0; a < 2; ++a)
#pragma unroll
        for (int b = 0; b < 2; ++b)
#pragma unroll
            for (int m = 0; m < 4; ++m)
#pragma unroll
                for (int n = 0; n < 2; ++n) acc[a][b][m][n] = (f32x4){0.f, 0.f, 0.f, 0.f};
    bf16x8 At[4][2], B0[2][2], B1[2][2];
    unsigned vc[2][2];
    LAS u32x4* vslot = (LAS u32x4*)(lds + STAGE_BYTES + 1024) + tid;
#define PG8_AOFFS(dst, U) do { int t2_ = tid; asm volatile("" : "+v"(t2_)); _Pragma("unroll") for (int i = 0; i < 2; ++i) { int R, C; stage_rc(t2_ * 16 + i * 8192, R, C); \
        dst[0][i] = S.a_off(U, R) + (unsigned)C * 2u; dst[1][i] = S.a_off(U, HALF + R) + (unsigned)C * 2u; } } while (0)
    PG8_AOFFS(vc, cur);
    const char* cB = S.b_tile(cur);
    E.begin(cur, ui, tid, lds);
    PG8_STAGE(PG8_SB(0, 0), cB, voffB); PG8_STAGE(PG8_SB(0, 1), cB + hstep, voffB); PG8_STAGE(PG8_SA(0, 0), Abase, vc[0]); PG8_STAGE(PG8_SA(0, 1), Abase, vc[1]);
    if (wr == 1) PG8_BAR;
    PG8_WAIT_V(2); PG8_BAR;
    PG8_STAGE(PG8_SB(1, 0), cB + kstep, voffB); PG8_STAGE(PG8_SA(1, 0), Abase + kstep, vc[0]); PG8_STAGE(PG8_SB(1, 1), cB + hstep + kstep, voffB);
    PG8_WAIT_V(6); PG8_BAR;
    for (;;) {
        const bool has_next = S.next(ui + 1, nxt);
        const char* nB = cB;
        { unsigned vn[2][2];
          if (has_next) { PG8_AOFFS(vn, nxt); nB = S.b_tile(nxt); *vslot = (u32x4){vn[0][0], vn[0][1], vn[1][0], vn[1][1]}; }
          else *vslot = (u32x4){vc[0][0], vc[0][1], vc[1][0], vc[1][1]}; }
        for (int t = 0; t < nt; t += 2) {
            if constexpr (Epi::MID) { if (t == (nt >> 1)) E.mid(acc, ui, wr, fr, lds); }
            const bool last = (t == nt - 2);
            const char* a1 = Abase + (size_t)(t + 1) * kstep;
            const char* a2 = last ? Abase : Abase + (size_t)(t + 2) * kstep; const char* b2 = last ? nB : cB + (size_t)(t + 2) * kstep;
            const char* a3 = a2 + kstep; const char* b3 = b2 + kstep;
            unsigned w2[2][2];
            if (last) { const u32x4 q = *vslot; w2[0][0] = q.x; w2[0][1] = q.y; w2[1][0] = q.z; w2[1][1] = q.w; }
            else { w2[0][0] = vc[0][0]; w2[0][1] = vc[0][1]; w2[1][0] = vc[1][0]; w2[1][1] = vc[1][1]; }
            PG8_LDB(B0, 0, 0); PG8_LDB(B1, 0, 1); PG8_SCHED; PG8_LDA(At, 0, 0); PG8_STAGE(PG8_SA(1, 1), a1, vc[1]);
            PG8_WAIT_V(8); PG8_WAIT_L(0); PG8_BAR; PG8_MMA(0, 0, At, B0); PG8_MMA(0, 1, At, B1); PG8_BAR; PG8_SCHED;
            PG8_LDA(At, 0, 1); PG8_STAGE(PG8_SB(0, 0), b2, voffB); PG8_STAGE(PG8_SB(0, 1), b2 + hstep, voffB); PG8_STAGE(PG8_SA(0, 0), a2, w2[0]);
            PG8_WAIT_V(8); PG8_WAIT_L(0); PG8_BAR; PG8_MMA(1, 0, At, B0); PG8_MMA(1, 1, At, B1); PG8_BAR; PG8_SCHED;
            PG8_LDB(B0, 1, 0); PG8_LDB(B1, 1, 1); PG8_SCHED; PG8_LDA(At, 1, 0); PG8_STAGE(PG8_SA(0, 1), a2, w2[1]);
            PG8_WAIT_V(8); PG8_WAIT_L(0); PG8_BAR; PG8_MMA(0, 0, At, B0); PG8_MMA(0, 1, At, B1); PG8_BAR; PG8_SCHED;
            PG8_LDA(At, 1, 1); PG8_STAGE(PG8_SB(1, 0), b3, voffB); PG8_STAGE(PG8_SB(1, 1), b3 + hstep, voffB); PG8_STAGE(PG8_SA(1, 0), a3, w2[0]);
            PG8_WAIT_V(8); PG8_WAIT_L(0); PG8_BAR; PG8_MMA(1, 0, At, B0); PG8_MMA(1, 1, At, B1); PG8_BAR; PG8_SCHED;
        }
        if (wr == 0) PG8_BAR;
        { int fr2 = fr, fq2 = fq; asm volatile("" : "+v"(fr2), "+v"(fq2));
          E(acc, cur, ui, wr, wc, fr2, fq2, lds); }
        if (!has_next) break;
#pragma unroll
        for (int a = 0; a < 2; ++a)
#pragma unroll
            for (int b = 0; b < 2; ++b)
#pragma unroll
                for (int m = 0; m < 4; ++m)
#pragma unroll
                    for (int n = 0; n < 2; ++n) acc[a][b][m][n] = (f32x4){0.f, 0.f, 0.f, 0.f};
        cur = nxt; cB = nB; ++ui;
        E.begin(cur, ui, tid, lds);
        { const u32x4 q = *vslot; vc[0][0] = q.x; vc[0][1] = q.y; vc[1][0] = q.z; vc[1][1] = q.w; }
        if (wr == 1) PG8_BAR;
    }
    PG8_WAIT_V(0);
    PG8_BAR;
#undef PG8_AOFFS
#undef PG8_SA
#undef PG8_SB
#undef PG8_STAGE
#undef PG8_LDA
#undef PG8_LDB
#undef PG8_MMA
#undef PG8_WAIT_V
#undef PG8_WAIT_L
#undef PG8_BAR
#undef PG8_SCHED
}
}
using pg8::Unit;

struct DenseSched {
    pg8::StaticOrder o; const char* Bt; int K;
    __device__ __forceinline__ bool next(int i, Unit& u) const { return o.next(i, u); }
    __device__ __forceinline__ unsigned a_off(const Unit& u, int r) const { return (unsigned)(u.pm * 256 + r) * (unsigned)(K * 2); }
    __device__ __forceinline__ const char* b_tile(const Unit& u) const { return Bt + (size_t)u.pn * 256 * K * 2; }
};
struct MoeSched {
    int G, c, npn, gather; const LAS int* tb; const int* liste; const char* Bt; int K, nB;
    __device__ __forceinline__ bool next(int i, Unit& u) const {
        const int L = i * G + c, ntile = tb[32];
        if (L >= ntile * npn) return false;
        const int ti = L / npn; u.pn = L % npn; u.pm = ti;
        int e = 0;
#pragma unroll 1
        for (; e < 31; ++e) if (ti < tb[e + 1]) break;
        u.e = e; u.tile = ti - tb[e]; const int rem = tb[40 + e] - 256 * u.tile; u.nrows = rem < 256 ? rem : 256; return true;
    }
    __device__ __forceinline__ unsigned a_off(const Unit& u, int r) const {
        if (gather) { int tok = 0; if (r < u.nrows) tok = liste[(size_t)u.e * T + 256 * u.tile + r] >> 1; return (unsigned)tok * (unsigned)(K * 2); }
        return (unsigned)(u.pm * 256 + r) * (unsigned)(K * 2);
    }
    __device__ __forceinline__ const char* b_tile(const Unit& u) const { return Bt + ((size_t)u.e * nB + (size_t)u.pn * 256) * K * 2; }
};

#define EPI_DEFAULTS static constexpr bool MID = false; __device__ __forceinline__ void begin(const Unit&, int, int, LAS unsigned char*) const {}
struct EpiIn {
    EPI_DEFAULTS
    const float* SSQ; bf16_t* QKV; bf16_t* CKV; bf16_t* CQ; bf16_t* KR; const float* COS; const float* SIN; float* SQQ; float* SQK;
    __device__ __forceinline__ void operator()(const f32x4 (&acc)[2][2][4][2], const Unit& u, int ui, int wr, int wc, int fr, int fq, LAS unsigned char* lds) const {
        const int pn = u.pn;
#pragma unroll
        for (int ai = 0; ai < 2; ++ai)
#pragma unroll
            for (int m = 0; m < 4; ++m) {
                const int row = u.pm * 256 + ai * 128 + wr * 64 + m * 16 + fr; const float rs = rstd_part16(SSQ + (size_t)row * 16, 1.f / DM);
                float sq = 0.f;
#pragma unroll
                for (int bj = 0; bj < 2; ++bj) {
                    const int c = bj * 128 + wc * 32 + fq * 8;
                    f32x4 v0 = acc[ai][bj][m][0] * rs, v1 = acc[ai][bj][m][1] * rs;
                    if (pn < 6) { if (pn < 2) { v0 = v0 * QS_SB; v1 = v1 * QS_SB; } *(u32x4*)(QKV + (size_t)row * 1536 + pn * 256 + c) = pack8(v0, v1); }
                    else if (pn == 6) { *(u32x4*)(CKV + (size_t)row * 256 + c) = pack8(v0, v1); sq += sq8(v0, v1); }
                    else if (pn == 7) { *(u32x4*)(CQ + (size_t)row * 384 + c) = pack8(v0, v1); sq += sq8(v0, v1); }
                    else if (bj == 0) { *(u32x4*)(CQ + (size_t)row * 384 + 256 + c) = pack8(v0, v1); sq += sq8(v0, v1); }
                    else if (wc == 0) {
                        const int ib = 8 * (fq & 1);
                        const f32x4 c0 = *(const f32x4*)(COS + (size_t)row * 16 + ib), c1 = *(const f32x4*)(COS + (size_t)row * 16 + ib + 4);
                        const f32x4 s0 = *(const f32x4*)(SIN + (size_t)row * 16 + ib), s1 = *(const f32x4*)(SIN + (size_t)row * 16 + ib + 4);
                        f32x4 p0, p1;
#pragma unroll
                        for (int i = 0; i < 4; ++i) { p0[i] = xor32(v0[i]); p1[i] = xor32(v1[i]); }
                        const float sg = (fq < 2) ? -1.f : 1.f;
                        const f32x4 o0 = v0 * c0 + p0 * s0 * sg, o1 = v1 * c1 + p1 * s1 * sg;
                        *(u32x4*)(KR + (size_t)row * 32 + fq * 8) = pack8(o0, o1);
                    }
                }
                if (pn >= 6) {
                    sq = fq_sum(sq);
                    if (fq == 0) { if (pn == 6) SQK[(size_t)row * 4 + wc] = sq; else SQQ[(size_t)row * 8 + (pn - 7) * 4 + wc] = sq; }
                }
                asm volatile("" ::: "memory");
            }
    }
};
struct EpiUq {
    EPI_DEFAULTS
    const float* RS; bf16_t* QM; const float* COS; const float* SIN;
    __device__ __forceinline__ void operator()(const f32x4 (&acc)[2][2][4][2], const Unit& u, int ui, int wr, int wc, int fr, int fq, LAS unsigned char* lds) const {
#pragma unroll
        for (int ai = 0; ai < 2; ++ai)
#pragma unroll
            for (int m = 0; m < 4; ++m) {
                const int row = u.pm * 256 + ai * 128 + wr * 64 + m * 16 + fr; const float rs = rstd_part8(RS + (size_t)row * 8, 1.f / QRANK) * QS_MLA;
#pragma unroll
                for (int bj = 0; bj < 2; ++bj) {
                    const int c = u.pn * 256 + bj * 128 + wc * 32 + fq * 8; const int g32 = u.pn * 8 + bj * 4 + wc;
                    f32x4 v0 = acc[ai][bj][m][0] * rs, v1 = acc[ai][bj][m][1] * rs;
                    if ((g32 % 3) == 2) {
                        const int ib = 8 * (fq & 1);
                        const f32x4 c0 = *(const f32x4*)(COS + (size_t)row * 16 + ib), c1 = *(const f32x4*)(COS + (size_t)row * 16 + ib + 4);
                        const f32x4 s0 = *(const f32x4*)(SIN + (size_t)row * 16 + ib), s1 = *(const f32x4*)(SIN + (size_t)row * 16 + ib + 4);
                        f32x4 p0, p1;
#pragma unroll
                        for (int i = 0; i < 4; ++i) { p0[i] = xor32(v0[i]); p1[i] = xor32(v1[i]); }
                        const float sg = (fq < 2) ? -1.f : 1.f;
                        v0 = v0 * c0 + p0 * s0 * sg; v1 = v1 * c1 + p1 * s1 * sg;
                    }
                    *(u32x4*)(QM + (size_t)row * 768 + c) = pack8(v0, v1);
                }
                asm volatile("" ::: "memory");
            }
    }
};
struct EpiUkv {
    EPI_DEFAULTS
    const float* RS; bf16_t* KN; bf16_t* VM;
    __device__ __forceinline__ void operator()(const f32x4 (&acc)[2][2][4][2], const Unit& u, int ui, int wr, int wc, int fr, int fq, LAS unsigned char* lds) const {
        bf16_t* dst = u.pn < 2 ? KN : VM; const int cb = (u.pn & 1) * 256;
#pragma unroll
        for (int ai = 0; ai < 2; ++ai)
#pragma unroll
            for (int m = 0; m < 4; ++m) {
                const int row = u.pm * 256 + ai * 128 + wr * 64 + m * 16 + fr; const float rs = rstd_part4(RS + (size_t)row * 4, 1.f / KVRANK);
#pragma unroll
                for (int bj = 0; bj < 2; ++bj) { const int c = cb + bj * 128 + wc * 32 + fq * 8;
                    *(u32x4*)(dst + (size_t)row * 512 + c) = pack8(acc[ai][bj][m][0] * rs, acc[ai][bj][m][1] * rs); }
            }
    }
};
struct EpiBf {
    EPI_DEFAULTS
    bf16_t* O; int ldc;
    __device__ __forceinline__ void operator()(const f32x4 (&acc)[2][2][4][2], const Unit& u, int ui, int wr, int wc, int fr, int fq, LAS unsigned char* lds) const {
#pragma unroll
        for (int ai = 0; ai < 2; ++ai)
#pragma unroll
            for (int m = 0; m < 4; ++m) {
                const int row = u.pm * 256 + ai * 128 + wr * 64 + m * 16 + fr;
#pragma unroll
                for (int bj = 0; bj < 2; ++bj) { const int c = u.pn * 256 + bj * 128 + wc * 32 + fq * 8;
                    *(u32x4*)(O + (size_t)row * ldc + c) = pack8(acc[ai][bj][m][0], acc[ai][bj][m][1]); }
            }
    }
};
constexpr int OTAB_OFF = pg8::STAGE_BYTES + 1024 + 8192;
struct EpiOut {
    static constexpr bool MID = true;
    const float* xin; const bf16_t* hin; bf16_t* hout; const float* OSS;
    __device__ __forceinline__ void begin(const Unit& u, int ui, int tid, LAS unsigned char* lds) const {
        if (tid < 256) { const float* p = OSS + (size_t)(u.pm * 256 + tid) * 16; const f32x4 a = ((const f32x4*)p)[0], b = ((const f32x4*)p)[1], c = ((const f32x4*)p)[2], d = ((const f32x4*)p)[3];
            const f32x4 s1 = a + b, s2 = c + d; const float rs = 1.0f / sqrtf(((s1[0] + s1[1]) + (s1[2] + s1[3])) * (1.f / 512.f) + EPS), rm = 1.0f / sqrtf(((s2[0] + s2[1]) + (s2[2] + s2[3])) * (1.f / 512.f) + EPS);
            ((LAS f32x2*)(lds + OTAB_OFF))[(ui & 1) * 256 + tid] = (f32x2){rs / rm, rm}; }
    }
    __device__ __forceinline__ void mid(f32x4 (&acc)[2][2][4][2], int ui, int wr, int fr, LAS unsigned char* lds) const {
#pragma unroll
        for (int ai = 0; ai < 2; ++ai)
#pragma unroll
            for (int m = 0; m < 4; ++m) { const float f = ((const LAS f32x2*)(lds + OTAB_OFF))[(ui & 1) * 256 + ai * 128 + wr * 64 + m * 16 + fr][0];
#pragma unroll
                for (int bj = 0; bj < 2; ++bj)
#pragma unroll
                    for (int n = 0; n < 2; ++n) acc[ai][bj][m][n] = acc[ai][bj][m][n] * f; }
    }
    __device__ __forceinline__ void operator()(const f32x4 (&acc)[2][2][4][2], const Unit& u, int ui, int wr, int wc, int fr, int fq, LAS unsigned char* lds) const {
#pragma unroll
        for (int ai = 0; ai < 2; ++ai)
#pragma unroll
            for (int m = 0; m < 4; ++m) {
                const int r = ai * 128 + wr * 64 + m * 16 + fr, row = u.pm * 256 + r; const float rm = ((const LAS f32x2*)(lds + OTAB_OFF))[(ui & 1) * 256 + r][1];
#pragma unroll
                for (int bj = 0; bj < 2; ++bj) { const size_t o = (size_t)row * DM + u.pn * 256 + bj * 128 + wc * 32 + fq * 8;
                    f32x4 a, b;
                    if (xin) { a = *(const f32x4*)(xin + o); b = *(const f32x4*)(xin + o + 4); }
                    else { float f[8]; unpack8(*(const u32x4*)(hin + o), f); a = (f32x4){f[0], f[1], f[2], f[3]}; b = (f32x4){f[4], f[5], f[6], f[7]}; }
                    *(u32x4*)(hout + o) = pack8(a + acc[ai][bj][m][0] * rm, b + acc[ai][bj][m][1] * rm); }
                asm volatile("" ::: "memory");
            }
    }
};
struct EpiG1 {
    EPI_DEFAULTS
    const float* RS; const int* liste; bf16_t* HID;
    __device__ __forceinline__ void operator()(const f32x4 (&acc)[2][2][4][2], const Unit& u, int ui, int wr, int wc, int fr, int fq, LAS unsigned char* lds) const {
#pragma unroll
        for (int ai = 0; ai < 2; ++ai)
#pragma unroll
            for (int m = 0; m < 4; ++m) {
                const int r = ai * 128 + wr * 64 + m * 16 + fr;
                if (r < u.nrows) {
                    const int tok = liste[(size_t)u.e * T + 256 * u.tile + r] >> 1; const float rs = RS[tok];
                    f32x4 h[2];
#pragma unroll
                    for (int n = 0; n < 2; ++n) { const f32x4 g = acc[ai][0][m][n] * rs, up = acc[ai][1][m][n] * rs;
#pragma unroll
                        for (int i = 0; i < 4; ++i) h[n][i] = g[i] * frcp(1.f + fexp2(-g[i] * LOG2E)) * up[i]; }
                    *(u32x4*)(HID + (size_t)(u.pm * 256 + r) * 256 + u.pn * 128 + wc * 32 + fq * 8) = pack8(h[0], h[1]);
                }
                asm volatile("" ::: "memory");
            }
    }
};
struct EpiDn {
    EPI_DEFAULTS
    const int* liste; const float* listw; bf16_t* Y;
    __device__ __forceinline__ void operator()(const f32x4 (&acc)[2][2][4][2], const Unit& u, int ui, int wr, int wc, int fr, int fq, LAS unsigned char* lds) const {
#pragma unroll
        for (int ai = 0; ai < 2; ++ai)
#pragma unroll
            for (int m = 0; m < 4; ++m) {
                const int r = ai * 128 + wr * 64 + m * 16 + fr;
                if (r < u.nrows) {
                    const size_t li = (size_t)u.e * T + 256 * u.tile + r; const int ent = liste[li]; const float w = listw[li];
#pragma unroll
                    for (int bj = 0; bj < 2; ++bj) { const int c = u.pn * 256 + bj * 128 + wc * 32 + fq * 8;
                        *(u32x4*)(Y + (size_t)ent * DM + c) = pack8(acc[ai][bj][m][0] * w, acc[ai][bj][m][1] * w); }
                }
                asm volatile("" ::: "memory");
            }
    }
};
struct EpiPle {
    EPI_DEFAULTS
    const float* RS; const bf16_t* PE; const bf16_t* H; bf16_t* HO; float* SSQ;
    __device__ __forceinline__ void operator()(const f32x4 (&acc)[2][2][4][2], const Unit& u, int ui, int wr, int wc, int fr, int fq, LAS unsigned char* lds) const {
#pragma unroll
        for (int ai = 0; ai < 2; ++ai)
#pragma unroll
            for (int m = 0; m < 4; ++m) {
                const int row = u.pm * 256 + ai * 128 + wr * 64 + m * 16 + fr; const float rs = RS[row];
                float sq = 0.f;
#pragma unroll
                for (int bj = 0; bj < 2; ++bj) { const size_t o = (size_t)row * DM + u.pn * 256 + bj * 128 + wc * 32 + fq * 8;
                    float pe[8], hv[8]; unpack8(*(const u32x4*)(PE + o), pe); unpack8(*(const u32x4*)(H + o), hv);
#pragma unroll
                    for (int i = 0; i < 4; ++i) { hv[i] += frcp(1.f + fexp2(-acc[ai][bj][m][0][i] * rs * LOG2E)) * pe[i]; hv[4 + i] += frcp(1.f + fexp2(-acc[ai][bj][m][1][i] * rs * LOG2E)) * pe[4 + i]; }
                    const u32x4 w = (u32x4){pk2(hv[0], hv[1]), pk2(hv[2], hv[3]), pk2(hv[4], hv[5]), pk2(hv[6], hv[7])};
                    *(u32x4*)(HO + o) = w; unpack8(w, hv);
#pragma unroll
                    for (int i = 0; i < 8; ++i) sq += hv[i] * hv[i]; }
                sq = fq_sum(sq);
                if (fq == 0) SSQ[(size_t)row * 16 + u.pn * 4 + wc] = sq;
                asm volatile("" ::: "memory");
            }
    }
};


#define XB_TMO      128
#define XB_XCNT(j)  (256  + 64 * (j))
#define XB_XSUB(j)  (1280 + 64 * (j))
#define XB_XGEN(j)  (2304 + 64 * (j))
#define XB_TOP      3328
#define XB_TOPGEN   3392
#define XCD_BAR_WORDS 3456
#define XB_SPIN_CAP (1u << 18)

__device__ __forceinline__ unsigned xb_ld(unsigned* p)              { return __hip_atomic_load(p, __ATOMIC_RELAXED, __HIP_MEMORY_SCOPE_AGENT); }
__device__ __forceinline__ unsigned xb_add(unsigned* p, unsigned v) { return __hip_atomic_fetch_add(p, v, __ATOMIC_RELAXED, __HIP_MEMORY_SCOPE_AGENT); }
__device__ __forceinline__ unsigned xb_xcc_id() { return (unsigned)__builtin_amdgcn_s_getreg((3 << 11) | 20) & 0xFu; }
#define XB_SPIN(cond, bar) do { unsigned _sp = 0; while (cond) { __builtin_amdgcn_s_sleep(1); \
    if ((++_sp & 255u) == 0u) { if (xb_ld(&(bar)[XB_TMO])) break; if (_sp > XB_SPIN_CAP) { atomicAdd(&(bar)[XB_TMO], 1u); break; } } } } while (0)

struct XcdBarrier {
    unsigned* bar; unsigned x;
    volatile LAS unsigned* st;
};

__device__ __forceinline__ XcdBarrier xcd_barrier_post(unsigned* bar, volatile LAS unsigned* st) {
    XcdBarrier b; b.bar = bar; b.x = xb_xcc_id(); b.st = st;
    if (threadIdx.x == 0) (void)xb_add(&bar[XB_XCNT(b.x)], 1u);
    return b;
}
__device__ __forceinline__ void xcd_barrier_complete(unsigned* bar, unsigned x, unsigned& nloc, unsigned& nx) {
    const unsigned G = gridDim.x * gridDim.y * gridDim.z;
    unsigned sum, cnt, mine, sp = 0u;
    for (;;) {
        sum = 0u; cnt = 0u; mine = 0u;
#pragma unroll
        for (unsigned j = 0; j < 16; ++j) { const unsigned c = xb_ld(&bar[XB_XCNT(j)]); sum += c; cnt += (c > 0u) ? 1u : 0u; mine = (j == x) ? c : mine; }
        if (sum == G) break;
        __builtin_amdgcn_s_sleep(1);
        if ((++sp & 255u) == 0u) { if (xb_ld(&bar[XB_TMO])) break; if (sp > XB_SPIN_CAP) { atomicAdd(&bar[XB_TMO], 1u); break; } }
    }
    nloc = mine > 0u ? mine : 1u; nx = cnt > 0u ? cnt : 1u;
}

__device__ __forceinline__ void xcd_barrier(const XcdBarrier& b) {
    asm volatile("s_waitcnt vmcnt(0)" ::: "memory");
    __syncthreads();
    if (threadIdx.x == 0) {
        unsigned* bar = b.bar;
        __builtin_amdgcn_s_waitcnt(0);
        unsigned nloc = b.st[0], nx = b.st[1];
        if (nloc == 0u) { xcd_barrier_complete(bar, b.x, nloc, nx); b.st[0] = nloc; b.st[1] = nx; }
        const unsigned old = xb_add(&bar[XB_XSUB(b.x)], 1u);
        const unsigned gen = old / nloc;
        if (old + 1u == (gen + 1u) * nloc) {
            __builtin_amdgcn_fence(__ATOMIC_RELEASE, "agent");
            asm volatile("s_waitcnt vmcnt(0)" ::: "memory");
            const unsigned og = xb_add(&bar[XB_TOP], 1u);
            const unsigned tg = og / nx;
            if (og + 1u == (tg + 1u) * nx) xb_add(&bar[XB_TOPGEN], 1u);
            else XB_SPIN(xb_ld(&bar[XB_TOPGEN]) == tg, bar);
            __builtin_amdgcn_fence(__ATOMIC_ACQUIRE, "agent");
            xb_add(&bar[XB_XGEN(b.x)], 1u);
            asm volatile("s_waitcnt vmcnt(0)" ::: "memory");
        } else {
            XB_SPIN(xb_ld(&bar[XB_XGEN(b.x)]) == gen, bar);
            __builtin_amdgcn_fence(__ATOMIC_ACQUIRE, "agent");
            asm volatile("s_waitcnt vmcnt(0)" ::: "memory");
        }
    }
    __syncthreads();
}


struct Frame {
    LAS unsigned char* lds; int tid, lane, wave, G, bx;
    const Params* P; unsigned char* ws;
    __device__ __forceinline__ int gw() const { return bx * NWAVES + wave; }
    __device__ __forceinline__ int ngw() const { return G * NWAVES; }
};
template <class Tp> __device__ __forceinline__ Tp* wsp(const Frame& F, size_t off) { return (Tp*)(F.ws + off); }

__device__ __forceinline__ void prep_item(const float* W, int ldw, int srccol0, const float* g, bf16_t* dstrow0, int K, int k0, LAS float* scr, int lane) {
    const int c = lane & 7;
    if (srccol0 < 0) {
#pragma unroll
        for (int j = 0; j < 4; ++j) { const int n = (lane >> 3) + 8 * j; *(u32x4*)(dstrow0 + (size_t)n * K + k0 + 8 * c) = (u32x4){0u, 0u, 0u, 0u}; }
        return;
    }
#pragma unroll 8
    for (int i = 0; i < 32; ++i) { const int kk = 2 * i + (lane >> 5); float v = W[(size_t)(k0 + kk) * ldw + srccol0 + (lane & 31)]; if (g) v *= g[k0 + kk]; scr[kk * 33 + (lane & 31)] = v; }
    asm volatile("s_waitcnt lgkmcnt(0)" ::: "memory");
#pragma unroll
    for (int j = 0; j < 4; ++j) { const int n = (lane >> 3) + 8 * j; const LAS float* s = scr + (8 * c) * 33 + n;
        u32x4 o; o.x = pk2(s[0 * 33], s[1 * 33]); o.y = pk2(s[2 * 33], s[3 * 33]); o.z = pk2(s[4 * 33], s[5 * 33]); o.w = pk2(s[6 * 33], s[7 * 33]);
        *(u32x4*)(dstrow0 + (size_t)n * K + k0 + 8 * c) = o; }
    asm volatile("s_waitcnt lgkmcnt(0)" ::: "memory");
}
__device__ __forceinline__ void phase_prep_small(Frame& F) {
    const Params& P = *F.P;
    LAS float* scr = (LAS float*)(F.lds + F.wave * 16384);
    constexpr int I_IN = 16 * 72, I_UQ = 6 * 24, I_UKV = 4 * 32, I_OUT = 16 * 32, I_PG = 16 * 32, I_PE = 4 * 32, I_L = I_IN + I_UQ + I_UKV + I_OUT + I_PG + I_PE;
    for (int it = F.gw(); it < NLAYER * I_L; it += F.ngw()) {
        const int l = it / I_L; int r = it % I_L;
        unsigned char* wb = F.ws + WS_WSM + (size_t)l * WSM_STRIDE;
        if (r < I_IN) { const int kb = r / 72, gi = r % 72, n0 = gi * 32; int src;
            if (n0 < 1536) src = n0; else if (n0 < 1792) src = 1920 + (n0 - 1536); else if (n0 < 2176) src = 1536 + (n0 - 1792); else if (n0 < 2208) src = n0; else src = -1;
            prep_item(P.in[4] + (size_t)l * DM * INC, INC, src, P.in[3] + l * DM, (bf16_t*)(wb + WSM_IN) + (size_t)n0 * DM, DM, kb * 64, scr, F.lane); continue; }
        r -= I_IN;
        if (r < I_UQ) { const int kb = r / 24, n0 = (r % 24) * 32;
            prep_item(P.in[6] + (size_t)l * QRANK * 768, 768, n0, P.in[5] + l * QRANK, (bf16_t*)(wb + WSM_UQ) + (size_t)n0 * QRANK, QRANK, kb * 64, scr, F.lane); continue; }
        r -= I_UQ;
        if (r < I_UKV) { const int kb = r / 32, n0 = (r % 32) * 32; const int hh = (n0 & 511) >> 6, d = n0 & 63; const int src = hh * 128 + (n0 >= 512 ? 64 : 0) + d;
            prep_item(P.in[8] + (size_t)l * KVRANK * 1024, 1024, src, P.in[7] + l * KVRANK, (bf16_t*)(wb + WSM_UKV) + (size_t)n0 * KVRANK, KVRANK, kb * 64, scr, F.lane); continue; }
        r -= I_UKV;
        if (r < I_OUT) { const int kb = r / 32, n0 = (r % 32) * 32; const int k0 = kb * 64;
            const float* g = k0 < 512 ? P.in[9] + l * 512 : P.in[10] + l * 512 - 512;
            prep_item(P.in[11] + (size_t)l * DM * DM, DM, n0, g, (bf16_t*)(wb + WSM_OUT) + (size_t)n0 * DM, DM, k0, scr, F.lane); continue; }
        r -= I_OUT;
        if (r < I_PG) { const int kb = r / 32, n0 = (r % 32) * 32;
            prep_item(P.in[21] + (size_t)l * DM * DM, DM, n0, P.in[20] + l * DM, (bf16_t*)(wb + WSM_PG) + (size_t)n0 * DM, DM, kb * 64, scr, F.lane); continue; }
        r -= I_PG;
        { const int kb = r / 32, n0 = (r % 32) * 32;
            prep_item(P.in[22] + (size_t)l * DPLE * DM, DM, n0, nullptr, (bf16_t*)(wb + WSM_PE) + (size_t)n0 * DPLE, DPLE, kb * 64, scr, F.lane); }
    }
    float* WR = wsp<float>(F, WS_WR);
    for (int i = F.bx * NTHREADS + F.tid; i < NLAYER * 36 * DM; i += F.G * NTHREADS) {
        const int l = i / (36 * DM), j = (i / DM) % 36, k = i % DM;
        const float w = j < 4 ? P.in[13][((size_t)l * DM + k) * 4 + j] : P.in[15][((size_t)l * DM + k) * 32 + (j - 4)];
        WR[i] = w * P.in[12][l * DM + k];
    }
    float* COS = wsp<float>(F, WS_COS); float* SIN = wsp<float>(F, WS_SIN); const int* pos = (const int*)P.in[2];
    for (int i = F.bx * NTHREADS + F.tid; i < T * 16; i += F.G * NTHREADS) {
        const float ang = (float)pos[i >> 4] * P.inv_freq[i & 15];
        const double a = (double)ang; const double q = __builtin_rint(a * 0.63661977236758134308);
        double r = __builtin_fma(-q, 1.57079632679489655800, a); r = __builtin_fma(-q, 6.12323399573676603587e-17, r);
        const double z = r * r;
        const double sp = r + r * z * (-0.166666666416265235595 + z * (0.0083333293858894631756 + z * (-0.000198393348360966317347 + z * 0.0000027183114939898219064)));
        const double cp = 1.0 + z * (-0.499999997251031003120 + z * (0.0416666233237390631894 + z * (-0.00138867637746099294692 + z * 0.0000243904487962774090654)));
        const int qi = (int)((long long)q & 3);
        const double sv = (qi == 0) ? sp : (qi == 1) ? cp : (qi == 2) ? -sp : -cp;
        const double cv = (qi == 0) ? cp : (qi == 1) ? -sp : (qi == 2) ? -cp : sp;
        COS[i] = (float)cv; SIN[i] = (float)sv;
    }
}
__device__ __forceinline__ void prep_item64(const float* W, int ldw, int srccol0, const float* g, bf16_t* dstrow0, int K, int k0, LAS float* scr, int lane) {
    f32x4 v[16];
    const int kq = lane >> 4, n4 = (lane & 15) * 4;
#pragma unroll
    for (int i = 0; i < 16; ++i) v[i] = *(const f32x4*)(W + (size_t)(k0 + 4 * i + kq) * ldw + srccol0 + n4);
#pragma unroll
    for (int i = 0; i < 16; ++i) { const float gg = g ? g[k0 + 4 * i + kq] : 1.f; LAS float* d = scr + (4 * i + kq) * 65 + n4; d[0] = v[i][0] * gg; d[1] = v[i][1] * gg; d[2] = v[i][2] * gg; d[3] = v[i][3] * gg; }
    asm volatile("s_waitcnt lgkmcnt(0)" ::: "memory");
    const int c = lane & 7;
#pragma unroll
    for (int j = 0; j < 8; ++j) { const int n = (lane >> 3) + 8 * j; const LAS float* s = scr + (8 * c) * 65 + n;
        u32x4 o; o.x = pk2(s[0 * 65], s[1 * 65]); o.y = pk2(s[2 * 65], s[3 * 65]); o.z = pk2(s[4 * 65], s[5 * 65]); o.w = pk2(s[6 * 65], s[7 * 65]);
        *(u32x4*)(dstrow0 + (size_t)n * K + k0 + 8 * c) = o; }
    asm volatile("s_waitcnt lgkmcnt(0)" ::: "memory");
}
__device__ __forceinline__ void phase_prep_moe(Frame& F, int l) {
    const Params& P = *F.P;
    LAS float* scr = (LAS float*)(F.lds + F.wave * 16640);
    constexpr int I_G1 = 16 * 8, I_DN = 4 * 16, I_E = I_G1 + I_DN;
    bf16_t* WG1 = wsp<bf16_t>(F, WS_WG1); bf16_t* WD = wsp<bf16_t>(F, WS_WD);
    for (int it = F.gw(); it < NEXP * I_E; it += F.ngw()) {
        const int e = it / I_E; int r = it % I_E;
        if (r < I_G1) { const int kb = r >> 3, n0 = (r & 7) * 64; const int pn = n0 >> 8, c = n0 & 255;
            const float* W = (c < 128 ? P.in[17] : P.in[18]) + ((size_t)l * NEXP + e) * DM * DEXP; const int src = pn * 128 + (c & 127);
            prep_item64(W, DEXP, src, P.in[12] + l * DM, WG1 + ((size_t)e * 512 + n0) * DM, DM, kb * 64, scr, F.lane); }
        else { r -= I_G1; const int kb = r >> 4, n0 = (r & 15) * 64;
            prep_item64(P.in[19] + ((size_t)l * NEXP + e) * DEXP * DM, DM, n0, nullptr, WD + ((size_t)e * DM + n0) * DEXP, DEXP, kb * 64, scr, F.lane); }
    }
}

__device__ __forceinline__ void phase_norm(Frame& F, const float* hin) {
    bf16_t* HB = wsp<bf16_t>(F, WS_HBI); float* SSQ = wsp<float>(F, WS_SSQ);
    for (int row = F.gw(); row < T; row += F.ngw()) {
        const f32x4* xr = (const f32x4*)(hin + (size_t)row * DM) + F.lane; f32x4 v[4]; float s = 0.f;
#pragma unroll
        for (int j = 0; j < 4; ++j) { v[j] = xr[64 * j]; s += (v[j][0] * v[j][0] + v[j][1] * v[j][1]) + (v[j][2] * v[j][2] + v[j][3] * v[j][3]); }
        s = wave_sum(s);
        u32x2* o = (u32x2*)(HB + (size_t)row * DM) + F.lane;
#pragma unroll
        for (int j = 0; j < 4; ++j) o[64 * j] = (u32x2){pk2(v[j][0], v[j][1]), pk2(v[j][2], v[j][3])};
        if (F.lane < 16) SSQ[(size_t)row * 16 + F.lane] = F.lane == 0 ? s : 0.f;
    }
}
__device__ __forceinline__ void phase_route(Frame& F, int l, bool dummy = false) {
    const Params& P = *F.P; bf16_t* PB = wsp<bf16_t>(F, WS_PB); const float* pl = P.in[1] + (size_t)l * T * DPLE;
    LAS float* WL = (LAS float*)F.lds;
    const float* WR = wsp<float>(F, WS_WR) + (size_t)l * 36 * DM;
    for (int i = F.tid; i < 36 * DM / 4; i += NTHREADS) ((LAS f32x4*)WL)[i] = ((const f32x4*)WR)[i];
    __syncthreads();
    const bf16_t* HB = wsp<bf16_t>(F, WS_HB); float* RS = wsp<float>(F, WS_RS);
    unsigned* cnt = wsp<unsigned>(F, WS_CTL) + CW_CNT + 64 * 32 * (dummy ? NLAYER + l : l); int* liste = dummy ? wsp<int>(F, WS_Y) : wsp<int>(F, WS_LISTE); float* listw = dummy ? wsp<float>(F, WS_Y + 4 * MiB) : wsp<float>(F, WS_LISTW);
    const float* brg = P.in[14] + l * 4; const float* bre = P.in[16] + l * 32;
    LAS unsigned* lcnt = (LAS unsigned*)(F.lds + 147456); LAS unsigned* lbase = lcnt + 32; LAS unsigned* ent = lcnt + 64;
    if (F.tid < 32) lcnt[F.tid] = 0u;
    __syncthreads();
    int nent = 0;
    for (int row = F.gw(); row < T; row += F.ngw()) {
        const u32x2* xr = (const u32x2*)(HB + (size_t)row * DM) + F.lane; f32x4 v[4]; float s = 0.f;
#pragma unroll
        for (int j = 0; j < 4; ++j) { const u32x2 w = xr[64 * j]; v[j] = (f32x4){bf2f(w.x & 0xffffu), bf2f(w.x >> 16), bf2f(w.y & 0xffffu), bf2f(w.y >> 16)}; s += (v[j][0] * v[j][0] + v[j][1] * v[j][1]) + (v[j][2] * v[j][2] + v[j][3] * v[j][3]); }
        s = wave_sum(s); const float rs = 1.0f / sqrtf(s * (1.f / DM) + EPS);
        { const f32x4 pv = ((const f32x4*)(pl + (size_t)row * DPLE))[F.lane]; ((u32x2*)(PB + (size_t)row * DPLE))[F.lane] = (u32x2){pk2(pv[0], pv[1]), pk2(pv[2], pv[3])}; }
        float gl[4];
#pragma unroll
        for (int q = 0; q < 4; ++q) { float a = 0.f;
#pragma unroll
            for (int j = 0; j < 4; ++j) { const f32x4 w = ((const LAS f32x4*)(WL + q * DM))[F.lane + 64 * j]; a += (v[j][0] * w[0] + v[j][1] * w[1]) + (v[j][2] * w[2] + v[j][3] * w[3]); }
            gl[q] = wave_sum(a) * rs; }
        const float g0 = gl[0] + brg[0], g1 = gl[1] + brg[1], g2 = gl[2] + brg[2], g3 = gl[3] + brg[3];
        int g = 0; float gm = g0; if (g1 > gm) { gm = g1; g = 1; } if (g2 > gm) { gm = g2; g = 2; } if (g3 > gm) { gm = g3; g = 3; }
        g = __builtin_amdgcn_readfirstlane(g);
        const float gp = 1.0f / (fexp2((g0 - gm) * LOG2E) + fexp2((g1 - gm) * LOG2E) + fexp2((g2 - gm) * LOG2E) + fexp2((g3 - gm) * LOG2E));
        float le[8];
#pragma unroll
        for (int q = 0; q < 8; ++q) { float a = 0.f; const LAS f32x4* wq = (const LAS f32x4*)(WL + (4 + g * 8 + q) * DM);
#pragma unroll
            for (int j = 0; j < 4; ++j) { const f32x4 w = wq[F.lane + 64 * j]; a += (v[j][0] * w[0] + v[j][1] * w[1]) + (v[j][2] * w[2] + v[j][3] * w[3]); }
            le[q] = wave_sum(a) * rs + bre[g * 8 + q]; }
        int i1 = 0; float l1 = le[0];
#pragma unroll
        for (int j = 1; j < 8; ++j) if (le[j] > l1) { l1 = le[j]; i1 = j; }
        int i2 = (i1 == 0) ? 1 : 0; float l2 = (i1 == 0) ? le[1] : le[0];
#pragma unroll
        for (int j = 1; j < 8; ++j) if (j != i1 && le[j] > l2) { l2 = le[j]; i2 = j; }
        const float e2 = fexp2((l2 - l1) * LOG2E); const float w1 = gp / (1.f + e2), w2 = gp * e2 / (1.f + e2);
        if (F.lane == 0) {
            RS[row] = rs;
            const int ea = g * 8 + i1, eb = g * 8 + i2;
            if (nent < 16) {
                const unsigned pa = atomicAdd((unsigned*)(lcnt + ea), 1u), pb = atomicAdd((unsigned*)(lcnt + eb), 1u);
                LAS unsigned* en = ent + (size_t)(F.wave * 32 + nent * 2) * 4;
                en[0] = (unsigned)ea; en[1] = pa; en[2] = (unsigned)(row * 2); en[3] = __float_as_uint(w1);
                en[4] = (unsigned)eb; en[5] = pb; en[6] = (unsigned)(row * 2 + 1); en[7] = __float_as_uint(w2);
            } else {
                const unsigned pa = atomicAdd(cnt + 64 * ea, 1u); liste[(size_t)ea * T + pa] = row * 2; listw[(size_t)ea * T + pa] = w1;
                const unsigned pb = atomicAdd(cnt + 64 * eb, 1u); liste[(size_t)eb * T + pb] = row * 2 + 1; listw[(size_t)eb * T + pb] = w2;
            }
        }
        if (nent < 16) ++nent;
    }
    __syncthreads();
    if (F.tid < 32) lbase[F.tid] = lcnt[F.tid] ? atomicAdd(cnt + 64 * F.tid, lcnt[F.tid]) : 0u;
    __syncthreads();
    if (F.lane < 2 * nent) {
        const LAS unsigned* en = ent + (size_t)(F.wave * 32 + F.lane) * 4;
        const size_t li = (size_t)en[0] * T + lbase[en[0]] + en[1];
        liste[li] = (int)en[2]; listw[li] = __uint_as_float(en[3]);
    }
}
__device__ __forceinline__ void phase_norm2(Frame& F, int l, float ysc) {
    bf16_t* HB = wsp<bf16_t>(F, WS_HB); float* RS = wsp<float>(F, WS_RS); const bf16_t* Y = wsp<bf16_t>(F, WS_Y);
    for (int row = F.gw(); row < T; row += F.ngw()) {
        u32x2* xr = (u32x2*)(HB + (size_t)row * DM) + F.lane; float s = 0.f;
        const u32x2* y0 = (const u32x2*)(Y + (size_t)row * 2 * DM) + F.lane; const u32x2* y1 = y0 + DM / 4;
        u32x2 hw[4], ya[4], yb[4];
#pragma unroll
        for (int j = 0; j < 4; ++j) { hw[j] = xr[64 * j]; ya[j] = y0[64 * j]; yb[j] = y1[64 * j]; }
#pragma unroll
        for (int j = 0; j < 4; ++j) { const u32x2 a = ya[j], b = yb[j];
            float v0 = bf2f(hw[j].x & 0xffffu) + ysc * (bf2f(a.x & 0xffffu) + bf2f(b.x & 0xffffu)), v1 = bf2f(hw[j].x >> 16) + ysc * (bf2f(a.x >> 16) + bf2f(b.x >> 16));
            float v2 = bf2f(hw[j].y & 0xffffu) + ysc * (bf2f(a.y & 0xffffu) + bf2f(b.y & 0xffffu)), v3 = bf2f(hw[j].y >> 16) + ysc * (bf2f(a.y >> 16) + bf2f(b.y >> 16));
            const u32x2 o = (u32x2){pk2(v0, v1), pk2(v2, v3)}; xr[64 * j] = o;
            v0 = bf2f(o.x & 0xffffu); v1 = bf2f(o.x >> 16); v2 = bf2f(o.y & 0xffffu); v3 = bf2f(o.y >> 16);
            s += (v0 * v0 + v1 * v1) + (v2 * v2 + v3 * v3); }
        s = wave_sum(s);
        if (F.lane == 0) RS[row] = 1.0f / sqrtf(s * (1.f / DM) + EPS);
    }
}
__device__ __forceinline__ void phase_final(Frame& F) {
    const Params& P = *F.P; const bf16_t* H = wsp<bf16_t>(F, WS_HBI); const float* g = P.in[23];
    for (int row = F.gw(); row < T; row += F.ngw()) {
        const u32x2* xr = (const u32x2*)(H + (size_t)row * DM) + F.lane; f32x4 v[4]; float s = 0.f;
#pragma unroll
        for (int j = 0; j < 4; ++j) { const u32x2 w = xr[64 * j]; v[j] = (f32x4){bf2f(w.x & 0xffffu), bf2f(w.x >> 16), bf2f(w.y & 0xffffu), bf2f(w.y >> 16)}; s += (v[j][0] * v[j][0] + v[j][1] * v[j][1]) + (v[j][2] * v[j][2] + v[j][3] * v[j][3]); }
        s = wave_sum(s); const float rs = 1.0f / sqrtf(s * (1.f / DM) + EPS);
        f32x4* o = (f32x4*)(P.out + (size_t)row * DM) + F.lane;
#pragma unroll
        for (int j = 0; j < 4; ++j) o[64 * j] = v[j] * rs * ((const f32x4*)g)[F.lane + 64 * j];
    }
}

namespace att {
typedef float f32x16 __attribute__((ext_vector_type(16)));
typedef short s16x4 __attribute__((ext_vector_type(4)));
typedef short v4i16_t __attribute__((ext_vector_type(4)));
typedef __bf16 bf16x2_t __attribute__((ext_vector_type(2)));
constexpr int NS = 6, PF = 5;
constexpr int FLAG_OFF = 131072 + 512;
__device__ __forceinline__ int crow(int r, int hi) { return (r & 3) + 8 * (r >> 2) + 4 * hi; }
__device__ __forceinline__ unsigned cvtpk(float lo, float hi) { f32x2 v = {lo, hi}; bf16x2_t b = __builtin_convertvector(v, bf16x2_t); return __builtin_bit_cast(unsigned, b); }
__device__ __forceinline__ s16x4 vtr(const LAS unsigned char* p) { return __builtin_bit_cast(s16x4, __builtin_amdgcn_ds_read_tr16_b64_v4i16((LAS v4i16_t*)p)); }
__device__ __forceinline__ void dma16(const void* g, LAS unsigned char* l) {
    unsigned keep; const unsigned dst = (unsigned)__builtin_amdgcn_readfirstlane((int)(unsigned)(uintptr_t)l);
    asm volatile("s_mov_b32 %0, m0\n\ts_mov_b32 m0, %2\n\ts_nop 0\n\tglobal_load_lds_dwordx4 %1, off\n\ts_mov_b32 m0, %0" : "=&s"(keep) : "v"(g), "s"(dst) : "memory"); }
__device__ __forceinline__ float swap32(float x) { auto rr = __builtin_amdgcn_permlane32_swap(__float_as_uint(x), __float_as_uint(x), false, false); return __uint_as_float(((unsigned)(threadIdx.x & 32)) ? rr[0] : rr[1]); }
#define ATT_WAIT_BAR(N) asm volatile("s_waitcnt vmcnt(%0) lgkmcnt(0)\n\ts_barrier" :: "n"(N) : "memory")
__device__ __forceinline__ bf16x8 pfrag(const f32x16& w, int b8) { u32x4 u; u.x = cvtpk(w[b8], w[b8 + 1]); u.y = cvtpk(w[b8 + 2], w[b8 + 3]); u.z = cvtpk(w[b8 + 4], w[b8 + 5]); u.w = cvtpk(w[b8 + 6], w[b8 + 7]); return __builtin_bit_cast(bf16x8, u); }
__device__ __forceinline__ void v_load(bf16x8 (&vf)[8], const LAS unsigned char* vp) {
#pragma unroll
    for (int ks = 0; ks < 4; ++ks) {
        const s16x4 a0 = vtr(vp + ks * 1024), a1 = vtr(vp + ks * 1024 + 512), b0 = vtr(vp + 4096 + ks * 1024), b1 = vtr(vp + 4096 + ks * 1024 + 512);
        vf[2 * ks] = (bf16x8){a0[0], a0[1], a0[2], a0[3], a1[0], a1[1], a1[2], a1[3]}; vf[2 * ks + 1] = (bf16x8){b0[0], b0[1], b0[2], b0[3], b1[0], b1[1], b1[2], b1[3]};
    }
}
__device__ __forceinline__ void pv_tile(f32x16& o0, f32x16& o1, const bf16x8 (&vf)[8], const f32x16& w0, const f32x16& w1) {
#pragma unroll
    for (int ks = 0; ks < 4; ++ks) {
        const bf16x8 pf = pfrag(ks < 2 ? w0 : w1, 8 * (ks & 1));
        o0 = __builtin_amdgcn_mfma_f32_32x32x16_bf16(vf[2 * ks], pf, o0, 0, 0, 0);
        o1 = __builtin_amdgcn_mfma_f32_32x32x16_bf16(vf[2 * ks + 1], pf, o1, 0, 0, 0);
    }
}
__device__ __forceinline__ void store_o(bf16_t* orow, const f32x16& o0, const f32x16& o1, int hi, float sc, float* oss) {
    float sq = 0.f;
#pragma unroll
    for (int r = 0; r < 16; ++r) sq += o0[r] * o0[r] + o1[r] * o1[r];
    sq = (sq + xor32(sq)) * (sc * sc);
    if (hi == 0) *oss = sq;
#pragma unroll
    for (int g = 0; g < 4; ++g) {
        *(u32x2*)(orow + 8 * g + 4 * hi) = (u32x2){cvtpk(o0[4 * g] * sc, o0[4 * g + 1] * sc), cvtpk(o0[4 * g + 2] * sc, o0[4 * g + 3] * sc)};
        *(u32x2*)(orow + 32 + 8 * g + 4 * hi) = (u32x2){cvtpk(o1[4 * g] * sc, o1[4 * g + 1] * sc), cvtpk(o1[4 * g + 2] * sc, o1[4 * g + 3] * sc)};
    }
}

__device__ __forceinline__ void sb_unit(LAS unsigned char* lds, int tid, const bf16_t* QKV, bf16_t* OA, float* OSS, int b, int h, int qb) {
    asm volatile("" : "+v"(tid));
    const int lane = tid & 63, r32 = lane & 31, hi = lane >> 5, wid = __builtin_amdgcn_readfirstlane(tid >> 6);
    const size_t rowb = (size_t)b * SEQ; const int q0 = qb * 256;
    const bf16_t* Qw = QKV + (rowb + q0 + wid * 32) * 1536 + h * 64;
    const bf16_t* Kh = QKV + rowb * 1536 + 512 + h * 64; const bf16_t* Vh = Kh + 512;
    const int kt_hi = (q0 >> 6) + 3, NT = kt_hi + 1, jd = 3 - (wid >> 1);
    const bf16_t* ksrc = Kh + (size_t)lane * 1536 + wid * 8;
    const bf16_t* vsrc = Vh + (size_t)(16 * (wid & 3) + (lane >> 2)) * 1536 + (wid >> 2) * 32 + (lane & 3) * 8;
#define SB_ISSUE(j) do { int kt_ = kt_hi - (j); kt_ = kt_ < 0 ? 0 : kt_; LAS unsigned char* sl_ = lds + ((j) % NS) * 16384 + wid * 1024; \
        dma16(ksrc + (size_t)kt_ * 64 * 1536, sl_); dma16(vsrc + (size_t)kt_ * 64 * 1536, sl_ + 8192); } while (0)
    bf16x8 qr[4];
#pragma unroll
    for (int d0 = 0; d0 < 4; ++d0) qr[d0] = *(const bf16x8*)(Qw + (size_t)r32 * 1536 + d0 * 16 + hi * 8);
#pragma unroll
    for (int j = 0; j < PF; ++j) SB_ISSUE(j);
    asm volatile("" : "+v"(qr[0]), "+v"(qr[1]), "+v"(qr[2]), "+v"(qr[3]));
    f32x16 o0 = {}, o1 = {}; float carry = 0.f; bool mydone = false;
    const int q = q0 + wid * 32 + r32;
    volatile LAS unsigned* flags = (volatile LAS unsigned*)(lds + FLAG_OFF);
    const int vpo = ((lane >> 4) & 1) * 32 + (lane & 3) * 8 + (4 * hi + ((lane & 15) >> 2)) * 64;
    for (int j = 0; j < NT; ++j) {
        ATT_WAIT_BAR(2 * (PF - 1));
        if (j >= 1) { const u32x4 fa = *(const LAS u32x4*)(lds + FLAG_OFF + ((j - 1) & 1) * 32), fb = *(const LAS u32x4*)(lds + FLAG_OFF + ((j - 1) & 1) * 32 + 16);
            if ((fa.x & fa.y & fa.z & fa.w & fb.x & fb.y & fb.z & fb.w) != 0u) break; }
        SB_ISSUE(j + PF);
        if (j >= jd && !mydone) {
            const LAS unsigned char* ks = lds + (j % NS) * 16384;
            f32x16 z0 = {}, z1 = {};
            bf16x8 kf[8], vf[8];
#pragma unroll
            for (int d0 = 0; d0 < 4; ++d0) { kf[2 * d0] = *(const LAS bf16x8*)(ks + (2 * d0 + hi) * 1024 + r32 * 16); kf[2 * d0 + 1] = *(const LAS bf16x8*)(ks + (2 * d0 + hi) * 1024 + 512 + r32 * 16); }
            __builtin_amdgcn_sched_barrier(0);
#pragma unroll
            for (int d0 = 0; d0 < 4; ++d0) { z0 = __builtin_amdgcn_mfma_f32_32x32x16_bf16(kf[2 * d0], qr[d0], z0, 0, 0, 0); z1 = __builtin_amdgcn_mfma_f32_32x32x16_bf16(kf[2 * d0 + 1], qr[d0], z1, 0, 0, 0); }
            v_load(vf, ks + 8192 + vpo);
            __builtin_amdgcn_sched_barrier(0);
            const bool diag = (j == jd); const int kb = (kt_hi - j) * 64;
            f32x16 s0, s1;
#pragma unroll
            for (int r = 0; r < 16; ++r) { s0[r] = -flog2(1.f + fexp2(fminf(z0[r], 126.f))); s1[r] = -flog2(1.f + fexp2(fminf(z1[r], 126.f))); }
            if (diag) {
#pragma unroll
                for (int r = 0; r < 16; ++r) { if (kb + crow(r, hi) >= q) s0[r] = 0.f; if (kb + 32 + crow(r, hi) >= q) s1[r] = 0.f; }
            }
#pragma unroll
            for (int g = 0; g < 4; ++g) { s0[4 * g + 2] += s0[4 * g + 3]; s0[4 * g + 1] += s0[4 * g + 2]; s0[4 * g] += s0[4 * g + 1]; s1[4 * g + 2] += s1[4 * g + 3]; s1[4 * g + 1] += s1[4 * g + 2]; s1[4 * g] += s1[4 * g + 1]; }
            float I[9]; I[8] = 0.f;
#pragma unroll
            for (int g = 7; g >= 0; --g) I[g] = I[g + 1] + (g < 4 ? s0[4 * g] : s1[4 * (g - 4)]);
            float off[8];
#pragma unroll
            for (int g = 0; g < 8; ++g) off[g] = carry + I[g + 1] + swap32(hi ? I[g] : I[g + 1]);
            carry += I[0] + swap32(I[0]);
            f32x16 w0, w1;
#pragma unroll
            for (int r = 0; r < 16; ++r) { w0[r] = fexp2(z0[r] + s0[r] + off[r >> 2]); w1[r] = fexp2(z1[r] + s1[r] + off[4 + (r >> 2)]); }
            if (diag) {
#pragma unroll
                for (int r = 0; r < 16; ++r) { if (kb + crow(r, hi) >= q) w0[r] = 0.f; if (kb + 32 + crow(r, hi) >= q) w1[r] = 0.f; }
            }
            pv_tile(o0, o1, vf, w0, w1);
        }
        mydone = __all(carry < -150.f); if (lane == 0) flags[(j & 1) * 8 + wid] = mydone ? 1u : 0u;
    }
    store_o(OA + (rowb + q) * DM + h * 64, o0, o1, hi, 1.f, OSS + (rowb + q) * 16 + h);
    asm volatile("s_waitcnt lgkmcnt(0)\n\ts_barrier" ::: "memory");
#undef SB_ISSUE
}

__device__ __forceinline__ void mla_unit(LAS unsigned char* lds, int tid, const bf16_t* QM, const bf16_t* KN, const bf16_t* KR, const bf16_t* VM, bf16_t* OA, float* OSS, int b, int h, int qb) {
    asm volatile("" : "+v"(tid));
    const int lane = tid & 63, r32 = lane & 31, hi = lane >> 5, wid = __builtin_amdgcn_readfirstlane(tid >> 6);
    const size_t rowb = (size_t)b * SEQ; const int q0 = qb * 256;
    const bf16_t* Qw = QM + (rowb + q0 + wid * 32) * 768 + h * 96;
    const int NT = (q0 >> 6) + 4, mych = (q0 >> 6) + (wid >> 1);
    const bf16_t* ksrc = KN + (rowb + lane) * 512 + h * 64 + wid * 8;
    const bf16_t* rsrc = KR + (rowb + lane) * 32 + (wid & 3) * 8;
    const bf16_t* vsrc = VM + (rowb + 16 * (wid & 3) + (lane >> 2)) * 512 + h * 64 + (wid >> 2) * 32 + (lane & 3) * 8;
    constexpr int SLOT = 20480;
#define MLA_ISSUE(j) do { int kt_ = (j); kt_ = kt_ >= NT ? NT - 1 : kt_; LAS unsigned char* sl_ = lds + ((j) % NS) * SLOT; \
        dma16(ksrc + (size_t)kt_ * 64 * 512, sl_ + wid * 1024); dma16(rsrc + (size_t)kt_ * 64 * 32, wid < 4 ? sl_ + (8 + wid) * 1024 : lds + NS * SLOT + wid * 1024);     dma16(vsrc + (size_t)kt_ * 64 * 512, sl_ + 12288 + wid * 1024); } while (0)
    bf16x8 qr[6];
#pragma unroll
    for (int d0 = 0; d0 < 6; ++d0) qr[d0] = *(const bf16x8*)(Qw + (size_t)r32 * 768 + d0 * 16 + hi * 8);
#pragma unroll
    for (int j = 0; j < PF; ++j) MLA_ISSUE(j);
    asm volatile("" : "+v"(qr[0]), "+v"(qr[1]), "+v"(qr[2]), "+v"(qr[3]), "+v"(qr[4]), "+v"(qr[5]));
    f32x16 o0 = {}, o1 = {}; float mx = -1.0e30f, lsum = 0.f;
    const int vpo = ((lane >> 4) & 1) * 32 + (lane & 3) * 8 + (4 * hi + ((lane & 15) >> 2)) * 64;
    for (int j = 0; j < NT; ++j) {
        ATT_WAIT_BAR(3 * (PF - 1));
        MLA_ISSUE(j + PF);
        if (j <= mych) {
            const LAS unsigned char* ks = lds + (j % NS) * SLOT;
            f32x16 z0 = {}, z1 = {};
            bf16x8 kf[12], vf[8];
#pragma unroll
            for (int d0 = 0; d0 < 6; ++d0) { kf[2 * d0] = *(const LAS bf16x8*)(ks + (2 * d0 + hi) * 1024 + r32 * 16); kf[2 * d0 + 1] = *(const LAS bf16x8*)(ks + (2 * d0 + hi) * 1024 + 512 + r32 * 16); }
            __builtin_amdgcn_sched_barrier(0);
#pragma unroll
            for (int d0 = 0; d0 < 6; ++d0) { z0 = __builtin_amdgcn_mfma_f32_32x32x16_bf16(kf[2 * d0], qr[d0], z0, 0, 0, 0); z1 = __builtin_amdgcn_mfma_f32_32x32x16_bf16(kf[2 * d0 + 1], qr[d0], z1, 0, 0, 0); }
            v_load(vf, ks + 12288 + vpo);
            __builtin_amdgcn_sched_barrier(0);
            float tm = fmaxf(z0[0], z1[0]);
#pragma unroll
            for (int r = 1; r < 16; ++r) tm = fmaxf(tm, fmaxf(z0[r], z1[r]));
            tm = fmaxf(tm, swap32(tm));
            const float mn = fmaxf(mx, tm), alpha = fexp2(mx - mn); mx = mn;
            float ps = 0.f;
#pragma unroll
            for (int r = 0; r < 16; ++r) { z0[r] = fexp2(z0[r] - mn); z1[r] = fexp2(z1[r] - mn); ps += z0[r] + z1[r]; }
            lsum = lsum * alpha + ps;
#pragma unroll
            for (int r = 0; r < 16; ++r) { o0[r] *= alpha; o1[r] *= alpha; }
            pv_tile(o0, o1, vf, z0, z1);
        }
    }
    lsum += swap32(lsum);
    store_o(OA + (rowb + q0 + wid * 32 + r32) * DM + 512 + h * 64, o0, o1, hi, 1.0f / lsum, OSS + (rowb + q0 + wid * 32 + r32) * 16 + 8 + h);
    asm volatile("s_waitcnt lgkmcnt(0)\n\ts_barrier" ::: "memory");
#undef MLA_ISSUE
}
}

__device__ __forceinline__ void phase_attn(Frame& F) {
    const bf16_t* QKV = wsp<bf16_t>(F, WS_QKV); bf16_t* OA = wsp<bf16_t>(F, WS_OA); float* OSS = wsp<float>(F, WS_OSS);
    const bf16_t* QM = wsp<bf16_t>(F, WS_QM); const bf16_t* KN = wsp<bf16_t>(F, WS_KN); const bf16_t* KR = wsp<bf16_t>(F, WS_KR); const bf16_t* VM = wsp<bf16_t>(F, WS_VM);
    const int vcu = (F.G % 8 == 0) ? (F.bx % 8) * (F.G / 8) + F.bx / 8 : F.bx;
    for (int p = vcu; p < 512; p += F.G) {
        const int bh = p >> 3, s = p & 7;
        att::mla_unit(F.lds, F.tid, QM, KN, KR, VM, OA, OSS, bh >> 3, bh & 7, 15 - s);
        att::mla_unit(F.lds, F.tid, QM, KN, KR, VM, OA, OSS, bh >> 3, bh & 7, s);
    }
    for (int u = vcu; u < 1024; u += F.G) { const int bh = u >> 4; att::sb_unit(F.lds, F.tid, QKV, OA, OSS, bh >> 3, bh & 7, u & 15); }
}

__device__ __forceinline__ DenseSched dense_sched(const Frame& F, int N, const void* Bt, int K) { DenseSched S; S.o.init(T, N, F.G, F.bx); S.Bt = (const char*)Bt; S.K = K; return S; }
__device__ __forceinline__ void phase_inproj(Frame& F, int l) {
    const DenseSched S = dense_sched(F, INP, F.ws + WS_WSM + (size_t)l * WSM_STRIDE + WSM_IN, DM);
    const EpiIn E{wsp<float>(F, WS_SSQ), wsp<bf16_t>(F, WS_QKV), wsp<bf16_t>(F, WS_CKV), wsp<bf16_t>(F, WS_CQ), wsp<bf16_t>(F, WS_KR), wsp<float>(F, WS_COS), wsp<float>(F, WS_SIN), wsp<float>(F, WS_RSCQ), wsp<float>(F, WS_RSCKV)};
    pg8::gemm_phase(F.lds, F.tid, (const char*)(F.ws + WS_HBI), DM, S, E);
}
__device__ __forceinline__ void phase_uq(Frame& F, int l) {
    const DenseSched S = dense_sched(F, 768, F.ws + WS_WSM + (size_t)l * WSM_STRIDE + WSM_UQ, QRANK);
    const EpiUq E{wsp<float>(F, WS_RSCQ), wsp<bf16_t>(F, WS_QM), wsp<float>(F, WS_COS), wsp<float>(F, WS_SIN)};
    pg8::gemm_phase(F.lds, F.tid, (const char*)(F.ws + WS_CQ), QRANK, S, E);
}
__device__ __forceinline__ void phase_ukv(Frame& F, int l) {
    const DenseSched S = dense_sched(F, 1024, F.ws + WS_WSM + (size_t)l * WSM_STRIDE + WSM_UKV, KVRANK);
    const EpiUkv E{wsp<float>(F, WS_RSCKV), wsp<bf16_t>(F, WS_KN), wsp<bf16_t>(F, WS_VM)};
    pg8::gemm_phase(F.lds, F.tid, (const char*)(F.ws + WS_CKV), KVRANK, S, E);
}
__device__ __forceinline__ void phase_outproj(Frame& F, int l) {
    const DenseSched S = dense_sched(F, DM, F.ws + WS_WSM + (size_t)l * WSM_STRIDE + WSM_OUT, DM);
    EpiOut E; E.xin = l == 0 ? F.P->in[0] : nullptr; E.hin = wsp<bf16_t>(F, WS_HBI); E.hout = wsp<bf16_t>(F, WS_HB); E.OSS = wsp<float>(F, WS_OSS);
    pg8::gemm_phase(F.lds, F.tid, (const char*)(F.ws + WS_OA), DM, S, E);
}
__device__ __forceinline__ void moe_table(Frame& F, int l) {
    LAS int* tb = (LAS int*)(F.lds + pg8::STAGE_BYTES);
    __syncthreads();
    if (F.tid == 0) { const unsigned* cnt = wsp<unsigned>(F, WS_CTL) + CW_CNT + 64 * 32 * l; int acc = 0;
        for (int e = 0; e < NEXP; ++e) { const int c = (int)__hip_atomic_load(cnt + 64 * e, __ATOMIC_RELAXED, __HIP_MEMORY_SCOPE_AGENT); tb[e] = acc; tb[40 + e] = c; acc += (c + 255) >> 8; }
        tb[32] = acc; }
    __syncthreads();
}
__device__ __forceinline__ void phase_moe1(Frame& F, int l) {
    moe_table(F, l);
    MoeSched S; S.G = F.G; S.c = F.bx; S.npn = 2; S.gather = 1; S.tb = (const LAS int*)(F.lds + pg8::STAGE_BYTES); S.liste = wsp<int>(F, WS_LISTE); S.Bt = (const char*)(F.ws + WS_WG1); S.K = DM; S.nB = 512;
    const EpiG1 E{wsp<float>(F, WS_RS), wsp<int>(F, WS_LISTE), wsp<bf16_t>(F, WS_HID)};
    pg8::gemm_phase(F.lds, F.tid, (const char*)(F.ws + WS_HB), DM, S, E);
}
__device__ __forceinline__ void phase_moe2(Frame& F, int l) {
    moe_table(F, l);
    MoeSched S; S.G = F.G; S.c = F.bx; S.npn = 4; S.gather = 0; S.tb = (const LAS int*)(F.lds + pg8::STAGE_BYTES); S.liste = wsp<int>(F, WS_LISTE); S.Bt = (const char*)(F.ws + WS_WD); S.K = DEXP; S.nB = 1024;
    const EpiDn E{wsp<int>(F, WS_LISTE), wsp<float>(F, WS_LISTW), wsp<bf16_t>(F, WS_Y)};
    pg8::gemm_phase(F.lds, F.tid, (const char*)(F.ws + WS_HID), DEXP, S, E);
}
__device__ __forceinline__ void phase_pe(Frame& F, int l) {
    const DenseSched S = dense_sched(F, DM, F.ws + WS_WSM + (size_t)l * WSM_STRIDE + WSM_PE, DPLE);
    const EpiBf E{wsp<bf16_t>(F, WS_PE), DM};
    pg8::gemm_phase(F.lds, F.tid, (const char*)(F.ws + WS_PB), DPLE, S, E);
}
__device__ __forceinline__ void phase_ple(Frame& F, int l) {
    const DenseSched S = dense_sched(F, DM, F.ws + WS_WSM + (size_t)l * WSM_STRIDE + WSM_PG, DM);
    const EpiPle E{wsp<float>(F, WS_RS), wsp<bf16_t>(F, WS_PE), wsp<bf16_t>(F, WS_HB), wsp<bf16_t>(F, WS_HBI), wsp<float>(F, WS_SSQ)};
    pg8::gemm_phase(F.lds, F.tid, (const char*)(F.ws + WS_HB), DM, S, E);
}

#ifndef PROBE
#define PROBE 0
#endif
constexpr int CW_BAR = 4096;
constexpr int MISC_OFF = 150 * 1024;
static_assert(CW_BAR + XCD_BAR_WORDS <= CW_CNT && (CW_CNT + 64 * 32 * 2 * NLAYER) * 4 <= (int)CTL_BYTES && (CW_BAR + XCD_BAR_WORDS) * 4 <= (int)CTL_BYTES && MISC_OFF + 16 <= LDS_BYTES, "control words");
__global__ void __launch_bounds__(NTHREADS, 2) mega_fwd(Params P) {
    extern __shared__ __attribute__((aligned(16))) unsigned char lds_raw[];
    Frame F; F.lds = (LAS unsigned char*)lds_raw; F.tid = threadIdx.x; F.lane = F.tid & 63; F.wave = __builtin_amdgcn_readfirstlane(F.tid >> 6); F.G = gridDim.x; F.bx = blockIdx.x; F.P = &P; F.ws = P.ws;
    volatile LAS unsigned* st = (volatile LAS unsigned*)(F.lds + MISC_OFF);
    if (F.tid < 4) st[F.tid] = 0u;
    __syncthreads();
    const XcdBarrier bar = xcd_barrier_post(wsp<unsigned>(F, WS_CTL) + CW_BAR, st);
#define GRID_BAR() do { XcdBarrier b_ = bar; asm volatile("" : "+s"(b_.x)); asm volatile("" : "+s"(b_.bar)); xcd_barrier(b_); PH_BEGIN(); } while (0)
#define PH_BEGIN() do { asm volatile("" : "+v"(F.tid)); F.lane = F.tid & 63; asm volatile("" : "+s"(F.ws)); } while (0)
    phase_prep_small(F);
    phase_norm(F, P.in[0]);
#if PROBE == 11
    __syncthreads(); PH_BEGIN(); phase_prep_small(F); phase_norm(F, P.in[0]);
#endif
    GRID_BAR();
#if PROBE == 13
    GRID_BAR(); GRID_BAR(); GRID_BAR(); GRID_BAR(); GRID_BAR(); GRID_BAR(); GRID_BAR(); GRID_BAR(); GRID_BAR(); GRID_BAR();
    GRID_BAR(); GRID_BAR(); GRID_BAR(); GRID_BAR(); GRID_BAR(); GRID_BAR(); GRID_BAR(); GRID_BAR(); GRID_BAR(); GRID_BAR();
#endif
#pragma unroll 1
    for (int l = 0; l < NLAYER; ++l) {
        PH_BEGIN();
        phase_inproj(F, l);
        PH_BEGIN();
        phase_prep_moe(F, l);
        GRID_BAR();
        phase_uq(F, l);
        PH_BEGIN();
        phase_ukv(F, l);
        GRID_BAR();
        phase_attn(F);
        GRID_BAR();
        phase_outproj(F, l);
        GRID_BAR();
        phase_route(F, l);
        GRID_BAR();
        phase_moe1(F, l);
        PH_BEGIN();
        phase_pe(F, l);
        GRID_BAR();
        phase_moe2(F, l);
        GRID_BAR();
        phase_norm2(F, l, 1.f);
        GRID_BAR();
        phase_ple(F, l);
        GRID_BAR();
    }
    phase_final(F);
#undef GRID_BAR
#undef PH_BEGIN
}

extern "C" void kernel_launch(void* const* d_in, const int* in_sizes, int n_in, void* d_out, int out_size, void* d_ws, size_t ws_size, hipStream_t stream) {
    if (n_in != 24 || out_size != T * DM || ws_size < WS_END) { fprintf(stderr, "kernel_launch: unexpected shapes (n_in %d, out %d, ws %zu < %zu)\n", n_in, out_size, ws_size, (size_t)WS_END); return; }
    Params P{};
    for (int i = 0; i < 24; ++i) P.in[i] = (const float*)d_in[i];
    P.out = (float*)d_out; P.ws = (unsigned char*)d_ws;
    for (int i = 0; i < 16; ++i) P.inv_freq[i] = (float)pow(10000.0, -(double)i / 16.0);
    (void)hipMemsetAsync((char*)d_ws + WS_CTL, 0, CTL_BYTES, stream);
    static int grid = 0;
    if (grid == 0) {
        int dev = 0, cus = 0;
        if (hipGetDevice(&dev) != hipSuccess || hipDeviceGetAttribute(&cus, hipDeviceAttributeMultiprocessorCount, dev) != hipSuccess || cus <= 0) { grid = -1; return; }
        if (hipFuncSetAttribute((const void*)mega_fwd, hipFuncAttributeMaxDynamicSharedMemorySize, LDS_BYTES) != hipSuccess) { fprintf(stderr, "kernel_launch: hipFuncSetAttribute failed\n"); grid = -1; return; }
        grid = cus;
    }
    if (grid < 0) return;
    hipLaunchKernelGGL(mega_fwd, dim3(grid), dim3(NTHREADS), LDS_BYTES, stream, P);
}
```

```cpp
#include <hip/hip_runtime.h>
#include <cstdio>
#include <cstdint>
#include <cmath>

#define GAS __attribute__((address_space(1)))
#define LAS __attribute__((address_space(3)))
#define GAS __attribute__((address_space(1)))
typedef unsigned short bf16_t;
typedef short bf16x8 __attribute__((ext_vector_type(8)));
typedef float f32x4 __attribute__((ext_vector_type(4)));
typedef float f32x2 __attribute__((ext_vector_type(2)));
typedef unsigned u32x4 __attribute__((ext_vector_type(4)));
typedef unsigned u32x2 __attribute__((ext_vector_type(2)));

constexpr int NB = 8, SEQ = 4096, DM = 1024, NLAYER = 4, T = NB * SEQ;
constexpr int DPLE = 256, SBW = 512, MLAW = 512, QRANK = 384, KVRANK = 256, ROPE = 32, QKD = 96;
constexpr int INC = 2208, INP = 2304;
constexpr int NEXP = 32, DEXP = 256;
constexpr float EPS = 1e-6f;
constexpr float LOG2E = 1.4426950408889634f;
constexpr float QS_SB = 0.125f * LOG2E;
constexpr float QS_MLA = 0.10206207261596575f * LOG2E;
constexpr int NWAVES = 8, NTHREADS = 512;

constexpr size_t MiB = 1u << 20;
constexpr size_t WS_CTL = 0, CTL_BYTES = 1 * MiB;
constexpr size_t WS_COS = 1 * MiB, WS_SIN = 3 * MiB;
constexpr size_t WS_RS = 5 * MiB, WS_RSCQ = 6 * MiB, WS_RSCKV = 7 * MiB;
constexpr size_t WS_LISTE = 8 * MiB, WS_LISTW = 12 * MiB;
constexpr size_t WS_WR = 16 * MiB;
constexpr int RT_PITCH = 1032, RT_STRIDE = 73 * 1024;
constexpr size_t WS_WSM = 18 * MiB, WSM_STRIDE = 11 * MiB;
constexpr size_t WSM_IN = 0, WSM_OUT = 4608 * 1024, WSM_PG = WSM_OUT + 2 * MiB, WSM_UQ = WSM_PG + 2 * MiB, WSM_UKV = WSM_UQ + 576 * 1024, WSM_PE = WSM_UKV + 512 * 1024;
constexpr size_t WS_WG1 = 62 * MiB, WS_WD = 94 * MiB;
constexpr size_t WS_H32 = 110 * MiB, WS_HB = 238 * MiB;
constexpr size_t WS_ATT = 302 * MiB;
constexpr size_t WS_QKV = WS_ATT, WS_CKV = WS_ATT + 96 * MiB, WS_CQ = WS_CKV + 16 * MiB, WS_KR = WS_CQ + 24 * MiB, WS_QM = WS_KR + 2 * MiB,
                 WS_KN = WS_QM + 48 * MiB, WS_VM = WS_KN + 32 * MiB, WS_OA = WS_VM + 32 * MiB, WS_ATT_END = WS_OA + 64 * MiB;
constexpr size_t WS_HBI = WS_H32;
constexpr size_t WS_HID = WS_ATT, WS_Y = WS_ATT + 36 * MiB, WS_MOE_END = WS_Y + 128 * MiB;
constexpr size_t WS_SSQ = (WS_ATT_END > WS_MOE_END ? WS_ATT_END : WS_MOE_END), WS_OSS = WS_SSQ + 2 * MiB, WS_PE = WS_OSS + 2 * MiB, WS_PB = WS_PE + 64 * MiB, WS_END = WS_PB + 16 * MiB;
static_assert(WSM_PE + 512 * 1024 <= WSM_STRIDE, "small weights");
static_assert(WS_WSM + 4 * WSM_STRIDE <= WS_WG1, "ws map");
constexpr int CW_CNT = 8192;

constexpr int LDS_BYTES = 152 * 1024;

struct Params {
    const float* in[24];
    float* out;
    unsigned char* ws;
    float inv_freq[16];
};

__device__ __forceinline__ float bf2f(unsigned v) { return __uint_as_float(v << 16); }
__device__ __forceinline__ unsigned f2bf(float f) { unsigned u = __float_as_uint(f); return (u + 0x7fffu + ((u >> 16) & 1u)) >> 16; }
typedef float f32x2_cv_ __attribute__((ext_vector_type(2)));
typedef __bf16 bf16x2_cv_ __attribute__((ext_vector_type(2)));
__device__ __forceinline__ unsigned pk2(float lo, float hi) { f32x2_cv_ v = {lo, hi}; return __builtin_bit_cast(unsigned, __builtin_convertvector(v, bf16x2_cv_)); }
template <int CTRL> __device__ __forceinline__ float dpp_f(float v) { return __uint_as_float((unsigned)__builtin_amdgcn_update_dpp(0, (int)__float_as_uint(v), CTRL, 0xf, 0xf, true)); }
__device__ __forceinline__ float row16_sum(float v) {
    v += dpp_f<0xB1>(v); v += dpp_f<0x4E>(v); v += dpp_f<0x141>(v); v += dpp_f<0x140>(v); return v; }
__device__ __forceinline__ float wave_sum(float v) {
    v = row16_sum(v);
    const float a = __uint_as_float(__builtin_amdgcn_readlane((int)__float_as_uint(v), 0)), b = __uint_as_float(__builtin_amdgcn_readlane((int)__float_as_uint(v), 16)),
                c = __uint_as_float(__builtin_amdgcn_readlane((int)__float_as_uint(v), 32)), d = __uint_as_float(__builtin_amdgcn_readlane((int)__float_as_uint(v), 48));
    return (a + b) + (c + d);
}
__device__ __forceinline__ float half32_sum(float v) {
    v = row16_sum(v);
    auto rr = __builtin_amdgcn_permlane16_swap(__float_as_uint(v), __float_as_uint(v), false, false);
    return __uint_as_float(rr[0]) + __uint_as_float(rr[1]);
}
__device__ __forceinline__ float xor32(float x) { auto rr = __builtin_amdgcn_permlane32_swap(__float_as_uint(x), __float_as_uint(x), false, false); return __uint_as_float(((unsigned)(threadIdx.x & 32)) ? rr[0] : rr[1]); }
__device__ __forceinline__ float xor16(float x) { auto rr = __builtin_amdgcn_permlane16_swap(__float_as_uint(x), __float_as_uint(x), false, false); return __uint_as_float(((unsigned)(threadIdx.x & 16)) ? rr[0] : rr[1]); }
__device__ __forceinline__ float fexp2(float x) { return __builtin_amdgcn_exp2f(x); }
__device__ __forceinline__ float flog2(float x) { return __builtin_amdgcn_logf(x); }
__device__ __forceinline__ float frcp(float x) { return __builtin_amdgcn_rcpf(x); }
__device__ __forceinline__ void unpack8(u32x4 w, float* f) {
    f[0] = __uint_as_float(w.x << 16); f[1] = __uint_as_float(w.x & 0xffff0000u);
    f[2] = __uint_as_float(w.y << 16); f[3] = __uint_as_float(w.y & 0xffff0000u);
    f[4] = __uint_as_float(w.z << 16); f[5] = __uint_as_float(w.z & 0xffff0000u);
    f[6] = __uint_as_float(w.w << 16); f[7] = __uint_as_float(w.w & 0xffff0000u);
}
__device__ __forceinline__ u32x4 pack8(f32x4 a, f32x4 b) { u32x4 w; w.x = pk2(a[0], a[1]); w.y = pk2(a[2], a[3]); w.z = pk2(b[0], b[1]); w.w = pk2(b[2], b[3]); return w; }

__device__ __forceinline__ float rstd_part16(const float* p, float inv_n) { const f32x4 a = ((const f32x4*)p)[0], b = ((const f32x4*)p)[1], c = ((const f32x4*)p)[2], d = ((const f32x4*)p)[3];
    const f32x4 s4 = (a + b) + (c + d); return 1.0f / sqrtf(((s4[0] + s4[1]) + (s4[2] + s4[3])) * inv_n + EPS); }
__device__ __forceinline__ float rstd_part8(const float* p, float inv_n) { const f32x4 a = ((const f32x4*)p)[0], b = ((const f32x4*)p)[1]; const f32x4 s4 = a + b; return 1.0f / sqrtf(((s4[0] + s4[1]) + (s4[2] + s4[3])) * inv_n + EPS); }
__device__ __forceinline__ float rstd_part4(const float* p, float inv_n) { const f32x4 a = ((const f32x4*)p)[0]; return 1.0f / sqrtf(((a[0] + a[1]) + (a[2] + a[3])) * inv_n + EPS); }
__device__ __forceinline__ float sq8(const f32x4& a, const f32x4& b) { return ((a[0] * a[0] + a[1] * a[1]) + (a[2] * a[2] + a[3] * a[3])) + ((b[0] * b[0] + b[1] * b[1]) + (b[2] * b[2] + b[3] * b[3])); }
__device__ __forceinline__ float fq_sum(float v) { v += xor16(v); v += xor32(v); return v; }

namespace pg8 {
constexpr int BM = 256, BK = 64, HALF = 128, HTB = HALF * BK * 2, STAGE_BYTES = 8 * HTB, NXCD = 8, WGM = 8;
__host__ __device__ __forceinline__ int lds_byte(int r, int c) { const int st = (r >> 4) * 2 + (c >> 5), rr = r & 15, cc = c & 31, ob = rr * 64 + cc * 2; return st * 1024 + (ob ^ (((ob >> 9) & 1) << 5)); }
__host__ __device__ __forceinline__ void stage_rc(int b, int& R, int& C) { const int st = b / 1024, sb = b % 1024, swz = sb ^ (((sb >> 9) & 1) << 5); R = (st >> 1) * 16 + swz / 64; C = (st & 1) * 32 + (swz % 64) / 2; }
__host__ __device__ __forceinline__ int perm32(int rho) { const int n = rho >> 4, i = rho & 15; return 8 * (i >> 2) + 4 * n + (i & 3); }

struct Unit { int pm, pn, e, tile, nrows; };

struct StaticOrder {
    int nM, nN, nwg, G, c;
    __device__ void init(int M, int N, int G_, int c_) { nM = M / BM; nN = N / BM; nwg = nM * nN; G = G_; c = c_; }
    __device__ bool next(int i, Unit& u) const {
        const long L = (long)i * G + c; if (L >= nwg) return false;
        int wgid = (int)L; { const int q = nwg / NXCD, r = nwg % NXCD, xcd = wgid % NXCD, off = wgid / NXCD; wgid = (xcd < r ? xcd * (q + 1) : r * (q + 1) + (xcd - r) * q) + off; }
        const int nig = WGM * nN, gid = wgid / nig, fm = gid * WGM, gsz = (nM - fm) < WGM ? (nM - fm) : WGM;
        u.pm = fm + ((wgid % nig) % gsz); u.pn = (wgid % nig) / gsz; u.e = 0; u.tile = 0; u.nrows = 256; return true;
    }
};

template <class Epi, class Sched>
__device__ __forceinline__ void gemm_phase(LAS unsigned char* lds, const int tid, const char* Abase, const int K, const Sched& S, const Epi& E) {
    const int wid = __builtin_amdgcn_readfirstlane(tid >> 6), lane = tid & 63, wr = wid >> 2, wc = wid & 3, fr = lane & 15, fq = lane >> 4;
    const int nt = K / BK;
    unsigned voffB[2];
#pragma unroll
    for (int i = 0; i < 2; ++i) { int R, C; stage_rc(tid * 16 + i * 8192, R, C); const int Rb = (R & ~31) + perm32(R & 31); voffB[i] = (unsigned)(Rb * K + C) * 2u; }
    const size_t kstep = (size_t)(BK * 2);
    const size_t hstep = (size_t)HALF * K * 2;
    const unsigned ldsw = (unsigned)wid * 1024u;
    const int aoff = lds_byte(wr * 64 + fr, fq * 8), boff = lds_byte(wc * 32 + fr, fq * 8);
#define PG8_SA(b, h) (((b) * 2 + (h)) * HTB)
#define PG8_SB(b, h) ((4 + (b) * 2 + (h)) * HTB)
#define PG8_STAGE(bufoff, gbase, voff) do { _Pragma("unroll") for (int _i = 0; _i < 2; ++_i) \
        __builtin_amdgcn_global_load_lds((const unsigned*)((const char*)(gbase) + (voff)[_i]), (LAS unsigned*)(lds + (bufoff) + ldsw + _i * 8192), 16, 0, 0); } while (0)
#define PG8_LDA(dst, b, h) do { _Pragma("unroll") for (int m = 0; m < 4; ++m) _Pragma("unroll") for (int k = 0; k < 2; ++k) dst[m][k] = *(const LAS bf16x8*)(lds + PG8_SA(b, h) + aoff + m * 2048 + k * 1024); } while (0)
#define PG8_LDB(dst, b, h) do { _Pragma("unroll") for (int n = 0; n < 2; ++n) _Pragma("unroll") for (int k = 0; k < 2; ++k) dst[n][k] = *(const LAS bf16x8*)(lds + PG8_SB(b, h) + boff + n * 2048 + k * 1024); } while (0)
#define PG8_MMA(ai, bj, At, Bt) do { __builtin_amdgcn_s_setprio(1); _Pragma("unroll") for (int m = 0; m < 4; ++m) _Pragma("unroll") for (int n = 0; n < 2; ++n) _Pragma("unroll") for (int k = 0; k < 2; ++k) \
        acc[ai][bj][m][n] = __builtin_amdgcn_mfma_f32_16x16x32_bf16(Bt[n][k], At[m][k], acc[ai][bj][m][n], 0, 0, 0); __builtin_amdgcn_s_setprio(0); } while (0)
#define PG8_WAIT_V(n) asm volatile("s_waitcnt vmcnt(" #n ")" ::: "memory")
#define PG8_WAIT_L(n) asm volatile("s_waitcnt lgkmcnt(" #n ")" ::: "memory")
#define PG8_BAR __builtin_amdgcn_s_barrier()
#define PG8_SCHED __builtin_amdgcn_sched_barrier(0)
    Unit cur, nxt; int ui = 0;
    if (!S.next(0, cur)) return;
    f32x4 acc[2][2][4][2];
#pragma unroll
    for (int a = 0; a < 2; ++a)
#pragma unroll
        for (int b = 0; b < 2; ++b)
#pragma unroll
            for (int m = 0; m < 4; ++m)
#pragma unroll
                for (int n = 0; n < 2; ++n) acc[a][b][m][n] = (f32x4){0.f, 0.f, 0.f, 0.f};
    bf16x8 At[4][2], B0[2][2], B1[2][2];
    unsigned vc[2][2];
    LAS u32x4* vslot = (LAS u32x4*)(lds + STAGE_BYTES + 1024) + tid;
#define PG8_AOFFS(dst, U) do { int t2_ = tid; asm volatile("" : "+v"(t2_)); _Pragma("unroll") for (int i = 0; i < 2; ++i) { int R, C; stage_rc(t2_ * 16 + i * 8192, R, C); \
        dst[0][i] = S.a_off(U, R) + (unsigned)C * 2u; dst[1][i] = S.a_off(U, HALF + R) + (unsigned)C * 2u; } } while (0)
    PG8_AOFFS(vc, cur);
    const char* cB = S.b_tile(cur);
    E.begin(cur, ui, tid, lds);
    PG8_STAGE(PG8_SB(0, 0), cB, voffB); PG8_STAGE(PG8_SB(0, 1), cB + hstep, voffB); PG8_STAGE(PG8_SA(0, 0), Abase, vc[0]); PG8_STAGE(PG8_SA(0, 1), Abase, vc[1]);
    if (wr == 1) PG8_BAR;
    PG8_WAIT_V(2); PG8_BAR;
    PG8_STAGE(PG8_SB(1, 0), cB + kstep, voffB); PG8_STAGE(PG8_SA(1, 0), Abase + kstep, vc[0]); PG8_STAGE(PG8_SB(1, 1), cB + hstep + kstep, voffB);
    PG8_WAIT_V(6); PG8_BAR;
    for (;;) {
        const bool has_next = S.next(ui + 1, nxt);
        const char* nB = cB;
        { unsigned vn[2][2];
          if (has_next) { PG8_AOFFS(vn, nxt); nB = S.b_tile(nxt); *vslot = (u32x4){vn[0][0], vn[0][1], vn[1][0], vn[1][1]}; }
          else *vslot = (u32x4){vc[0][0], vc[0][1], vc[1][0], vc[1][1]}; }
        for (int t = 0; t < nt; t += 2) {
            if constexpr (Epi::MID) { if (t == (nt >> 1)) E.mid(acc, ui, wr, fr, lds); }
            const bool last = (t == nt - 2);
            const char* a1 = Abase + (size_t)(t + 1) * kstep;
            const char* a2 = last ? Abase : Abase + (size_t)(t + 2) * kstep; const char* b2 = last ? nB : cB + (size_t)(t + 2) * kstep;
            const char* a3 = a2 + kstep; const char* b3 = b2 + kstep;
            unsigned w2[2][2];
            if (last) { const u32x4 q = *vslot; w2[0][0] = q.x; w2[0][1] = q.y; w2[1][0] = q.z; w2[1][1] = q.w; }
            else { w2[0][0] = vc[0][0]; w2[0][1] = vc[0][1]; w2[1][0] = vc[1][0]; w2[1][1] = vc[1][1]; }
            PG8_LDB(B0, 0, 0); PG8_LDB(B1, 0, 1); PG8_SCHED; PG8_LDA(At, 0, 0); PG8_STAGE(PG8_SA(1, 1), a1, vc[1]);
            PG8_WAIT_V(8); PG8_WAIT_L(0); PG8_BAR; PG8_MMA(0, 0, At, B0); PG8_MMA(0, 1, At, B1); PG8_BAR; PG8_SCHED;
            PG8_LDA(At, 0, 1); PG8_STAGE(PG8_SB(0, 0), b2, voffB); PG8_STAGE(PG8_SB(0, 1), b2 + hstep, voffB); PG8_STAGE(PG8_SA(0, 0), a2, w2[0]);
            PG8_WAIT_V(8); PG8_WAIT_L(0); PG8_BAR; PG8_MMA(1, 0, At, B0); PG8_MMA(1, 1, At, B1); PG8_BAR; PG8_SCHED;
            PG8_LDB(B0, 1, 0); PG8_LDB(B1, 1, 1); PG8_SCHED; PG8_LDA(At, 1, 0); PG8_STAGE(PG8_SA(0, 1), a2, w2[1]);
            PG8_WAIT_V(8); PG8_WAIT_L(0); PG8_BAR; PG8_MMA(0, 0, At, B0); PG8_MMA(0, 1, At, B1); PG8_BAR; PG8_SCHED;
            PG8_LDA(At, 1, 1); PG8_STAGE(PG8_SB(1, 0), b3, voffB); PG8_STAGE(PG8_SB(1, 1), b3 + hstep, voffB); PG8_STAGE(PG8_SA(1, 0), a3, w2[0]);
            PG8_WAIT_V(8); PG8_WAIT_L(0); PG8_BAR; PG8_MMA(1, 0, At, B0); PG8_MMA(1, 1, At, B1); PG8_BAR; PG8_SCHED;
        }
        if (wr == 0) PG8_BAR;
        { int t3 = tid; asm volatile("" : "+v"(t3)); const int fr2 = t3 & 15, fq2 = (t3 >> 4) & 3;
          E(acc, cur, ui, wr, wc, fr2, fq2, lds); }
        if (!has_next) break;
#pragma unroll
        for (int a = 0; a < 2; ++a)
#pragma unroll
            for (int b = 0; b < 2; ++b)
#pragma unroll
                for (int m = 0; m < 4; ++m)
#pragma unroll
                    for (int n = 0; n < 2; ++n) acc[a][b][m][n] = (f32x4){0.f, 0.f, 0.f, 0.f};
        cur = nxt; cB = nB; ++ui;
        E.begin(cur, ui, tid, lds);
        { const u32x4 q = *vslot; vc[0][0] = q.x; vc[0][1] = q.y; vc[1][0] = q.z; vc[1][1] = q.w; }
        if (wr == 1) PG8_BAR;
    }
    PG8_WAIT_V(0);
    PG8_BAR;
#undef PG8_AOFFS
#undef PG8_SA
#undef PG8_SB
#undef PG8_STAGE
#undef PG8_LDA
#undef PG8_LDB
#undef PG8_MMA
#undef PG8_WAIT_V
#undef PG8_WAIT_L
#undef PG8_BAR
#undef PG8_SCHED
}
}
using pg8::Unit;

struct DenseSched {
    pg8::StaticOrder o; const char* Bt; int K;
    __device__ __forceinline__ bool next(int i, Unit& u) const { return o.next(i, u); }
    __device__ __forceinline__ unsigned a_off(const Unit& u, int r) const { return (unsigned)(u.pm * 256 + r) * (unsigned)(K * 2); }
    __device__ __forceinline__ const char* b_tile(const Unit& u) const { return Bt + (size_t)u.pn * 256 * K * 2; }
};
struct MoeSched {
    int G, c, npn, gather; const LAS int* tb; const int* liste; const char* Bt; int K, nB;
    __device__ __forceinline__ bool next(int i, Unit& u) const {
        if ((G & 7) == 0) {
            const int x = c & 7, W = G >> 3, q = i * W + (c >> 3);
            int tq = q / npn; u.pn = q % npn;
#pragma unroll 1
            for (int k = 0; k < 4; ++k) { const int e = x + 8 * k, nte = tb[e + 1] - tb[e];
                if (tq < nte) { u.e = e; u.tile = tq; u.pm = tb[e] + tq; const int rem = tb[40 + e] - 256 * tq; u.nrows = rem < 256 ? rem : 256; return true; }
                tq -= nte; }
            return false;
        }
        const int L = i * G + c, ntile = tb[32];
        if (L >= ntile * npn) return false;
        const int ti = L / npn; u.pn = L % npn; u.pm = ti;
        int e = 0;
#pragma unroll 1
        for (; e < 31; ++e) if (ti < tb[e + 1]) break;
        u.e = e; u.tile = ti - tb[e]; const int rem = tb[40 + e] - 256 * u.tile; u.nrows = rem < 256 ? rem : 256; return true;
    }
    __device__ __forceinline__ unsigned a_off(const Unit& u, int r) const {
        if (gather) { int tok = 0; if (r < u.nrows) tok = liste[(size_t)u.e * T + 256 * u.tile + r] >> 1; return (unsigned)tok * (unsigned)(K * 2); }
        return (unsigned)(u.pm * 256 + r) * (unsigned)(K * 2);
    }
    __device__ __forceinline__ const char* b_tile(const Unit& u) const { return Bt + ((size_t)u.e * nB + (size_t)u.pn * 256) * K * 2; }
};

#define EPI_DEFAULTS static constexpr bool MID = false; __device__ __forceinline__ void begin(const Unit&, int, int, LAS unsigned char*) const {}
#define EPI_NOMID static constexpr bool MID = false;
constexpr int RTAB_OFF = pg8::STAGE_BYTES + 1024 + 8192;
__device__ __forceinline__ void rtab_put(LAS unsigned char* lds, int ui, int r, float a, float b) { asm volatile("" : "+v"(r));
    ((LAS f32x2*)(lds + RTAB_OFF))[(ui & 1) * 256 + r] = (f32x2){a, b}; }
__device__ __forceinline__ f32x2 rtab_get(LAS unsigned char* lds, int ui, int r) { return ((const LAS f32x2*)(lds + RTAB_OFF))[(ui & 1) * 256 + r]; }
struct EpiIn {
    EPI_NOMID
    __device__ __forceinline__ void begin(const Unit& u, int ui, int tid, LAS unsigned char* lds) const { if (tid < 256) rtab_put(lds, ui, tid, rstd_part16(SSQ + (size_t)(u.pm * 256 + tid) * 16, 1.f / DM), 0.f); }
    const float* SSQ; bf16_t* QKV; bf16_t* CKV; bf16_t* CQ; bf16_t* KR; const float* COS; const float* SIN; float* SQQ; float* SQK;
    __device__ __forceinline__ void operator()(const f32x4 (&acc)[2][2][4][2], const Unit& u, int ui, int wr, int wc, int fr, int fq, LAS unsigned char* lds) const {
        const int pn = u.pn;
#pragma unroll
        for (int ai = 0; ai < 2; ++ai)
#pragma unroll
            for (int m = 0; m < 4; ++m) {
                const int rr = ai * 128 + wr * 64 + m * 16 + fr, row = u.pm * 256 + rr; const float rs = rtab_get(lds, ui, rr)[0];
                float sq = 0.f;
#pragma unroll
                for (int bj = 0; bj < 2; ++bj) {
                    const int c = bj * 128 + wc * 32 + fq * 8;
                    f32x4 v0 = acc[ai][bj][m][0] * rs, v1 = acc[ai][bj][m][1] * rs;
                    if (pn < 6) { if (pn < 2) { v0 = v0 * QS_SB; v1 = v1 * QS_SB; } *(u32x4*)(QKV + (size_t)row * 1536 + pn * 256 + c) = pack8(v0, v1); }
                    else if (pn == 6) { *(u32x4*)(CKV + (size_t)row * 256 + c) = pack8(v0, v1); sq += sq8(v0, v1); }
                    else if (pn == 7) { *(u32x4*)(CQ + (size_t)row * 384 + c) = pack8(v0, v1); sq += sq8(v0, v1); }
                    else if (bj == 0) { *(u32x4*)(CQ + (size_t)row * 384 + 256 + c) = pack8(v0, v1); sq += sq8(v0, v1); }
                    else if (wc == 0) {
                        const int ib = 8 * (fq & 1);
                        const f32x4 c0 = *(const f32x4*)(COS + (size_t)row * 16 + ib), c1 = *(const f32x4*)(COS + (size_t)row * 16 + ib + 4);
                        const f32x4 s0 = *(const f32x4*)(SIN + (size_t)row * 16 + ib), s1 = *(const f32x4*)(SIN + (size_t)row * 16 + ib + 4);
                        f32x4 p0, p1;
#pragma unroll
                        for (int i = 0; i < 4; ++i) { p0[i] = xor32(v0[i]); p1[i] = xor32(v1[i]); }
                        const float sg = (fq < 2) ? -1.f : 1.f;
                        const f32x4 o0 = v0 * c0 + p0 * s0 * sg, o1 = v1 * c1 + p1 * s1 * sg;
                        *(u32x4*)(KR + (size_t)row * 32 + fq * 8) = pack8(o0, o1);
                    }
                }
                if (pn >= 6) {
                    sq = fq_sum(sq);
                    if (fq == 0) { if (pn == 6) SQK[(size_t)row * 4 + wc] = sq; else SQQ[(size_t)row * 8 + (pn - 7) * 4 + wc] = sq; }
                }
                asm volatile("" ::: "memory");
            }
    }
};
struct EpiUq {
    EPI_NOMID
    __device__ __forceinline__ void begin(const Unit& u, int ui, int tid, LAS unsigned char* lds) const { if (tid < 256) rtab_put(lds, ui, tid, rstd_part8(RS + (size_t)(u.pm * 256 + tid) * 8, 1.f / QRANK) * QS_MLA, 0.f); }
    const float* RS; bf16_t* QM; const float* COS; const float* SIN;
    __device__ __forceinline__ void operator()(const f32x4 (&acc)[2][2][4][2], const Unit& u, int ui, int wr, int wc, int fr, int fq, LAS unsigned char* lds) const {
#pragma unroll
        for (int ai = 0; ai < 2; ++ai)
#pragma unroll
            for (int m = 0; m < 4; ++m) {
                const int rr = ai * 128 + wr * 64 + m * 16 + fr, row = u.pm * 256 + rr; const float rs = rtab_get(lds, ui, rr)[0];
#pragma unroll
                for (int bj = 0; bj < 2; ++bj) {
                    const int c = u.pn * 256 + bj * 128 + wc * 32 + fq * 8; const int g32 = u.pn * 8 + bj * 4 + wc;
                    f32x4 v0 = acc[ai][bj][m][0] * rs, v1 = acc[ai][bj][m][1] * rs;
                    if ((g32 % 3) == 2) {
                        const int ib = 8 * (fq & 1);
                        const f32x4 c0 = *(const f32x4*)(COS + (size_t)row * 16 + ib), c1 = *(const f32x4*)(COS + (size_t)row * 16 + ib + 4);
                        const f32x4 s0 = *(const f32x4*)(SIN + (size_t)row * 16 + ib), s1 = *(const f32x4*)(SIN + (size_t)row * 16 + ib + 4);
                        f32x4 p0, p1;
#pragma unroll
                        for (int i = 0; i < 4; ++i) { p0[i] = xor32(v0[i]); p1[i] = xor32(v1[i]); }
                        const float sg = (fq < 2) ? -1.f : 1.f;
                        v0 = v0 * c0 + p0 * s0 * sg; v1 = v1 * c1 + p1 * s1 * sg;
                    }
                    *(u32x4*)(QM + (size_t)row * 768 + c) = pack8(v0, v1);
                }
                asm volatile("" ::: "memory");
            }
    }
};
struct EpiUkv {
    EPI_NOMID
    __device__ __forceinline__ void begin(const Unit& u, int ui, int tid, LAS unsigned char* lds) const { if (tid < 256) rtab_put(lds, ui, tid, rstd_part4(RS + (size_t)(u.pm * 256 + tid) * 4, 1.f / KVRANK), 0.f); }
    const float* RS; bf16_t* KN; bf16_t* VM;
    __device__ __forceinline__ void operator()(const f32x4 (&acc)[2][2][4][2], const Unit& u, int ui, int wr, int wc, int fr, int fq, LAS unsigned char* lds) const {
        bf16_t* dst = u.pn < 2 ? KN : VM; const int cb = (u.pn & 1) * 256;
#pragma unroll
        for (int ai = 0; ai < 2; ++ai)
#pragma unroll
            for (int m = 0; m < 4; ++m) {
                const int rr = ai * 128 + wr * 64 + m * 16 + fr, row = u.pm * 256 + rr; const float rs = rtab_get(lds, ui, rr)[0];
#pragma unroll
                for (int bj = 0; bj < 2; ++bj) { const int c = cb + bj * 128 + wc * 32 + fq * 8;
                    *(u32x4*)(dst + (size_t)row * 512 + c) = pack8(acc[ai][bj][m][0] * rs, acc[ai][bj][m][1] * rs); }
            }
    }
};
struct EpiBf {
    EPI_DEFAULTS
    bf16_t* O; int ldc;
    __device__ __forceinline__ void operator()(const f32x4 (&acc)[2][2][4][2], const Unit& u, int ui, int wr, int wc, int fr, int fq, LAS unsigned char* lds) const {
#pragma unroll
        for (int ai = 0; ai < 2; ++ai)
#pragma unroll
            for (int m = 0; m < 4; ++m) {
                const int row = u.pm * 256 + ai * 128 + wr * 64 + m * 16 + fr;
#pragma unroll
                for (int bj = 0; bj < 2; ++bj) { const int c = u.pn * 256 + bj * 128 + wc * 32 + fq * 8;
                    *(u32x4*)(O + (size_t)row * ldc + c) = pack8(acc[ai][bj][m][0], acc[ai][bj][m][1]); }
            }
    }
};
constexpr int OTAB_OFF = RTAB_OFF;
struct EpiOut {
    static constexpr bool MID = true;
    const float* xin; const bf16_t* hin; bf16_t* hout; const float* OSS;
    __device__ __forceinline__ void begin(const Unit& u, int ui, int tid, LAS unsigned char* lds) const {
        if (tid < 256) { const float* p = OSS + (size_t)(u.pm * 256 + tid) * 16; const f32x4 a = ((const f32x4*)p)[0], b = ((const f32x4*)p)[1], c = ((const f32x4*)p)[2], d = ((const f32x4*)p)[3];
            const f32x4 s1 = a + b, s2 = c + d; const float rs = 1.0f / sqrtf(((s1[0] + s1[1]) + (s1[2] + s1[3])) * (1.f / 512.f) + EPS), rm = 1.0f / sqrtf(((s2[0] + s2[1]) + (s2[2] + s2[3])) * (1.f / 512.f) + EPS);
            ((LAS f32x2*)(lds + OTAB_OFF))[(ui & 1) * 256 + tid] = (f32x2){rs / rm, rm}; }
    }
    __device__ __forceinline__ void mid(f32x4 (&acc)[2][2][4][2], int ui, int wr, int fr, LAS unsigned char* lds) const {
#pragma unroll
        for (int ai = 0; ai < 2; ++ai)
#pragma unroll
            for (int m = 0; m < 4; ++m) { const float f = ((const LAS f32x2*)(lds + OTAB_OFF))[(ui & 1) * 256 + ai * 128 + wr * 64 + m * 16 + fr][0];
#pragma unroll
                for (int bj = 0; bj < 2; ++bj)
#pragma unroll
                    for (int n = 0; n < 2; ++n) acc[ai][bj][m][n] = acc[ai][bj][m][n] * f; }
    }
    __device__ __forceinline__ void operator()(const f32x4 (&acc)[2][2][4][2], const Unit& u, int ui, int wr, int wc, int fr, int fq, LAS unsigned char* lds) const {
#pragma unroll
        for (int ai = 0; ai < 2; ++ai) {
            if (xin) {
#pragma unroll
                for (int m = 0; m < 4; ++m) { const int r = ai * 128 + wr * 64 + m * 16 + fr, row = u.pm * 256 + r; const float rm = rtab_get(lds, ui, r)[1];
#pragma unroll
                    for (int bj = 0; bj < 2; ++bj) { const size_t o = (size_t)row * DM + u.pn * 256 + bj * 128 + wc * 32 + fq * 8;
                        const f32x4 a = *(const f32x4*)(xin + o), b = *(const f32x4*)(xin + o + 4);
                        *(u32x4*)(hout + o) = pack8(a + acc[ai][bj][m][0] * rm, b + acc[ai][bj][m][1] * rm); }
                    asm volatile("" ::: "memory"); }
            } else {
                u32x4 hb[4][2];
#pragma unroll
                for (int m = 0; m < 4; ++m)
#pragma unroll
                    for (int bj = 0; bj < 2; ++bj) hb[m][bj] = *(const u32x4*)(hin + (size_t)(u.pm * 256 + ai * 128 + wr * 64 + m * 16 + fr) * DM + u.pn * 256 + bj * 128 + wc * 32 + fq * 8);
#pragma unroll
                for (int m = 0; m < 4; ++m) { const int r = ai * 128 + wr * 64 + m * 16 + fr, row = u.pm * 256 + r; const float rm = rtab_get(lds, ui, r)[1];
#pragma unroll
                    for (int bj = 0; bj < 2; ++bj) { const size_t o = (size_t)row * DM + u.pn * 256 + bj * 128 + wc * 32 + fq * 8;
                        float f[8]; unpack8(hb[m][bj], f);
                        *(u32x4*)(hout + o) = pack8((f32x4){f[0], f[1], f[2], f[3]} + acc[ai][bj][m][0] * rm, (f32x4){f[4], f[5], f[6], f[7]} + acc[ai][bj][m][1] * rm); } }
            }
            asm volatile("" ::: "memory");
        }
    }
};
struct EpiG1 {
    EPI_NOMID
    __device__ __forceinline__ void begin(const Unit& u, int ui, int tid, LAS unsigned char* lds) const {
        if (tid < 256) { float rs = 0.f; if (tid < u.nrows) rs = RS[liste[(size_t)u.e * T + 256 * u.tile + tid] >> 1]; rtab_put(lds, ui, tid, rs, 0.f); } }
    const float* RS; const int* liste; bf16_t* HID;
    __device__ __forceinline__ void operator()(const f32x4 (&acc)[2][2][4][2], const Unit& u, int ui, int wr, int wc, int fr, int fq, LAS unsigned char* lds) const {
#pragma unroll
        for (int ai = 0; ai < 2; ++ai)
#pragma unroll
            for (int m = 0; m < 4; ++m) {
                const int r = ai * 128 + wr * 64 + m * 16 + fr;
                if (r < u.nrows) {
                    const float rs = rtab_get(lds, ui, r)[0];
                    f32x4 h[2];
#pragma unroll
                    for (int n = 0; n < 2; ++n) { const f32x4 g = acc[ai][0][m][n] * rs, up = acc[ai][1][m][n] * rs;
#pragma unroll
                        for (int i = 0; i < 4; ++i) h[n][i] = g[i] * frcp(1.f + fexp2(-g[i] * LOG2E)) * up[i]; }
                    *(u32x4*)(HID + (size_t)(u.pm * 256 + r) * 256 + u.pn * 128 + wc * 32 + fq * 8) = pack8(h[0], h[1]);
                }
                asm volatile("" ::: "memory");
            }
    }
};
struct EpiDn {
    EPI_NOMID
    __device__ __forceinline__ void begin(const Unit& u, int ui, int tid, LAS unsigned char* lds) const {
        asm volatile("" : "+v"(tid));
        if (tid < 256) { int ent = 0; float w = 0.f; if (tid < u.nrows) { const size_t li = (size_t)u.e * T + 256 * u.tile + tid; ent = liste[li]; w = listw[li]; } rtab_put(lds, ui, tid, __int_as_float(ent), w); } }
    const int* liste; const float* listw; bf16_t* Y;
    __device__ __forceinline__ void operator()(const f32x4 (&acc)[2][2][4][2], const Unit& u, int ui, int wr, int wc, int fr, int fq, LAS unsigned char* lds) const {
#pragma unroll
        for (int ai = 0; ai < 2; ++ai)
#pragma unroll
            for (int m = 0; m < 4; ++m) {
                const int r = ai * 128 + wr * 64 + m * 16 + fr;
                if (r < u.nrows) {
                    const f32x2 te = rtab_get(lds, ui, r); const int ent = __float_as_int(te[0]); const float w = te[1];
#pragma unroll
                    for (int bj = 0; bj < 2; ++bj) { const int c = u.pn * 256 + bj * 128 + wc * 32 + fq * 8;
                        *(u32x4*)(Y + (size_t)ent * DM + c) = pack8(acc[ai][bj][m][0] * w, acc[ai][bj][m][1] * w); }
                }
                asm volatile("" ::: "memory");
            }
    }
};
struct EpiPle {
    EPI_NOMID
    __device__ __forceinline__ void begin(const Unit& u, int ui, int tid, LAS unsigned char* lds) const { if (tid < 256) rtab_put(lds, ui, tid, RS[u.pm * 256 + tid], 0.f); }
    const float* RS; const bf16_t* PE; const bf16_t* H; bf16_t* HO; float* SSQ;
    __device__ __forceinline__ void operator()(const f32x4 (&acc)[2][2][4][2], const Unit& u, int ui, int wr, int wc, int fr, int fq, LAS unsigned char* lds) const {
#pragma unroll
        for (int ai = 0; ai < 2; ++ai) {
            u32x4 hb[4][2], pb[4][2];
#pragma unroll
            for (int m = 0; m < 4; ++m)
#pragma unroll
                for (int bj = 0; bj < 2; ++bj) { const size_t o = (size_t)(u.pm * 256 + ai * 128 + wr * 64 + m * 16 + fr) * DM + u.pn * 256 + bj * 128 + wc * 32 + fq * 8;
                    hb[m][bj] = *(const GAS u32x4*)(H + o); pb[m][bj] = *(const GAS u32x4*)(PE + o); }
#pragma unroll
            for (int m = 0; m < 4; ++m) {
                const int rr = ai * 128 + wr * 64 + m * 16 + fr, row = u.pm * 256 + rr; const float rs = rtab_get(lds, ui, rr)[0];
                float sq = 0.f;
#pragma unroll
                for (int bj = 0; bj < 2; ++bj) { const size_t o = (size_t)row * DM + u.pn * 256 + bj * 128 + wc * 32 + fq * 8;
                    float pe[8], hv[8]; unpack8(pb[m][bj], pe); unpack8(hb[m][bj], hv);
#pragma unroll
                    for (int i = 0; i < 4; ++i) { hv[i] += frcp(1.f + fexp2(-acc[ai][bj][m][0][i] * rs * LOG2E)) * pe[i]; hv[4 + i] += frcp(1.f + fexp2(-acc[ai][bj][m][1][i] * rs * LOG2E)) * pe[4 + i]; }
                    const u32x4 w = (u32x4){pk2(hv[0], hv[1]), pk2(hv[2], hv[3]), pk2(hv[4], hv[5]), pk2(hv[6], hv[7])};
                    *(GAS u32x4*)(HO + o) = w; unpack8(w, hv);
#pragma unroll
                    for (int i = 0; i < 8; ++i) sq += hv[i] * hv[i]; }
                sq = fq_sum(sq);
                if (fq == 0) *(GAS float*)(SSQ + (size_t)row * 16 + u.pn * 4 + wc) = sq;
            }
            asm volatile("" ::: "memory");
        }
    }
};


#define XB_TMO      128
#define XB_XCNT(j)  (256  + 64 * (j))
#define XB_XSUB(j)  (1280 + 64 * (j))
#define XB_XGEN(j)  (2304 + 64 * (j))
#define XB_TOP      3328
#define XB_TOPGEN   3392
#define XCD_BAR_WORDS 3456
#define XB_SPIN_CAP (1u << 18)

__device__ __forceinline__ unsigned xb_ld(unsigned* p)              { return __hip_atomic_load(p, __ATOMIC_RELAXED, __HIP_MEMORY_SCOPE_AGENT); }
__device__ __forceinline__ unsigned xb_add(unsigned* p, unsigned v) { return __hip_atomic_fetch_add(p, v, __ATOMIC_RELAXED, __HIP_MEMORY_SCOPE_AGENT); }
__device__ __forceinline__ unsigned xb_xcc_id() { return (unsigned)__builtin_amdgcn_s_getreg((3 << 11) | 20) & 0xFu; }
#define XB_SPIN(cond, bar) do { unsigned _sp = 0; while (cond) { __builtin_amdgcn_s_sleep(1); \
    if ((++_sp & 255u) == 0u) { if (xb_ld(&(bar)[XB_TMO])) break; if (_sp > XB_SPIN_CAP) { atomicAdd(&(bar)[XB_TMO], 1u); break; } } } } while (0)

struct XcdBarrier {
    unsigned* bar; unsigned x;
    volatile LAS unsigned* st;
};

__device__ __forceinline__ XcdBarrier xcd_barrier_post(unsigned* bar, volatile LAS unsigned* st) {
    XcdBarrier b; b.bar = bar; b.x = xb_xcc_id(); b.st = st;
    if (threadIdx.x == 0) (void)xb_add(&bar[XB_XCNT(b.x)], 1u);
    return b;
}
__device__ __forceinline__ void xcd_barrier_complete(unsigned* bar, unsigned x, unsigned& nloc, unsigned& nx) {
    const unsigned G = gridDim.x * gridDim.y * gridDim.z;
    unsigned sum, cnt, mine, sp = 0u;
    for (;;) {
        sum = 0u; cnt = 0u; mine = 0u;
#pragma unroll
        for (unsigned j = 0; j < 16; ++j) { const unsigned c = xb_ld(&bar[XB_XCNT(j)]); sum += c; cnt += (c > 0u) ? 1u : 0u; mine = (j == x) ? c : mine; }
        if (sum == G) break;
        __builtin_amdgcn_s_sleep(1);
        if ((++sp & 255u) == 0u) { if (xb_ld(&bar[XB_TMO])) break; if (sp > XB_SPIN_CAP) { atomicAdd(&bar[XB_TMO], 1u); break; } }
    }
    nloc = mine > 0u ? mine : 1u; nx = cnt > 0u ? cnt : 1u;
}

__device__ __forceinline__ void xcd_barrier(const XcdBarrier& b) {
    asm volatile("s_waitcnt vmcnt(0)" ::: "memory");
    __syncthreads();
    if (threadIdx.x == 0) {
        unsigned* bar = b.bar;
        __builtin_amdgcn_s_waitcnt(0);
        unsigned nloc = b.st[0], nx = b.st[1];
        if (nloc == 0u) { xcd_barrier_complete(bar, b.x, nloc, nx); b.st[0] = nloc; b.st[1] = nx; }
        const unsigned old = xb_add(&bar[XB_XSUB(b.x)], 1u);
        const unsigned gen = old / nloc;
        if (old + 1u == (gen + 1u) * nloc) {
            __builtin_amdgcn_fence(__ATOMIC_RELEASE, "agent");
            asm volatile("s_waitcnt vmcnt(0)" ::: "memory");
            const unsigned og = xb_add(&bar[XB_TOP], 1u);
            const unsigned tg = og / nx;
            if (og + 1u == (tg + 1u) * nx) xb_add(&bar[XB_TOPGEN], 1u);
            else XB_SPIN(xb_ld(&bar[XB_TOPGEN]) == tg, bar);
            __builtin_amdgcn_fence(__ATOMIC_ACQUIRE, "agent");
            xb_add(&bar[XB_XGEN(b.x)], 1u);
            asm volatile("s_waitcnt vmcnt(0)" ::: "memory");
        } else {
            XB_SPIN(xb_ld(&bar[XB_XGEN(b.x)]) == gen, bar);
            __builtin_amdgcn_fence(__ATOMIC_ACQUIRE, "agent");
            asm volatile("s_waitcnt vmcnt(0)" ::: "memory");
        }
    }
    __syncthreads();
}


struct Frame {
    LAS unsigned char* lds; int tid, lane, wave, G, bx;
    const Params* P; unsigned char* ws;
    __device__ __forceinline__ int gw() const { return bx * NWAVES + wave; }
    __device__ __forceinline__ int ngw() const { return G * NWAVES; }
};
template <class Tp> __device__ __forceinline__ Tp* wsp(const Frame& F, size_t off) { return (Tp*)(F.ws + off); }

__device__ __forceinline__ void prep_item(const float* W, int ldw, int srccol0, const float* g, bf16_t* dstrow0, int K, int k0, LAS float* scr, int lane) {
    const int c = lane & 7;
    if (srccol0 < 0) {
#pragma unroll
        for (int j = 0; j < 4; ++j) { const int n = (lane >> 3) + 8 * j; *(u32x4*)(dstrow0 + (size_t)n * K + k0 + 8 * c) = (u32x4){0u, 0u, 0u, 0u}; }
        return;
    }
#pragma unroll 8
    for (int i = 0; i < 32; ++i) { const int kk = 2 * i + (lane >> 5); float v = W[(size_t)(k0 + kk) * ldw + srccol0 + (lane & 31)]; if (g) v *= g[k0 + kk]; scr[kk * 33 + (lane & 31)] = v; }
    asm volatile("s_waitcnt lgkmcnt(0)" ::: "memory");
#pragma unroll
    for (int j = 0; j < 4; ++j) { const int n = (lane >> 3) + 8 * j; const LAS float* s = scr + (8 * c) * 33 + n;
        u32x4 o; o.x = pk2(s[0 * 33], s[1 * 33]); o.y = pk2(s[2 * 33], s[3 * 33]); o.z = pk2(s[4 * 33], s[5 * 33]); o.w = pk2(s[6 * 33], s[7 * 33]);
        *(u32x4*)(dstrow0 + (size_t)n * K + k0 + 8 * c) = o; }
    asm volatile("s_waitcnt lgkmcnt(0)" ::: "memory");
}
__device__ __forceinline__ void phase_prep_small(Frame& F) {
    const Params& P = *F.P;
    LAS float* scr = (LAS float*)(F.lds + F.wave * 16384);
    constexpr int I_IN = 16 * 72, I_UQ = 6 * 24, I_UKV = 4 * 32, I_OUT = 16 * 32, I_PG = 16 * 32, I_PE = 4 * 32, I_L = I_IN + I_UQ + I_UKV + I_OUT + I_PG + I_PE;
    for (int it = F.gw(); it < NLAYER * I_L; it += F.ngw()) {
        const int l = it / I_L; int r = it % I_L;
        unsigned char* wb = F.ws + WS_WSM + (size_t)l * WSM_STRIDE;
        if (r < I_IN) { const int kb = r / 72, gi = r % 72, n0 = gi * 32; int src;
            if (n0 < 1536) src = n0; else if (n0 < 1792) src = 1920 + (n0 - 1536); else if (n0 < 2176) src = 1536 + (n0 - 1792); else if (n0 < 2208) src = n0; else src = -1;
            prep_item(P.in[4] + (size_t)l * DM * INC, INC, src, P.in[3] + l * DM, (bf16_t*)(wb + WSM_IN) + (size_t)n0 * DM, DM, kb * 64, scr, F.lane); continue; }
        r -= I_IN;
        if (r < I_UQ) { const int kb = r / 24, n0 = (r % 24) * 32;
            prep_item(P.in[6] + (size_t)l * QRANK * 768, 768, n0, P.in[5] + l * QRANK, (bf16_t*)(wb + WSM_UQ) + (size_t)n0 * QRANK, QRANK, kb * 64, scr, F.lane); continue; }
        r -= I_UQ;
        if (r < I_UKV) { const int kb = r / 32, n0 = (r % 32) * 32; const int hh = (n0 & 511) >> 6, d = n0 & 63; const int src = hh * 128 + (n0 >= 512 ? 64 : 0) + d;
            prep_item(P.in[8] + (size_t)l * KVRANK * 1024, 1024, src, P.in[7] + l * KVRANK, (bf16_t*)(wb + WSM_UKV) + (size_t)n0 * KVRANK, KVRANK, kb * 64, scr, F.lane); continue; }
        r -= I_UKV;
        if (r < I_OUT) { const int kb = r / 32, n0 = (r % 32) * 32; const int k0 = kb * 64;
            const float* g = k0 < 512 ? P.in[9] + l * 512 : P.in[10] + l * 512 - 512;
            prep_item(P.in[11] + (size_t)l * DM * DM, DM, n0, g, (bf16_t*)(wb + WSM_OUT) + (size_t)n0 * DM, DM, k0, scr, F.lane); continue; }
        r -= I_OUT;
        if (r < I_PG) { const int kb = r / 32, n0 = (r % 32) * 32;
            prep_item(P.in[21] + (size_t)l * DM * DM, DM, n0, P.in[20] + l * DM, (bf16_t*)(wb + WSM_PG) + (size_t)n0 * DM, DM, kb * 64, scr, F.lane); continue; }
        r -= I_PG;
        { const int kb = r / 32, n0 = (r % 32) * 32;
            prep_item(P.in[22] + (size_t)l * DPLE * DM, DM, n0, nullptr, (bf16_t*)(wb + WSM_PE) + (size_t)n0 * DPLE, DPLE, kb * 64, scr, F.lane); }
    }
    bf16_t* WRT = wsp<bf16_t>(F, WS_WR);
    for (int i = F.bx * NTHREADS + F.tid; i < NLAYER * 36 * DM; i += F.G * NTHREADS) {
        const int l = i / (36 * DM), c = (i / DM) % 36, k = i % DM;
        const float w = (c < 32 ? P.in[15][((size_t)l * DM + k) * 32 + c] : P.in[13][((size_t)l * DM + k) * 4 + (c - 32)]) * P.in[12][l * DM + k];
        const unsigned hb = f2bf(w); const float lo = w - bf2f(hb);
        bf16_t* tb = WRT + (size_t)l * (2 * RT_STRIDE / 2);
        tb[c * RT_PITCH + k] = (bf16_t)hb; tb[RT_STRIDE / 2 + c * RT_PITCH + k] = (bf16_t)f2bf(lo);
    }
    float* COS = wsp<float>(F, WS_COS); float* SIN = wsp<float>(F, WS_SIN); const int* pos = (const int*)P.in[2];
    for (int i = F.bx * NTHREADS + F.tid; i < T * 16; i += F.G * NTHREADS) {
        const float ang = (float)pos[i >> 4] * P.inv_freq[i & 15];
        const double a = (double)ang; const double q = __builtin_rint(a * 0.63661977236758134308);
        double r = __builtin_fma(-q, 1.57079632679489655800, a); r = __builtin_fma(-q, 6.12323399573676603587e-17, r);
        const double z = r * r;
        const double sp = r + r * z * (-0.166666666416265235595 + z * (0.0083333293858894631756 + z * (-0.000198393348360966317347 + z * 0.0000027183114939898219064)));
        const double cp = 1.0 + z * (-0.499999997251031003120 + z * (0.0416666233237390631894 + z * (-0.00138867637746099294692 + z * 0.0000243904487962774090654)));
        const int qi = (int)((long long)q & 3);
        const double sv = (qi == 0) ? sp : (qi == 1) ? cp : (qi == 2) ? -sp : -cp;
        const double cv = (qi == 0) ? cp : (qi == 1) ? -sp : (qi == 2) ? -cp : sp;
        COS[i] = (float)cv; SIN[i] = (float)sv;
    }
}
__device__ __forceinline__ void prep_item64(const float* W, int ldw, int srccol0, const float* g, bf16_t* dstrow0, int K, int k0, LAS float* scr, int lane) {
    f32x4 v[16];
    const int kq = lane >> 4, n4 = (lane & 15) * 4;
#pragma unroll
    for (int i = 0; i < 16; ++i) v[i] = __builtin_nontemporal_load((const f32x4*)(W + (size_t)(k0 + 4 * i + kq) * ldw + srccol0 + n4));
#pragma unroll
    for (int i = 0; i < 16; ++i) { const float gg = g ? g[k0 + 4 * i + kq] : 1.f; LAS float* d = scr + (4 * i + kq) * 65 + n4; d[0] = v[i][0] * gg; d[1] = v[i][1] * gg; d[2] = v[i][2] * gg; d[3] = v[i][3] * gg; }
    asm volatile("s_waitcnt lgkmcnt(0)" ::: "memory");
    const int c = lane & 7;
#pragma unroll
    for (int j = 0; j < 8; ++j) { const int n = (lane >> 3) + 8 * j; const LAS float* s = scr + (8 * c) * 65 + n;
        u32x4 o; o.x = pk2(s[0 * 65], s[1 * 65]); o.y = pk2(s[2 * 65], s[3 * 65]); o.z = pk2(s[4 * 65], s[5 * 65]); o.w = pk2(s[6 * 65], s[7 * 65]);
        *(u32x4*)(dstrow0 + (size_t)n * K + k0 + 8 * c) = o; }
    asm volatile("s_waitcnt lgkmcnt(0)" ::: "memory");
}
__device__ __forceinline__ void phase_prep_moe(Frame& F, int l) {
    const Params& P = *F.P;
    LAS float* scr = (LAS float*)(F.lds + F.wave * 16640);
    constexpr int I_G1 = 16 * 8, I_DN = 4 * 16, I_E = I_G1 + I_DN;
    bf16_t* WG1 = wsp<bf16_t>(F, WS_WG1); bf16_t* WD = wsp<bf16_t>(F, WS_WD);
    const int nextra = ((T / 256) * (INP / 256)) % F.G, nlight = F.G - nextra;
    const int slots = (nextra ? nextra : 0) * NWAVES + nlight * NWAVES * (nextra ? 5 : 1);
    const bool light = F.bx >= nextra; const int mult = (light && nextra) ? 5 : 1;
    const int base = light ? nextra * NWAVES + ((F.bx - nextra) * NWAVES + F.wave) * mult : F.bx * NWAVES + F.wave;
    for (int rnd = 0; rnd * slots < NEXP * I_E; ++rnd)
      for (int k = 0; k < mult; ++k) {
        const int it = rnd * slots + base + k; if (it >= NEXP * I_E) break;
        const int e = it / I_E; int r = it % I_E;
        if (r < I_G1) { const int kb = r >> 3, n0 = (r & 7) * 64; const int pn = n0 >> 8, c = n0 & 255;
            const float* W = (c < 128 ? P.in[17] : P.in[18]) + ((size_t)l * NEXP + e) * DM * DEXP; const int src = pn * 128 + (c & 127);
            prep_item64(W, DEXP, src, P.in[12] + l * DM, WG1 + ((size_t)e * 512 + n0) * DM, DM, kb * 64, scr, F.lane); }
        else { r -= I_G1; const int kb = r >> 4, n0 = (r & 15) * 64;
            prep_item64(P.in[19] + ((size_t)l * NEXP + e) * DEXP * DM, DM, n0, nullptr, WD + ((size_t)e * DM + n0) * DEXP, DEXP, kb * 64, scr, F.lane); }
      }
}

__device__ __forceinline__ void phase_norm(Frame& F, const float* hin) {
    bf16_t* HB = wsp<bf16_t>(F, WS_HBI); float* SSQ = wsp<float>(F, WS_SSQ);
    for (int row = F.gw(); row < T; row += F.ngw()) {
        const f32x4* xr = (const f32x4*)(hin + (size_t)row * DM) + F.lane; f32x4 v[4]; float s = 0.f;
#pragma unroll
        for (int j = 0; j < 4; ++j) { v[j] = xr[64 * j]; s += (v[j][0] * v[j][0] + v[j][1] * v[j][1]) + (v[j][2] * v[j][2] + v[j][3] * v[j][3]); }
        s = wave_sum(s);
        u32x2* o = (u32x2*)(HB + (size_t)row * DM) + F.lane;
#pragma unroll
        for (int j = 0; j < 4; ++j) o[64 * j] = (u32x2){pk2(v[j][0], v[j][1]), pk2(v[j][2], v[j][3])};
        if (F.lane < 16) SSQ[(size_t)row * 16 + F.lane] = F.lane == 0 ? s : 0.f;
    }
}
__device__ __forceinline__ void lds_dma16(const void* g, LAS unsigned char* l) {
    unsigned keep; const unsigned dst = (unsigned)__builtin_amdgcn_readfirstlane((int)(unsigned)(uintptr_t)l);
    asm volatile("s_mov_b32 %0, m0\n\ts_mov_b32 m0, %2\n\ts_nop 0\n\tglobal_load_lds_dwordx4 %1, off\n\ts_mov_b32 m0, %0" : "=&s"(keep) : "v"(g), "s"(dst) : "memory"); }
__device__ __forceinline__ void phase_route(Frame& F, int l, bool dummy = false) {
    const Params& P = *F.P; bf16_t* PB = wsp<bf16_t>(F, WS_PB); const float* pl = P.in[1] + (size_t)l * T * DPLE;
    const char* WRT = (const char*)(F.ws + WS_WR) + (size_t)l * 2 * RT_STRIDE;
    const bf16_t* HB = wsp<bf16_t>(F, WS_HB); float* RS = wsp<float>(F, WS_RS);
    unsigned* cnt = wsp<unsigned>(F, WS_CTL) + CW_CNT + 64 * 32 * (dummy ? NLAYER + l : l); int* liste = dummy ? wsp<int>(F, WS_Y) : wsp<int>(F, WS_LISTE); float* listw = dummy ? wsp<float>(F, WS_Y + 4 * MiB) : wsp<float>(F, WS_LISTW);
    const float* brg = P.in[14] + l * 4; const float* bre = P.in[16] + l * 32;
    constexpr int SC_OFF = RT_STRIDE, SC_WAVE = 16 * 49 * 4, RK_OFF = SC_OFF + NWAVES * SC_WAVE;
    LAS unsigned* lcnt = (LAS unsigned*)(F.lds + RK_OFF); LAS unsigned* lbase = lcnt + 32; LAS unsigned* ent = lcnt + 64;
    LAS float* sc = (LAS float*)(F.lds + SC_OFF + F.wave * SC_WAVE);
    const int step = F.ngw(), ri = F.lane & 15, kq = F.lane >> 4;
    for (int pc = F.wave; pc < 73; pc += NWAVES) lds_dma16(WRT + (size_t)pc * 1024 + F.lane * 16, F.lds + pc * 1024);
    if (F.tid < 32) lcnt[F.tid] = 0u;
    int nent = 0;
    for (int row0 = F.gw(); row0 < T; row0 += 16 * step) {
        const int myrow = row0 + ri * step; const bool rv = myrow < T;
        const bf16_t* xr = HB + (size_t)(rv ? myrow : row0) * DM + 8 * kq;
        bf16x8 af[32]; float ssq = 0.f;
#pragma unroll
        for (int sI = 0; sI < 32; ++sI) af[sI] = *(const bf16x8*)(xr + 32 * sI);
        if (rv) {
#pragma unroll
            for (int q = 0; q < 4; ++q) { const float* pp = pl + (size_t)myrow * DPLE + 64 * kq + 16 * q; const f32x4 a = ((const f32x4*)pp)[0], b2 = ((const f32x4*)pp)[1], c2 = ((const f32x4*)pp)[2], d2 = ((const f32x4*)pp)[3];
                u32x4* dst = (u32x4*)(PB + (size_t)myrow * DPLE + 64 * kq + 16 * q); dst[0] = pack8(a, b2); dst[1] = pack8(c2, d2); } }
#pragma unroll
        for (int sI = 0; sI < 32; ++sI) { float f[8]; unpack8(__builtin_bit_cast(u32x4, af[sI]), f);
#pragma unroll
            for (int i = 0; i < 8; ++i) ssq += f[i] * f[i]; }
        ssq += xor16(ssq); ssq += xor32(ssq);
        f32x4 acc[3] = {{0.f, 0.f, 0.f, 0.f}, {0.f, 0.f, 0.f, 0.f}, {0.f, 0.f, 0.f, 0.f}};
#pragma unroll 1
        for (int pass = 0; pass < 2; ++pass) {
            asm volatile("s_waitcnt vmcnt(0)" ::: "memory"); __syncthreads();
            const LAS unsigned char* tb = F.lds + (size_t)ri * (RT_PITCH * 2) + kq * 16;
#pragma unroll
            for (int sI = 0; sI < 32; ++sI) {
#pragma unroll
                for (int blk = 0; blk < 3; ++blk) { const int cb = blk < 2 ? blk * 16 : 20;
                    const bf16x8 bfr = *(const LAS bf16x8*)(tb + (size_t)cb * (RT_PITCH * 2) + sI * 64);
                    acc[blk] = __builtin_amdgcn_mfma_f32_16x16x32_bf16(af[sI], bfr, acc[blk], 0, 0, 0); }
            }
            __syncthreads();
            if (pass == 0) { for (int pc = F.wave; pc < 73; pc += NWAVES) lds_dma16(WRT + RT_STRIDE + (size_t)pc * 1024 + F.lane * 16, F.lds + pc * 1024); }
            else if (row0 + 16 * step < T) { for (int pc = F.wave; pc < 73; pc += NWAVES) lds_dma16(WRT + (size_t)pc * 1024 + F.lane * 16, F.lds + pc * 1024); }
        }
#pragma unroll
        for (int blk = 0; blk < 3; ++blk)
#pragma unroll
            for (int i = 0; i < 4; ++i) sc[(4 * kq + i) * 49 + 16 * blk + ri] = acc[blk][i];
        asm volatile("s_waitcnt lgkmcnt(0)" ::: "memory");
        if (F.lane < 16 && rv) {
            const LAS float* lr = sc + F.lane * 49;
            const float rs = 1.0f / sqrtf(ssq * (1.f / DM) + EPS);
            const float g0 = lr[44] * rs + brg[0], g1 = lr[45] * rs + brg[1], g2 = lr[46] * rs + brg[2], g3 = lr[47] * rs + brg[3];
            int g = 0; float gm = g0; if (g1 > gm) { gm = g1; g = 1; } if (g2 > gm) { gm = g2; g = 2; } if (g3 > gm) { gm = g3; g = 3; }
            const float gp = 1.0f / (fexp2((g0 - gm) * LOG2E) + fexp2((g1 - gm) * LOG2E) + fexp2((g2 - gm) * LOG2E) + fexp2((g3 - gm) * LOG2E));
            float le[8];
#pragma unroll
            for (int q = 0; q < 8; ++q) le[q] = lr[8 * g + q] * rs + bre[8 * g + q];
            int i1 = 0; float l1 = le[0];
#pragma unroll
            for (int j = 1; j < 8; ++j) if (le[j] > l1) { l1 = le[j]; i1 = j; }
            int i2 = (i1 == 0) ? 1 : 0; float l2 = (i1 == 0) ? le[1] : le[0];
#pragma unroll
            for (int j = 1; j < 8; ++j) if (j != i1 && le[j] > l2) { l2 = le[j]; i2 = j; }
            const float e2 = fexp2((l2 - l1) * LOG2E); const float w1 = gp / (1.f + e2), w2 = gp * e2 / (1.f + e2);
            const int ea = g * 8 + i1, eb = g * 8 + i2;
            RS[myrow] = rs;
            if (nent == 0) {
                const unsigned pa = atomicAdd((unsigned*)(lcnt + ea), 1u), pb = atomicAdd((unsigned*)(lcnt + eb), 1u);
                LAS unsigned* en = ent + (size_t)(F.wave * 32 + F.lane * 2) * 4;
                en[0] = (unsigned)ea; en[1] = pa; en[2] = (unsigned)(myrow * 2); en[3] = __float_as_uint(w1);
                en[4] = (unsigned)eb; en[5] = pb; en[6] = (unsigned)(myrow * 2 + 1); en[7] = __float_as_uint(w2);
            } else {
                const unsigned pa = atomicAdd(cnt + 64 * ea, 1u); liste[(size_t)ea * T + pa] = myrow * 2; listw[(size_t)ea * T + pa] = w1;
                const unsigned pb = atomicAdd(cnt + 64 * eb, 1u); liste[(size_t)eb * T + pb] = myrow * 2 + 1; listw[(size_t)eb * T + pb] = w2;
            }
        }
        if (nent == 0) { int nv = 0; for (int r = 0; r < 16; ++r) nv += (row0 + r * step < T) ? 1 : 0; nent = nv > 0 ? nv : 1; }
    }
    asm volatile("s_waitcnt vmcnt(0) lgkmcnt(0)" ::: "memory");
    __syncthreads();
    if (F.tid < 32) lbase[F.tid] = lcnt[F.tid] ? atomicAdd(cnt + 64 * F.tid, lcnt[F.tid]) : 0u;
    __syncthreads();
    { const int r = F.lane >> 1; const bool v = F.lane < 32 && (F.gw() + r * step < T);
      if (v) { const LAS unsigned* en = ent + (size_t)(F.wave * 32 + F.lane) * 4;
          const size_t li = (size_t)en[0] * T + lbase[en[0]] + en[1];
          liste[li] = (int)en[2]; listw[li] = __uint_as_float(en[3]); } }
}
__device__ __forceinline__ void phase_norm2(Frame& F, int l, float ysc) {
    bf16_t* HB = wsp<bf16_t>(F, WS_HB); float* RS = wsp<float>(F, WS_RS); const bf16_t* Y = wsp<bf16_t>(F, WS_Y);
    for (int row = F.gw(); row < T; row += F.ngw()) {
        u32x2* xr = (u32x2*)(HB + (size_t)row * DM) + F.lane; float s = 0.f;
        const u32x2* y0 = (const u32x2*)(Y + (size_t)row * 2 * DM) + F.lane; const u32x2* y1 = y0 + DM / 4;
        u32x2 hw[4], ya[4], yb[4];
#pragma unroll
        for (int j = 0; j < 4; ++j) { hw[j] = xr[64 * j]; ya[j] = y0[64 * j]; yb[j] = y1[64 * j]; }
#pragma unroll
        for (int j = 0; j < 4; ++j) { const u32x2 a = ya[j], b = yb[j];
            float v0 = bf2f(hw[j].x & 0xffffu) + ysc * (bf2f(a.x & 0xffffu) + bf2f(b.x & 0xffffu)), v1 = bf2f(hw[j].x >> 16) + ysc * (bf2f(a.x >> 16) + bf2f(b.x >> 16));
            float v2 = bf2f(hw[j].y & 0xffffu) + ysc * (bf2f(a.y & 0xffffu) + bf2f(b.y & 0xffffu)), v3 = bf2f(hw[j].y >> 16) + ysc * (bf2f(a.y >> 16) + bf2f(b.y >> 16));
            const u32x2 o = (u32x2){pk2(v0, v1), pk2(v2, v3)}; xr[64 * j] = o;
            v0 = bf2f(o.x & 0xffffu); v1 = bf2f(o.x >> 16); v2 = bf2f(o.y & 0xffffu); v3 = bf2f(o.y >> 16);
            s += (v0 * v0 + v1 * v1) + (v2 * v2 + v3 * v3); }
        s = wave_sum(s);
        if (F.lane == 0) RS[row] = 1.0f / sqrtf(s * (1.f / DM) + EPS);
    }
}
__device__ __forceinline__ void phase_final(Frame& F) {
    const Params& P = *F.P; const bf16_t* H = wsp<bf16_t>(F, WS_HBI); const float* g = P.in[23];
    for (int row = F.gw(); row < T; row += F.ngw()) {
        const u32x2* xr = (const u32x2*)(H + (size_t)row * DM) + F.lane; f32x4 v[4]; float s = 0.f;
#pragma unroll
        for (int j = 0; j < 4; ++j) { const u32x2 w = xr[64 * j]; v[j] = (f32x4){bf2f(w.x & 0xffffu), bf2f(w.x >> 16), bf2f(w.y & 0xffffu), bf2f(w.y >> 16)}; s += (v[j][0] * v[j][0] + v[j][1] * v[j][1]) + (v[j][2] * v[j][2] + v[j][3] * v[j][3]); }
        s = wave_sum(s); const float rs = 1.0f / sqrtf(s * (1.f / DM) + EPS);
        f32x4* o = (f32x4*)(P.out + (size_t)row * DM) + F.lane;
#pragma unroll
        for (int j = 0; j < 4; ++j) __builtin_nontemporal_store(v[j] * rs * ((const f32x4*)g)[F.lane + 64 * j], o + 64 * j);
    }
}

namespace att {
typedef float f32x16 __attribute__((ext_vector_type(16)));
typedef short s16x4 __attribute__((ext_vector_type(4)));
typedef short v4i16_t __attribute__((ext_vector_type(4)));
typedef __bf16 bf16x2_t __attribute__((ext_vector_type(2)));
constexpr int NS = 6, PF = 5;
constexpr int FLAG_OFF = 131072 + 512;
__device__ __forceinline__ int crow(int r, int hi) { return (r & 3) + 8 * (r >> 2) + 4 * hi; }
__device__ __forceinline__ unsigned cvtpk(float lo, float hi) { f32x2 v = {lo, hi}; bf16x2_t b = __builtin_convertvector(v, bf16x2_t); return __builtin_bit_cast(unsigned, b); }
__device__ __forceinline__ s16x4 vtr(const LAS unsigned char* p) { return __builtin_bit_cast(s16x4, __builtin_amdgcn_ds_read_tr16_b64_v4i16((LAS v4i16_t*)p)); }
__device__ __forceinline__ void dma16(const void* g, LAS unsigned char* l) {
    unsigned keep; const unsigned dst = (unsigned)__builtin_amdgcn_readfirstlane((int)(unsigned)(uintptr_t)l);
    asm volatile("s_mov_b32 %0, m0\n\ts_mov_b32 m0, %2\n\ts_nop 0\n\tglobal_load_lds_dwordx4 %1, off\n\ts_mov_b32 m0, %0" : "=&s"(keep) : "v"(g), "s"(dst) : "memory"); }
__device__ __forceinline__ float vmul(float a, float b) { float r; asm("v_mul_f32 %0, %1, %2" : "=v"(r) : "v"(a), "v"(b)); return r; }
__device__ __forceinline__ float vsub(float a, float b) { float r; asm("v_sub_f32 %0, %1, %2" : "=v"(r) : "v"(a), "v"(b)); return r; }
__device__ __forceinline__ float vadd(float a, float b) { float r; asm("v_add_f32 %0, %1, %2" : "=v"(r) : "v"(a), "v"(b)); return r; }
__device__ __forceinline__ float swap32(float x) { auto rr = __builtin_amdgcn_permlane32_swap(__float_as_uint(x), __float_as_uint(x), false, false); return __uint_as_float(((unsigned)(threadIdx.x & 32)) ? rr[0] : rr[1]); }
__device__ __forceinline__ float swap_sel(float a, float b) { auto rr = __builtin_amdgcn_permlane32_swap(__float_as_uint(a), __float_as_uint(b), false, false); return __uint_as_float(((unsigned)(threadIdx.x & 32)) ? rr[0] : rr[1]); }
#define ATT_WAIT_BAR(N) asm volatile("s_waitcnt vmcnt(%0) lgkmcnt(0)\n\ts_barrier" :: "n"(N) : "memory")
__device__ __forceinline__ bf16x8 pfrag(const f32x16& w, int b8) { u32x4 u; u.x = cvtpk(w[b8], w[b8 + 1]); u.y = cvtpk(w[b8 + 2], w[b8 + 3]); u.z = cvtpk(w[b8 + 4], w[b8 + 5]); u.w = cvtpk(w[b8 + 6], w[b8 + 7]); return __builtin_bit_cast(bf16x8, u); }
#define VTR_(dst, OFF) asm volatile("ds_read_b64_tr_b16 %0, %1 offset:" #OFF : "=v"(dst) : "v"(a_))
#define VLD_(i, O0, O1) do { u32x2 lo_, hi_; VTR_(lo_, O0); VTR_(hi_, O1); vf[i] = __builtin_bit_cast(bf16x8, (u32x4){lo_.x, lo_.y, hi_.x, hi_.y}); } while (0)
__device__ __forceinline__ void v_load(bf16x8 (&vf)[8], const LAS unsigned char* vp) {
    const unsigned a_ = (unsigned)(uintptr_t)vp;
    VLD_(0, 0, 512);    VLD_(1, 4096, 4608);
    VLD_(2, 1024, 1536); VLD_(3, 5120, 5632);
    VLD_(4, 2048, 2560); VLD_(5, 6144, 6656);
    VLD_(6, 3072, 3584); VLD_(7, 7168, 7680);
}
#undef VLD_
#undef VTR_
#define V_WAIT(vf) asm volatile("s_waitcnt lgkmcnt(0)" : "+v"(vf[0]), "+v"(vf[1]), "+v"(vf[2]), "+v"(vf[3]), "+v"(vf[4]), "+v"(vf[5]), "+v"(vf[6]), "+v"(vf[7]))
__device__ __forceinline__ void pv_tile(f32x16& o0, f32x16& o1, const bf16x8 (&vf)[8], const f32x16& w0, const f32x16& w1) {
#pragma unroll
    for (int ks = 0; ks < 4; ++ks) {
        const bf16x8 pf = pfrag(ks < 2 ? w0 : w1, 8 * (ks & 1));
        o0 = __builtin_amdgcn_mfma_f32_32x32x16_bf16(vf[2 * ks], pf, o0, 0, 0, 0);
        o1 = __builtin_amdgcn_mfma_f32_32x32x16_bf16(vf[2 * ks + 1], pf, o1, 0, 0, 0);
    }
}
__device__ __forceinline__ void store_o(bf16_t* orow, const f32x16& o0, const f32x16& o1, int hi, float sc, float* oss) {
    float sq = 0.f;
#pragma unroll
    for (int r = 0; r < 16; ++r) sq += o0[r] * o0[r] + o1[r] * o1[r];
    sq = (sq + xor32(sq)) * (sc * sc);
    if (hi == 0) *(GAS float*)oss = sq;
#pragma unroll
    for (int half = 0; half < 2; ++half) {
        const f32x16& o = half ? o1 : o0;
#pragma unroll
        for (int k = 0; k < 4; k += 2) {
            unsigned ax = cvtpk(o[4 * k] * sc, o[4 * k + 1] * sc), ay = cvtpk(o[4 * k + 2] * sc, o[4 * k + 3] * sc);
            unsigned bx = cvtpk(o[4 * k + 4] * sc, o[4 * k + 5] * sc), by = cvtpk(o[4 * k + 6] * sc, o[4 * k + 7] * sc);
            { auto r = __builtin_amdgcn_permlane32_swap(ax, bx, false, false); ax = r[0]; bx = r[1]; }
            { auto r = __builtin_amdgcn_permlane32_swap(ay, by, false, false); ay = r[0]; by = r[1]; }
            *(GAS u32x4*)(orow + 32 * half + 8 * k + 8 * hi) = (u32x4){ax, ay, bx, by};
        }
    }
}

template <bool DIAG> __device__ __forceinline__ void sb_tile(const LAS unsigned char* ks, int vpo, const bf16x8 (&qr)[4], f32x16& o0, f32x16& o1, float& carry, int kb, int q, int r32, int hi) {
    f32x16 z0 = {}, z1 = {};
    bf16x8 kf[8], vf[8];
#pragma unroll
    for (int d0 = 0; d0 < 4; ++d0) { kf[2 * d0] = *(const LAS bf16x8*)(ks + (2 * d0 + hi) * 1024 + r32 * 16); kf[2 * d0 + 1] = *(const LAS bf16x8*)(ks + (2 * d0 + hi) * 1024 + 512 + r32 * 16); }
    __builtin_amdgcn_sched_barrier(0);
#pragma unroll
    for (int d0 = 0; d0 < 4; ++d0) { z0 = __builtin_amdgcn_mfma_f32_32x32x16_bf16(kf[2 * d0], qr[d0], z0, 0, 0, 0); z1 = __builtin_amdgcn_mfma_f32_32x32x16_bf16(kf[2 * d0 + 1], qr[d0], z1, 0, 0, 0); }
    v_load(vf, ks + 8192 + vpo);
    __builtin_amdgcn_sched_barrier(0);
    f32x16 s0, s1;
#pragma unroll
    for (int r = 0; r < 16; ++r) { s0[r] = frcp(1.f + fexp2(z0[r])); s1[r] = frcp(1.f + fexp2(z1[r])); }
    if (DIAG) {
        const int dq = q - kb - 4 * hi;
#pragma unroll
        for (int r = 0; r < 16; ++r) { if (crow(r, 0) >= dq) s0[r] = 1.f; if (32 + crow(r, 0) >= dq) s1[r] = 1.f; }
    }
#pragma unroll
    for (int g = 0; g < 4; ++g) {
        s0[4 * g + 2] = vmul(s0[4 * g + 2], s0[4 * g + 3]); s0[4 * g + 1] = vmul(s0[4 * g + 1], s0[4 * g + 2]); s0[4 * g] = vmul(s0[4 * g], s0[4 * g + 1]);
        s1[4 * g + 2] = vmul(s1[4 * g + 2], s1[4 * g + 3]); s1[4 * g + 1] = vmul(s1[4 * g + 1], s1[4 * g + 2]); s1[4 * g] = vmul(s1[4 * g], s1[4 * g + 1]);
    }
    float I[9]; I[8] = 1.f; I[7] = s1[12];
#pragma unroll
    for (int g = 6; g >= 0; --g) I[g] = vmul(I[g + 1], g < 4 ? s0[4 * g] : s1[4 * (g - 4)]);
    float off[8];
#pragma unroll
    for (int g = 0; g < 8; ++g) {
        const float x = swap_sel(I[g], I[g + 1]);
        off[g] = (g == 7) ? vmul(carry, x) : vmul(vmul(carry, I[g + 1]), x);
    }
    carry = vmul(carry, vmul(I[0], swap32(I[0])));
    f32x16 w0, w1;
#pragma unroll
    for (int g = 0; g < 4; ++g) {
        { const float o = off[g]; const float S3 = vmul(s0[4 * g + 3], o), S2 = vmul(s0[4 * g + 2], o), S1 = vmul(s0[4 * g + 1], o), S0 = vmul(s0[4 * g], o);
          w0[4 * g + 3] = vsub(o, S3); w0[4 * g + 2] = vsub(S3, S2); w0[4 * g + 1] = vsub(S2, S1); w0[4 * g] = vsub(S1, S0); }
        { const float o = off[4 + g]; const float S3 = vmul(s1[4 * g + 3], o), S2 = vmul(s1[4 * g + 2], o), S1 = vmul(s1[4 * g + 1], o), S0 = vmul(s1[4 * g], o);
          w1[4 * g + 3] = vsub(o, S3); w1[4 * g + 2] = vsub(S3, S2); w1[4 * g + 1] = vsub(S2, S1); w1[4 * g] = vsub(S1, S0); }
    }
    V_WAIT(vf);
    pv_tile(o0, o1, vf, w0, w1);
}
__device__ __forceinline__ void sb_unit(LAS unsigned char* lds, int tid, const bf16_t* QKV, bf16_t* OA, float* OSS, int b, int h, int qb) {
    asm volatile("" : "+v"(tid));
    const int lane = tid & 63, r32 = lane & 31, hi = lane >> 5, wid = __builtin_amdgcn_readfirstlane(tid >> 6);
    const size_t rowb = (size_t)b * SEQ; const int q0 = qb * 256;
    const bf16_t* Qw = QKV + (rowb + q0 + wid * 32) * 1536 + h * 64;
    const bf16_t* Kh = QKV + rowb * 1536 + 512 + h * 64; const bf16_t* Vh = Kh + 512;
    const int kt_hi = (q0 >> 6) + 3, NT = kt_hi + 1, jd = 3 - (wid >> 1);
    const bf16_t* ksrc = Kh + (size_t)lane * 1536 + wid * 8;
    const bf16_t* vsrc = Vh + (size_t)(16 * (wid & 3) + (lane >> 2)) * 1536 + (wid >> 2) * 32 + (lane & 3) * 8;
#define SB_ISSUE(j) do { int kt_ = kt_hi - (j); kt_ = kt_ < 0 ? 0 : kt_; LAS unsigned char* sl_ = lds + ((j) % NS) * 16384 + wid * 1024; \
        dma16(ksrc + (size_t)kt_ * 64 * 1536, sl_); dma16(vsrc + (size_t)kt_ * 64 * 1536, sl_ + 8192); } while (0)
    bf16x8 qr[4];
#pragma unroll
    for (int d0 = 0; d0 < 4; ++d0) qr[d0] = *(const GAS bf16x8*)(Qw + (size_t)r32 * 1536 + d0 * 16 + hi * 8);
#pragma unroll
    for (int j = 0; j < PF; ++j) SB_ISSUE(j);
    asm volatile("" : "+v"(qr[0]), "+v"(qr[1]), "+v"(qr[2]), "+v"(qr[3]));
    f32x16 o0 = {}, o1 = {}; float carry = 1.f; bool mydone = false;
    const int q = q0 + wid * 32 + r32;
    volatile LAS unsigned* flags = (volatile LAS unsigned*)(lds + FLAG_OFF);
    const int vpo = ((lane >> 4) & 1) * 32 + (lane & 3) * 8 + (4 * hi + ((lane & 15) >> 2)) * 64;
    for (int j = 0; j < NT; ++j) {
        ATT_WAIT_BAR(2);
        if (j >= 1) { const u32x4 fa = *(const LAS u32x4*)(lds + FLAG_OFF + ((j - 1) & 1) * 32), fb = *(const LAS u32x4*)(lds + FLAG_OFF + ((j - 1) & 1) * 32 + 16);
            if ((fa.x & fa.y & fa.z & fa.w & fb.x & fb.y & fb.z & fb.w) != 0u) break; }
        SB_ISSUE(j + PF);
        const int tj = j + jd;
        if (tj < NT && !mydone) {
            const LAS unsigned char* ks = lds + (tj % NS) * 16384; const int kb = (kt_hi - tj) * 64;
            if (j == 0) sb_tile<true>(ks, vpo, qr, o0, o1, carry, kb, q, r32, hi); else sb_tile<false>(ks, vpo, qr, o0, o1, carry, kb, q, r32, hi);
        }
        mydone = __all(carry < 1.17549435e-38f) || (tj + 1 >= NT);
        if (lane == 0) flags[(j & 1) * 8 + wid] = mydone ? 1u : 0u;
    }
    store_o(OA + (rowb + q) * DM + h * 64, o0, o1, hi, 1.f, OSS + (rowb + q) * 16 + h);
    asm volatile("s_waitcnt lgkmcnt(0)\n\ts_barrier" ::: "memory");
#undef SB_ISSUE
}

__device__ __forceinline__ void mla_kload(bf16x8 (&kf)[12], const LAS unsigned char* ks, int r32, int hi, int g) {
#pragma unroll
    for (int i = 0; i < 2; ++i) { const int d0 = 2 * g + i; kf[2 * d0] = *(const LAS bf16x8*)(ks + (2 * d0 + hi) * 1024 + r32 * 16); kf[2 * d0 + 1] = *(const LAS bf16x8*)(ks + (2 * d0 + hi) * 1024 + 512 + r32 * 16); }
}
struct AU { int b, h, qb; };
constexpr int MLA_SLOT = 20480;
__device__ __forceinline__ void mla_issue(LAS unsigned char* lds, int wid, const bf16_t* ksrc, const bf16_t* rsrc, const bf16_t* vsrc, int kt) {
    LAS unsigned char* sl_ = lds + (kt % NS) * MLA_SLOT;
    dma16(ksrc + (size_t)kt * 64 * 512, sl_ + wid * 1024); if (wid < 4) dma16(rsrc + (size_t)kt * 64 * 32, sl_ + (8 + wid) * 1024);
    dma16(vsrc + (size_t)kt * 64 * 512, sl_ + 12288 + wid * 1024);
}
#define MLA_ADDR(u) const int lane = tid & 63, r32 = lane & 31, hi = lane >> 5, wid = __builtin_amdgcn_readfirstlane(tid >> 6); \
    const size_t rowb = (size_t)(u).b * SEQ; const int q0 = (u).qb * 256, h = (u).h; \
    const int NT = (q0 >> 6) + 4; \
    const bf16_t* ksrc = KN + (rowb + lane) * 512 + h * 64 + wid * 8; \
    const bf16_t* rsrc = KR + (rowb + lane) * 32 + (wid & 3) * 8; \
    const bf16_t* vsrc = VM + (rowb + 16 * (wid & 3) + (lane >> 2)) * 512 + h * 64 + (wid >> 2) * 32 + (lane & 3) * 8;
__device__ __forceinline__ void mla_prologue(LAS unsigned char* lds, int tid, const bf16_t* QM, const bf16_t* KN, const bf16_t* KR, const bf16_t* VM, AU u, bf16x8 (&qr)[6]) {
    asm volatile("" : "+v"(tid));
    MLA_ADDR(u)
    const bf16_t* Qw = QM + (rowb + q0 + wid * 32) * 768 + h * 96;
#pragma unroll
    for (int d0 = 0; d0 < 6; ++d0) qr[d0] = *(const GAS bf16x8*)(Qw + (size_t)r32 * 768 + d0 * 16 + hi * 8);
#pragma unroll
    for (int j = 0; j < 5; ++j) if (j < NT) mla_issue(lds, wid, ksrc, rsrc, vsrc, j);
}
__device__ __forceinline__ void mla_unit(LAS unsigned char* lds, int tid, const bf16_t* QM, const bf16_t* KN, const bf16_t* KR, const bf16_t* VM, bf16_t* OA, float* OSS, AU u, bool has_next, AU nx, bf16x8 (&qr)[6]) {
    asm volatile("" : "+v"(tid));
    MLA_ADDR(u)
    const int mych = (q0 >> 6) + (wid >> 1);
    constexpr int SLOT = MLA_SLOT;
#define MLA_ISSUE(j) mla_issue(lds, wid, ksrc, rsrc, vsrc, (j))
#define MLA_WAITN(n) do { if (wid < 4) ATT_WAIT_BAR(3 * (n)); else ATT_WAIT_BAR(2 * (n)); } while (0)
#define MLA_WAIT_DYN(nf) do { const int nf_ = (nf); if (nf_ >= 3) MLA_WAITN(3); else if (nf_ == 2) MLA_WAITN(2); else if (nf_ == 1) MLA_WAITN(1); else MLA_WAITN(0); } while (0)
    asm volatile("s_waitcnt vmcnt(0)" : "+v"(qr[0]), "+v"(qr[1]), "+v"(qr[2]), "+v"(qr[3]), "+v"(qr[4]), "+v"(qr[5]));
    f32x16 o0 = {}, o1 = {}, negm = {}; float mref = 0.f, lsum = 0.f;
    const int vpo = ((lane >> 4) & 1) * 32 + (lane & 3) * 8 + (4 * hi + ((lane & 15) >> 2)) * 64;
    MLA_WAIT_DYN((NT < 5 ? NT - 1 : 4) - 1);
    if (5 < NT) MLA_ISSUE(5);
    bf16x8 kf[12];
    mla_kload(kf, lds, r32, hi, 0); mla_kload(kf, lds, r32, hi, 1); mla_kload(kf, lds, r32, hi, 2);
    for (int j = 0; j < NT; ++j) {
        const LAS unsigned char* sl = lds + (j % NS) * SLOT; const LAS unsigned char* sn = lds + ((j + 1) % NS) * SLOT;
        if (j <= mych) {
            f32x16 z0, z1;
            z0 = __builtin_amdgcn_mfma_f32_32x32x16_bf16(kf[0], qr[0], negm, 0, 0, 0); z1 = __builtin_amdgcn_mfma_f32_32x32x16_bf16(kf[1], qr[0], negm, 0, 0, 0);
#pragma unroll
            for (int d0 = 1; d0 < 6; ++d0) { z0 = __builtin_amdgcn_mfma_f32_32x32x16_bf16(kf[2 * d0], qr[d0], z0, 0, 0, 0); z1 = __builtin_amdgcn_mfma_f32_32x32x16_bf16(kf[2 * d0 + 1], qr[d0], z1, 0, 0, 0); }
            bf16x8 vf[8];
            v_load(vf, sl + 12288 + vpo);
            __builtin_amdgcn_sched_barrier(0);
#define MLA_MOVE_REF(FIRST) do { float tm = fmaxf(z0[0], z1[0]); _Pragma("unroll") for (int r = 1; r < 16; ++r) tm = fmaxf(tm, fmaxf(z0[r], z1[r])); tm = fmaxf(tm, swap32(tm)); \
                const float dl = (FIRST) ? tm : fmaxf(tm, 0.f); mref += dl; const float al = fexp2(-dl); lsum *= al; \
                _Pragma("unroll") for (int r = 0; r < 16; ++r) { z0[r] -= dl; z1[r] -= dl; negm[r] = -mref; o0[r] *= al; o1[r] *= al; } } while (0)
            if (j == 0) MLA_MOVE_REF(true);
            float ps, pb;
            z0[0] = fexp2(z0[0]); z1[0] = fexp2(z1[0]); ps = z0[0]; pb = z1[0];
#pragma unroll
            for (int r = 1; r < 16; ++r) { z0[r] = fexp2(z0[r]); z1[r] = fexp2(z1[r]); ps = vadd(ps, z0[r]); pb = vadd(pb, z1[r]); }
            ps = vadd(ps, pb);
            if (__builtin_expect(__any(!(ps < 1.8446744e19f)), 0)) {
                z0 = __builtin_amdgcn_mfma_f32_32x32x16_bf16(kf[0], qr[0], negm, 0, 0, 0); z1 = __builtin_amdgcn_mfma_f32_32x32x16_bf16(kf[1], qr[0], negm, 0, 0, 0);
#pragma unroll
                for (int d0 = 1; d0 < 6; ++d0) { z0 = __builtin_amdgcn_mfma_f32_32x32x16_bf16(kf[2 * d0], qr[d0], z0, 0, 0, 0); z1 = __builtin_amdgcn_mfma_f32_32x32x16_bf16(kf[2 * d0 + 1], qr[d0], z1, 0, 0, 0); }
                MLA_MOVE_REF(false);
                ps = 0.f;
#pragma unroll
                for (int r = 0; r < 16; ++r) { z0[r] = fexp2(z0[r]); z1[r] = fexp2(z1[r]); ps += z0[r] + z1[r]; }
            }
#undef MLA_MOVE_REF
            lsum += ps;
            __builtin_amdgcn_sched_barrier(0);
            V_WAIT(vf);
#pragma unroll
            for (int ks2 = 0; ks2 < 4; ++ks2) {
                const bf16x8 pf = pfrag(ks2 < 2 ? z0 : z1, 8 * (ks2 & 1));
                o0 = __builtin_amdgcn_mfma_f32_32x32x16_bf16(vf[2 * ks2], pf, o0, 0, 0, 0);
                o1 = __builtin_amdgcn_mfma_f32_32x32x16_bf16(vf[2 * ks2 + 1], pf, o1, 0, 0, 0);
                if (ks2 < 3) mla_kload(kf, sn, r32, hi, ks2);
                __builtin_amdgcn_sched_barrier(0);
            }
        } else if (j + 1 <= mych) {   }
        { const int im = (j + 5 < NT - 1) ? j + 5 : NT - 1; MLA_WAIT_DYN(im - (j + 2)); }
        if (j + 6 < NT) MLA_ISSUE(j + 6);
    }
    lsum += swap32(lsum);
    bf16_t* orow = OA + (rowb + q0 + wid * 32 + r32) * DM + 512 + h * 64; float* oss = OSS + (rowb + q0 + wid * 32 + r32) * 16 + 8 + h; const int hi2 = hi;
    store_o(orow, o0, o1, hi2, 1.0f / lsum, oss);
    asm volatile("s_waitcnt lgkmcnt(0)\n\ts_barrier" ::: "memory");
    if (has_next) mla_prologue(lds, tid, QM, KN, KR, VM, nx, qr);
#undef MLA_ISSUE
#undef MLA_WAITN
#undef MLA_WAIT_DYN
}
}

__device__ __forceinline__ void phase_attn(Frame& F) {
    const bf16_t* QKV = wsp<bf16_t>(F, WS_QKV); bf16_t* OA = wsp<bf16_t>(F, WS_OA); float* OSS = wsp<float>(F, WS_OSS);
    const bf16_t* QM = wsp<bf16_t>(F, WS_QM); const bf16_t* KN = wsp<bf16_t>(F, WS_KN); const bf16_t* KR = wsp<bf16_t>(F, WS_KR); const bf16_t* VM = wsp<bf16_t>(F, WS_VM);
    const int vcu = (F.G % 8 == 0) ? (F.bx % 8) * (F.G / 8) + F.bx / 8 : F.bx;
    { const int nu = vcu < 512 ? 2 * ((512 - vcu + F.G - 1) / F.G) : 0;
      auto unit = [&](int i) { const int p = vcu + (i >> 1) * F.G, bh = p >> 3, s = p & 7; return att::AU{bh >> 3, bh & 7, (i & 1) ? s : 15 - s}; };
      if (nu > 0) {
          bf16x8 qr[6];
          att::mla_prologue(F.lds, F.tid, QM, KN, KR, VM, unit(0), qr);
#pragma unroll 1
          for (int i = 0; i < nu; ++i) att::mla_unit(F.lds, F.tid, QM, KN, KR, VM, OA, OSS, unit(i), i + 1 < nu, unit(i + 1 < nu ? i + 1 : i), qr);
      } }
    { int k = 0; for (int u = vcu; u < 1024; u += F.G, ++k) { const int bh = u >> 4; att::sb_unit(F.lds, F.tid, QKV, OA, OSS, bh >> 3, bh & 7, (u + 4 * k) & 15); } }
}

__device__ __forceinline__ DenseSched dense_sched(const Frame& F, int N, const void* Bt, int K) { DenseSched S; S.o.init(T, N, F.G, F.bx); S.Bt = (const char*)Bt; S.K = K; return S; }
__device__ __forceinline__ void phase_inproj(Frame& F, int l) {
    const DenseSched S = dense_sched(F, INP, F.ws + WS_WSM + (size_t)l * WSM_STRIDE + WSM_IN, DM);
    const EpiIn E{wsp<float>(F, WS_SSQ), wsp<bf16_t>(F, WS_QKV), wsp<bf16_t>(F, WS_CKV), wsp<bf16_t>(F, WS_CQ), wsp<bf16_t>(F, WS_KR), wsp<float>(F, WS_COS), wsp<float>(F, WS_SIN), wsp<float>(F, WS_RSCQ), wsp<float>(F, WS_RSCKV)};
    pg8::gemm_phase(F.lds, F.tid, (const char*)(F.ws + WS_HBI), DM, S, E);
}
__device__ __forceinline__ void phase_uq(Frame& F, int l, int Gp, int cp) {
    DenseSched S; S.o.init(T, 768, Gp, cp); S.Bt = (const char*)(F.ws + WS_WSM + (size_t)l * WSM_STRIDE + WSM_UQ); S.K = QRANK;
    const EpiUq E{wsp<float>(F, WS_RSCQ), wsp<bf16_t>(F, WS_QM), wsp<float>(F, WS_COS), wsp<float>(F, WS_SIN)};
    pg8::gemm_phase(F.lds, F.tid, (const char*)(F.ws + WS_CQ), QRANK, S, E);
}
__device__ __forceinline__ void phase_ukv(Frame& F, int l, int Gp, int cp) {
    DenseSched S; S.o.init(T, 1024, Gp, cp); S.Bt = (const char*)(F.ws + WS_WSM + (size_t)l * WSM_STRIDE + WSM_UKV); S.K = KVRANK;
    const EpiUkv E{wsp<float>(F, WS_RSCKV), wsp<bf16_t>(F, WS_KN), wsp<bf16_t>(F, WS_VM)};
    pg8::gemm_phase(F.lds, F.tid, (const char*)(F.ws + WS_CKV), KVRANK, S, E);
}
__device__ __forceinline__ void phase_outproj(Frame& F, int l) {
    const DenseSched S = dense_sched(F, DM, F.ws + WS_WSM + (size_t)l * WSM_STRIDE + WSM_OUT, DM);
    EpiOut E; E.xin = l == 0 ? F.P->in[0] : nullptr; E.hin = wsp<bf16_t>(F, WS_HBI); E.hout = wsp<bf16_t>(F, WS_HB); E.OSS = wsp<float>(F, WS_OSS);
    pg8::gemm_phase(F.lds, F.tid, (const char*)(F.ws + WS_OA), DM, S, E);
}
__device__ __forceinline__ void moe_table(Frame& F, int l) {
    LAS int* tb = (LAS int*)(F.lds + pg8::STAGE_BYTES);
    __syncthreads();
    if (F.tid == 0) { const unsigned* cnt = wsp<unsigned>(F, WS_CTL) + CW_CNT + 64 * 32 * l; int acc = 0;
        for (int e = 0; e < NEXP; ++e) { const int c = (int)__hip_atomic_load(cnt + 64 * e, __ATOMIC_RELAXED, __HIP_MEMORY_SCOPE_AGENT); tb[e] = acc; tb[40 + e] = c; acc += (c + 255) >> 8; }
        tb[32] = acc; }
    __syncthreads();
}
__device__ __forceinline__ void phase_moe1(Frame& F, int l) {
    moe_table(F, l);
    MoeSched S; S.G = F.G; S.c = F.bx; S.npn = 2; S.gather = 1; S.tb = (const LAS int*)(F.lds + pg8::STAGE_BYTES); S.liste = wsp<int>(F, WS_LISTE); S.Bt = (const char*)(F.ws + WS_WG1); S.K = DM; S.nB = 512;
    const EpiG1 E{wsp<float>(F, WS_RS), wsp<int>(F, WS_LISTE), wsp<bf16_t>(F, WS_HID)};
    pg8::gemm_phase(F.lds, F.tid, (const char*)(F.ws + WS_HB), DM, S, E);
}
__device__ __forceinline__ void phase_moe2(Frame& F, int l) {
    moe_table(F, l);
    MoeSched S; S.G = F.G; S.c = F.bx; S.npn = 4; S.gather = 0; S.tb = (const LAS int*)(F.lds + pg8::STAGE_BYTES); S.liste = wsp<int>(F, WS_LISTE); S.Bt = (const char*)(F.ws + WS_WD); S.K = DEXP; S.nB = 1024;
    const EpiDn E{wsp<int>(F, WS_LISTE), wsp<float>(F, WS_LISTW), wsp<bf16_t>(F, WS_Y)};
    pg8::gemm_phase(F.lds, F.tid, (const char*)(F.ws + WS_HID), DEXP, S, E);
}
__device__ __forceinline__ void phase_pe(Frame& F, int l) {
    if ((F.G & 7) != 0 || F.G < 128) { const DenseSched S = dense_sched(F, DM, F.ws + WS_WSM + (size_t)l * WSM_STRIDE + WSM_PE, DPLE); const EpiBf E{wsp<bf16_t>(F, WS_PE), DM}; pg8::gemm_phase(F.lds, F.tid, (const char*)(F.ws + WS_PB), DPLE, S, E); return; }
    const int rank = F.bx >> 3; if (rank < 8) return;
    DenseSched S; S.o.init(T, DM, F.G - 64, (F.bx & 7) + 8 * (rank - 8)); S.Bt = (const char*)(F.ws + WS_WSM + (size_t)l * WSM_STRIDE + WSM_PE); S.K = DPLE;
    const EpiBf E{wsp<bf16_t>(F, WS_PE), DM};
    pg8::gemm_phase(F.lds, F.tid, (const char*)(F.ws + WS_PB), DPLE, S, E);
}
__device__ __forceinline__ void phase_ple(Frame& F, int l) {
    const DenseSched S = dense_sched(F, DM, F.ws + WS_WSM + (size_t)l * WSM_STRIDE + WSM_PG, DM);
    const EpiPle E{wsp<float>(F, WS_RS), wsp<bf16_t>(F, WS_PE), wsp<bf16_t>(F, WS_HB), wsp<bf16_t>(F, WS_HBI), wsp<float>(F, WS_SSQ)};
    pg8::gemm_phase(F.lds, F.tid, (const char*)(F.ws + WS_HB), DM, S, E);
}

#ifndef PROBE
#define PROBE 0
#endif
constexpr int CW_BAR = 4096;
constexpr int MISC_OFF = 150 * 1024;
static_assert(CW_BAR + XCD_BAR_WORDS <= CW_CNT && (CW_CNT + 64 * 32 * 2 * NLAYER) * 4 <= (int)CTL_BYTES && (CW_BAR + XCD_BAR_WORDS) * 4 <= (int)CTL_BYTES && MISC_OFF + 16 <= LDS_BYTES, "control words");
__global__ void __launch_bounds__(NTHREADS, 2) mega_fwd(Params P) {
    extern __shared__ __attribute__((aligned(16))) unsigned char lds_raw[];
    Frame F; F.lds = (LAS unsigned char*)lds_raw; F.tid = threadIdx.x; F.lane = F.tid & 63; F.wave = __builtin_amdgcn_readfirstlane(F.tid >> 6); F.G = gridDim.x; F.bx = blockIdx.x; F.P = &P; F.ws = P.ws;
    volatile LAS unsigned* st = (volatile LAS unsigned*)(F.lds + MISC_OFF);
    if (F.tid < 4) st[F.tid] = 0u;
    __syncthreads();
    const XcdBarrier bar = xcd_barrier_post(wsp<unsigned>(F, WS_CTL) + CW_BAR, st);
#define GRID_BAR() do { XcdBarrier b_ = bar; asm volatile("" : "+s"(b_.x)); asm volatile("" : "+s"(b_.bar)); xcd_barrier(b_); PH_BEGIN(); } while (0)
#define PH_BEGIN() do { asm volatile("" : "+v"(F.tid)); F.lane = F.tid & 63; asm volatile("" : "+s"(F.ws)); } while (0)
    phase_prep_small(F);
    phase_norm(F, P.in[0]);
#if PROBE == 11
    __syncthreads(); PH_BEGIN(); phase_prep_small(F); phase_norm(F, P.in[0]);
#endif
    GRID_BAR();
#if PROBE == 13
    GRID_BAR(); GRID_BAR(); GRID_BAR(); GRID_BAR(); GRID_BAR(); GRID_BAR(); GRID_BAR(); GRID_BAR(); GRID_BAR(); GRID_BAR();
    GRID_BAR(); GRID_BAR(); GRID_BAR(); GRID_BAR(); GRID_BAR(); GRID_BAR(); GRID_BAR(); GRID_BAR(); GRID_BAR(); GRID_BAR();
#endif
#ifndef TPROBE
#define TPROBE 0
#endif
#define TPH(id, ...) do { unsigned long long t0_ = 0; if (TPROBE == (id)) t0_ = __builtin_amdgcn_s_memrealtime(); __VA_ARGS__; GRID_BAR(); \
        if (TPROBE == (id)) { const unsigned long long t1_ = __builtin_amdgcn_s_memrealtime(); while (__builtin_amdgcn_s_memrealtime() - t1_ < 4ull * (t1_ - t0_)) __builtin_amdgcn_s_sleep(8); GRID_BAR(); } } while (0)
#pragma unroll 1
    for (int l = 0; l < NLAYER; ++l) {
        PH_BEGIN();
        TPH(1, phase_inproj(F, l); PH_BEGIN(); phase_prep_moe(F, l));
        { const bool split = (F.G & 15) == 0; const int Gp = split ? F.G / 2 : F.G;
          TPH(2, if (!split || F.bx < Gp) phase_uq(F, l, Gp, F.bx); PH_BEGIN(); if (!split || F.bx >= Gp) phase_ukv(F, l, Gp, split ? F.bx - Gp : F.bx)); }
        TPH(3, phase_attn(F));
        TPH(4, phase_outproj(F, l));
        TPH(5, phase_route(F, l));
        TPH(6, phase_moe1(F, l); PH_BEGIN(); phase_pe(F, l));
        TPH(7, phase_moe2(F, l));
        TPH(8, phase_norm2(F, l, 1.f));
        TPH(9, phase_ple(F, l));
    }
    phase_final(F);
#undef TPH
#undef GRID_BAR
#undef PH_BEGIN
}

extern "C" void kernel_launch(void* const* d_in, const int* in_sizes, int n_in, void* d_out, int out_size, void* d_ws, size_t ws_size, hipStream_t stream) {
    if (n_in != 24 || out_size != T * DM || ws_size < WS_END) { fprintf(stderr, "kernel_launch: unexpected shapes (n_in %d, out %d, ws %zu < %zu)\n", n_in, out_size, ws_size, (size_t)WS_END); return; }
    Params P{};
    for (int i = 0; i < 24; ++i) P.in[i] = (const float*)d_in[i];
    P.out = (float*)d_out; P.ws = (unsigned char*)d_ws;
    for (int i = 0; i < 16; ++i) P.inv_freq[i] = (float)pow(10000.0, -(double)i / 16.0);
    (void)hipMemsetAsync((char*)d_ws + WS_CTL, 0, CTL_BYTES, stream);
    static int grid = 0;
    if (grid == 0) {
        int dev = 0, cus = 0;
        if (hipGetDevice(&dev) != hipSuccess || hipDeviceGetAttribute(&cus, hipDeviceAttributeMultiprocessorCount, dev) != hipSuccess || cus <= 0) { grid = -1; return; }
        if (hipFuncSetAttribute((const void*)mega_fwd, hipFuncAttributeMaxDynamicSharedMemorySize, LDS_BYTES) != hipSuccess) { fprintf(stderr, "kernel_launch: hipFuncSetAttribute failed\n"); grid = -1; return; }
        grid = cus;
    }
    if (grid < 0) return;
    hipLaunchKernelGGL(mega_fwd, dim3(grid), dim3(NTHREADS), LDS_BYTES, stream, P);
}
```

```cpp
#include <hip/hip_runtime.h>
#include <cstdio>
#include <cstdint>
#include <cmath>

#define GAS __attribute__((address_space(1)))
#define LAS __attribute__((address_space(3)))
#define GAS __attribute__((address_space(1)))
typedef unsigned short bf16_t;
typedef short bf16x8 __attribute__((ext_vector_type(8)));
typedef float f32x4 __attribute__((ext_vector_type(4)));
typedef float f32x2 __attribute__((ext_vector_type(2)));
typedef unsigned u32x4 __attribute__((ext_vector_type(4)));
typedef unsigned u32x2 __attribute__((ext_vector_type(2)));

constexpr int NB = 8, SEQ = 4096, DM = 1024, NLAYER = 4, T = NB * SEQ;
constexpr int DPLE = 256, SBW = 512, MLAW = 512, QRANK = 384, KVRANK = 256, ROPE = 32, QKD = 96;
constexpr int INC = 2208, INP = 2304;
constexpr int NEXP = 32, DEXP = 256;
constexpr float EPS = 1e-6f;
constexpr float LOG2E = 1.4426950408889634f;
constexpr float QS_SB = 0.125f * LOG2E;
constexpr float QS_MLA = 0.10206207261596575f * LOG2E;
constexpr int NWAVES = 8, NTHREADS = 512;

constexpr size_t MiB = 1u << 20;
constexpr size_t WS_CTL = 0, CTL_BYTES = 1 * MiB;
constexpr size_t WS_COS = 1 * MiB, WS_SIN = 3 * MiB;
constexpr size_t WS_RS = 5 * MiB, WS_RSCQ = 6 * MiB, WS_RSCKV = 7 * MiB;
constexpr size_t WS_LISTE = 8 * MiB, WS_LISTW = 12 * MiB;
constexpr size_t WS_WR = 16 * MiB;
constexpr int RT_PITCH = 1032, RT_STRIDE = 73 * 1024;
constexpr size_t WS_WSM = 18 * MiB, WSM_STRIDE = 11 * MiB;
constexpr size_t WSM_IN = 0, WSM_OUT = 4608 * 1024, WSM_PG = WSM_OUT + 2 * MiB, WSM_UQ = WSM_PG + 2 * MiB, WSM_UKV = WSM_UQ + 576 * 1024, WSM_PE = WSM_UKV + 512 * 1024;
constexpr size_t WS_WG1 = 62 * MiB, WS_WD = 94 * MiB;
constexpr size_t WS_H32 = 110 * MiB, WS_HB = 238 * MiB;
constexpr size_t WS_ATT = 302 * MiB;
constexpr size_t WS_QKV = WS_ATT, WS_CKV = WS_ATT + 96 * MiB, WS_CQ = WS_CKV + 16 * MiB, WS_KR = WS_CQ + 24 * MiB, WS_QM = WS_KR + 2 * MiB,
                 WS_KN = WS_QM + 48 * MiB, WS_VM = WS_KN + 32 * MiB, WS_OA = WS_VM + 32 * MiB, WS_ATT_END = WS_OA + 64 * MiB;
constexpr size_t WS_HBI = WS_H32;
constexpr size_t WS_HID = WS_ATT, WS_Y = WS_ATT + 36 * MiB, WS_MOE_END = WS_Y + 128 * MiB;
constexpr size_t WS_SSQ = (WS_ATT_END > WS_MOE_END ? WS_ATT_END : WS_MOE_END), WS_OSS = WS_SSQ + 2 * MiB, WS_PE = WS_OSS + 2 * MiB, WS_PB = WS_PE + 64 * MiB, WS_END = WS_PB + 16 * MiB;
static_assert(WSM_PE + 512 * 1024 <= WSM_STRIDE, "small weights");
static_assert(WS_WSM + 4 * WSM_STRIDE <= WS_WG1, "ws map");
constexpr int CW_CNT = 8192;

constexpr int LDS_BYTES = 152 * 1024;

struct Params {
    const float* in[24];
    float* out;
    unsigned char* ws;
    float inv_freq[16];
};

__device__ __forceinline__ float bf2f(unsigned v) { return __uint_as_float(v << 16); }
__device__ __forceinline__ unsigned f2bf(float f) { unsigned u = __float_as_uint(f); return (u + 0x7fffu + ((u >> 16) & 1u)) >> 16; }
typedef float f32x2_cv_ __attribute__((ext_vector_type(2)));
typedef __bf16 bf16x2_cv_ __attribute__((ext_vector_type(2)));
__device__ __forceinline__ unsigned pk2(float lo, float hi) { f32x2_cv_ v = {lo, hi}; return __builtin_bit_cast(unsigned, __builtin_convertvector(v, bf16x2_cv_)); }
template <int CTRL> __device__ __forceinline__ float dpp_f(float v) { return __uint_as_float((unsigned)__builtin_amdgcn_update_dpp(0, (int)__float_as_uint(v), CTRL, 0xf, 0xf, true)); }
__device__ __forceinline__ float row16_sum(float v) {
    v += dpp_f<0xB1>(v); v += dpp_f<0x4E>(v); v += dpp_f<0x141>(v); v += dpp_f<0x140>(v); return v; }
__device__ __forceinline__ float wave_sum(float v) {
    v = row16_sum(v);
    const float a = __uint_as_float(__builtin_amdgcn_readlane((int)__float_as_uint(v), 0)), b = __uint_as_float(__builtin_amdgcn_readlane((int)__float_as_uint(v), 16)),
                c = __uint_as_float(__builtin_amdgcn_readlane((int)__float_as_uint(v), 32)), d = __uint_as_float(__builtin_amdgcn_readlane((int)__float_as_uint(v), 48));
    return (a + b) + (c + d);
}
__device__ __forceinline__ float half32_sum(float v) {
    v = row16_sum(v);
    auto rr = __builtin_amdgcn_permlane16_swap(__float_as_uint(v), __float_as_uint(v), false, false);
    return __uint_as_float(rr[0]) + __uint_as_float(rr[1]);
}
__device__ __forceinline__ float xor32(float x) { auto rr = __builtin_amdgcn_permlane32_swap(__float_as_uint(x), __float_as_uint(x), false, false); return __uint_as_float(((unsigned)(threadIdx.x & 32)) ? rr[0] : rr[1]); }
__device__ __forceinline__ float xor16(float x) { auto rr = __builtin_amdgcn_permlane16_swap(__float_as_uint(x), __float_as_uint(x), false, false); return __uint_as_float(((unsigned)(threadIdx.x & 16)) ? rr[0] : rr[1]); }
__device__ __forceinline__ float fexp2(float x) { return __builtin_amdgcn_exp2f(x); }
__device__ __forceinline__ float flog2(float x) { return __builtin_amdgcn_logf(x); }
__device__ __forceinline__ float frcp(float x) { return __builtin_amdgcn_rcpf(x); }
__device__ __forceinline__ void unpack8(u32x4 w, float* f) {
    f[0] = __uint_as_float(w.x << 16); f[1] = __uint_as_float(w.x & 0xffff0000u);
    f[2] = __uint_as_float(w.y << 16); f[3] = __uint_as_float(w.y & 0xffff0000u);
    f[4] = __uint_as_float(w.z << 16); f[5] = __uint_as_float(w.z & 0xffff0000u);
    f[6] = __uint_as_float(w.w << 16); f[7] = __uint_as_float(w.w & 0xffff0000u);
}
__device__ __forceinline__ u32x4 pack8(f32x4 a, f32x4 b) { u32x4 w; w.x = pk2(a[0], a[1]); w.y = pk2(a[2], a[3]); w.z = pk2(b[0], b[1]); w.w = pk2(b[2], b[3]); return w; }

__device__ __forceinline__ float rstd_part16(const float* p, float inv_n) { const f32x4 a = ((const f32x4*)p)[0], b = ((const f32x4*)p)[1], c = ((const f32x4*)p)[2], d = ((const f32x4*)p)[3];
    const f32x4 s4 = (a + b) + (c + d); return 1.0f / sqrtf(((s4[0] + s4[1]) + (s4[2] + s4[3])) * inv_n + EPS); }
__device__ __forceinline__ float rstd_part8(const float* p, float inv_n) { const f32x4 a = ((const f32x4*)p)[0], b = ((const f32x4*)p)[1]; const f32x4 s4 = a + b; return 1.0f / sqrtf(((s4[0] + s4[1]) + (s4[2] + s4[3])) * inv_n + EPS); }
__device__ __forceinline__ float rstd_part4(const float* p, float inv_n) { const f32x4 a = ((const f32x4*)p)[0]; return 1.0f / sqrtf(((a[0] + a[1]) + (a[2] + a[3])) * inv_n + EPS); }
__device__ __forceinline__ float sq8(const f32x4& a, const f32x4& b) { return ((a[0] * a[0] + a[1] * a[1]) + (a[2] * a[2] + a[3] * a[3])) + ((b[0] * b[0] + b[1] * b[1]) + (b[2] * b[2] + b[3] * b[3])); }
__device__ __forceinline__ float fq_sum(float v) { v += xor16(v); v += xor32(v); return v; }

namespace pg8 {
constexpr int BM = 256, BK = 64, HALF = 128, HTB = HALF * BK * 2, STAGE_BYTES = 8 * HTB, NXCD = 8, WGM = 8;
__host__ __device__ __forceinline__ int lds_byte(int r, int c) { const int st = (r >> 4) * 2 + (c >> 5), rr = r & 15, cc = c & 31, ob = rr * 64 + cc * 2; return st * 1024 + (ob ^ (((ob >> 9) & 1) << 5)); }
__host__ __device__ __forceinline__ void stage_rc(int b, int& R, int& C) { const int st = b / 1024, sb = b % 1024, swz = sb ^ (((sb >> 9) & 1) << 5); R = (st >> 1) * 16 + swz / 64; C = (st & 1) * 32 + (swz % 64) / 2; }
__host__ __device__ __forceinline__ int perm32(int rho) { const int n = rho >> 4, i = rho & 15; return 8 * (i >> 2) + 4 * n + (i & 3); }

struct Unit { int pm, pn, e, tile, nrows; };

struct StaticOrder {
    int nM, nN, nwg, G, c;
    __device__ void init(int M, int N, int G_, int c_) { nM = M / BM; nN = N / BM; nwg = nM * nN; G = G_; c = c_; }
    __device__ bool next(int i, Unit& u) const {
        const long L = (long)i * G + c; if (L >= nwg) return false;
        int wgid = (int)L; { const int q = nwg / NXCD, r = nwg % NXCD, xcd = wgid % NXCD, off = wgid / NXCD; wgid = (xcd < r ? xcd * (q + 1) : r * (q + 1) + (xcd - r) * q) + off; }
        const int nig = WGM * nN, gid = wgid / nig, fm = gid * WGM, gsz = (nM - fm) < WGM ? (nM - fm) : WGM;
        u.pm = fm + ((wgid % nig) % gsz); u.pn = (wgid % nig) / gsz; u.e = 0; u.tile = 0; u.nrows = 256; return true;
    }
};

template <class Epi, class Sched>
__device__ __forceinline__ void gemm_phase(LAS unsigned char* lds, const int tid, const char* Abase, const int K, const Sched& S, const Epi& E) {
    const int wid = __builtin_amdgcn_readfirstlane(tid >> 6), lane = tid & 63, wr = wid >> 2, wc = wid & 3, fr = lane & 15, fq = lane >> 4;
    const int nt = K / BK;
    unsigned voffB[2];
#pragma unroll
    for (int i = 0; i < 2; ++i) { int R, C; stage_rc(tid * 16 + i * 8192, R, C); const int Rb = (R & ~31) + perm32(R & 31); voffB[i] = (unsigned)(Rb * K + C) * 2u; }
    const size_t kstep = (size_t)(BK * 2);
    const size_t hstep = (size_t)HALF * K * 2;
    const unsigned ldsw = (unsigned)wid * 1024u;
    const int aoff = lds_byte(wr * 64 + fr, fq * 8), boff = lds_byte(wc * 32 + fr, fq * 8);
#define PG8_SA(b, h) (((b) * 2 + (h)) * HTB)
#define PG8_SB(b, h) ((4 + (b) * 2 + (h)) * HTB)
#define PG8_STAGE(bufoff, gbase, voff) do { _Pragma("unroll") for (int _i = 0; _i < 2; ++_i) \
        __builtin_amdgcn_global_load_lds((const unsigned*)((const char*)(gbase) + (voff)[_i]), (LAS unsigned*)(lds + (bufoff) + ldsw + _i * 8192), 16, 0, 0); } while (0)
#define PG8_LDA(dst, b, h) do { _Pragma("unroll") for (int m = 0; m < 4; ++m) _Pragma("unroll") for (int k = 0; k < 2; ++k) dst[m][k] = *(const LAS bf16x8*)(lds + PG8_SA(b, h) + aoff + m * 2048 + k * 1024); } while (0)
#define PG8_LDB(dst, b, h) do { _Pragma("unroll") for (int n = 0; n < 2; ++n) _Pragma("unroll") for (int k = 0; k < 2; ++k) dst[n][k] = *(const LAS bf16x8*)(lds + PG8_SB(b, h) + boff + n * 2048 + k * 1024); } while (0)
#define PG8_MMA(ai, bj, At, Bt) do { __builtin_amdgcn_s_setprio(1); _Pragma("unroll") for (int m = 0; m < 4; ++m) _Pragma("unroll") for (int n = 0; n < 2; ++n) _Pragma("unroll") for (int k = 0; k < 2; ++k) \
        acc[ai][bj][m][n] = __builtin_amdgcn_mfma_f32_16x16x32_bf16(Bt[n][k], At[m][k], acc[ai][bj][m][n], 0, 0, 0); __builtin_amdgcn_s_setprio(0); } while (0)
#define PG8_WAIT_V(n) asm volatile("s_waitcnt vmcnt(" #n ")" ::: "memory")
#define PG8_WAIT_L(n) asm volatile("s_waitcnt lgkmcnt(" #n ")" ::: "memory")
#define PG8_BAR __builtin_amdgcn_s_barrier()
#define PG8_SCHED __builtin_amdgcn_sched_barrier(0)
    Unit cur, nxt; int ui = 0;
    if (!S.next(0, cur)) return;
    f32x4 acc[2][2][4][2];
#pragma unroll
    for (int a = 0; a < 2; ++a)
#pragma unroll
        for (int b = 0; b < 2; ++b)
#pragma unroll
            for (int m = 0; m < 4; ++m)
#pragma unroll
                for (int n = 0; n < 2; ++n) acc[a][b][m][n] = (f32x4){0.f, 0.f, 0.f, 0.f};
    bf16x8 At[4][2], B0[2][2], B1[2][2];
    unsigned vc[2][2];
    LAS u32x4* vslot = (LAS u32x4*)(lds + STAGE_BYTES + 1024) + tid;
#define PG8_AOFFS(dst, U) do { int t2_ = tid; asm volatile("" : "+v"(t2_)); _Pragma("unroll") for (int i = 0; i < 2; ++i) { int R, C; stage_rc(t2_ * 16 + i * 8192, R, C); \
        dst[0][i] = S.a_off(U, R) + (unsigned)C * 2u; dst[1][i] = S.a_off(U, HALF + R) + (unsigned)C * 2u; } } while (0)
    PG8_AOFFS(vc, cur);
    const char* cB = S.b_tile(cur);
    E.begin(cur, ui, tid, lds);
    PG8_STAGE(PG8_SB(0, 0), cB, voffB); PG8_STAGE(PG8_SB(0, 1), cB + hstep, voffB); PG8_STAGE(PG8_SA(0, 0), Abase, vc[0]); PG8_STAGE(PG8_SA(0, 1), Abase, vc[1]);
    if (wr == 1) PG8_BAR;
    PG8_WAIT_V(2); PG8_BAR;
    PG8_STAGE(PG8_SB(1, 0), cB + kstep, voffB); PG8_STAGE(PG8_SA(1, 0), Abase + kstep, vc[0]); PG8_STAGE(PG8_SB(1, 1), cB + hstep + kstep, voffB);
    PG8_WAIT_V(6); PG8_BAR;
    for (;;) {
        const bool has_next = S.next(ui + 1, nxt);
        const char* nB = cB;
        { unsigned vn[2][2];
          if (has_next) { PG8_AOFFS(vn, nxt); nB = S.b_tile(nxt); *vslot = (u32x4){vn[0][0], vn[0][1], vn[1][0], vn[1][1]}; }
          else *vslot = (u32x4){vc[0][0], vc[0][1], vc[1][0], vc[1][1]}; }
        for (int t = 0; t < nt; t += 2) {
            if constexpr (Epi::MID) { if (t == (nt >> 1)) E.mid(acc, ui, wr, fr, lds); }
            const bool last = (t == nt - 2);
            const char* a1 = Abase + (size_t)(t + 1) * kstep;
            const char* a2 = last ? Abase : Abase + (size_t)(t + 2) * kstep; const char* b2 = last ? nB : cB + (size_t)(t + 2) * kstep;
            const char* a3 = a2 + kstep; const char* b3 = b2 + kstep;
            unsigned w2[2][2];
            if (last) { const u32x4 q = *vslot; w2[0][0] = q.x; w2[0][1] = q.y; w2[1][0] = q.z; w2[1][1] = q.w; }
            else { w2[0][0] = vc[0][0]; w2[0][1] = vc[0][1]; w2[1][0] = vc[1][0]; w2[1][1] = vc[1][1]; }
            PG8_LDB(B0, 0, 0); PG8_LDB(B1, 0, 1); PG8_SCHED; PG8_LDA(At, 0, 0); PG8_STAGE(PG8_SA(1, 1), a1, vc[1]);
            PG8_WAIT_V(8); PG8_WAIT_L(0); PG8_BAR; PG8_MMA(0, 0, At, B0); PG8_MMA(0, 1, At, B1); PG8_BAR; PG8_SCHED;
            PG8_LDA(At, 0, 1); PG8_STAGE(PG8_SB(0, 0), b2, voffB); PG8_STAGE(PG8_SB(0, 1), b2 + hstep, voffB); PG8_STAGE(PG8_SA(0, 0), a2, w2[0]);
            PG8_WAIT_V(8); PG8_WAIT_L(0); PG8_BAR; PG8_MMA(1, 0, At, B0); PG8_MMA(1, 1, At, B1); PG8_BAR; PG8_SCHED;
            PG8_LDB(B0, 1, 0); PG8_LDB(B1, 1, 1); PG8_SCHED; PG8_LDA(At, 1, 0); PG8_STAGE(PG8_SA(0, 1), a2, w2[1]);
            PG8_WAIT_V(8); PG8_WAIT_L(0); PG8_BAR; PG8_MMA(0, 0, At, B0); PG8_MMA(0, 1, At, B1); PG8_BAR; PG8_SCHED;
            PG8_LDA(At, 1, 1); PG8_STAGE(PG8_SB(1, 0), b3, voffB); PG8_STAGE(PG8_SB(1, 1), b3 + hstep, voffB); PG8_STAGE(PG8_SA(1, 0), a3, w2[0]);
            PG8_WAIT_V(8); PG8_WAIT_L(0); PG8_BAR; PG8_MMA(1, 0, At, B0); PG8_MMA(1, 1, At, B1); PG8_BAR; PG8_SCHED;
        }
        if (wr == 0) PG8_BAR;
        { int t3 = tid; asm volatile("" : "+v"(t3)); const int fr2 = t3 & 15, fq2 = (t3 >> 4) & 3;
          E(acc, cur, ui, wr, wc, fr2, fq2, lds); }
        if (!has_next) break;
#pragma unroll
        for (int a = 0; a < 2; ++a)
#pragma unroll
            for (int b = 0; b < 2; ++b)
#pragma unroll
                for (int m = 0; m < 4; ++m)
#pragma unroll
                    for (int n = 0; n < 2; ++n) acc[a][b][m][n] = (f32x4){0.f, 0.f, 0.f, 0.f};
        cur = nxt; cB = nB; ++ui;
        E.begin(cur, ui, tid, lds);
        { const u32x4 q = *vslot; vc[0][0] = q.x; vc[0][1] = q.y; vc[1][0] = q.z; vc[1][1] = q.w; }
        if (wr == 1) PG8_BAR;
    }
    PG8_WAIT_V(0);
    PG8_BAR;
#undef PG8_AOFFS
#undef PG8_SA
#undef PG8_SB
#undef PG8_STAGE
#undef PG8_LDA
#undef PG8_LDB
#undef PG8_MMA
#undef PG8_WAIT_V
#undef PG8_WAIT_L
#undef PG8_BAR
#undef PG8_SCHED
}
}
using pg8::Unit;

struct DenseSched {
    pg8::StaticOrder o; const char* Bt; int K;
    __device__ __forceinline__ bool next(int i, Unit& u) const { return o.next(i, u); }
    __device__ __forceinline__ unsigned a_off(const Unit& u, int r) const { return (unsigned)(u.pm * 256 + r) * (unsigned)(K * 2); }
    __device__ __forceinline__ const char* b_tile(const Unit& u) const { return Bt + (size_t)u.pn * 256 * K * 2; }
};
struct MoeSched {
    int G, c, npn, gather; const LAS int* tb; const int* liste; const char* Bt; int K, nB;
    __device__ __forceinline__ bool next(int i, Unit& u) const {
        if ((G & 7) == 0) {
            const int x = c & 7, W = G >> 3, q = i * W + (c >> 3);
            int tq = q / npn; u.pn = q % npn;
#pragma unroll 1
            for (int k = 0; k < 4; ++k) { const int e = x + 8 * k, nte = tb[e + 1] - tb[e];
                if (tq < nte) { u.e = e; u.tile = tq; u.pm = tb[e] + tq; const int rem = tb[40 + e] - 256 * tq; u.nrows = rem < 256 ? rem : 256; return true; }
                tq -= nte; }
            return false;
        }
        const int L = i * G + c, ntile = tb[32];
        if (L >= ntile * npn) return false;
        const int ti = L / npn; u.pn = L % npn; u.pm = ti;
        int e = 0;
#pragma unroll 1
        for (; e < 31; ++e) if (ti < tb[e + 1]) break;
        u.e = e; u.tile = ti - tb[e]; const int rem = tb[40 + e] - 256 * u.tile; u.nrows = rem < 256 ? rem : 256; return true;
    }
    __device__ __forceinline__ unsigned a_off(const Unit& u, int r) const {
        if (gather) { int tok = 0; if (r < u.nrows) tok = liste[(size_t)u.e * T + 256 * u.tile + r] >> 1; return (unsigned)tok * (unsigned)(K * 2); }
        return (unsigned)(u.pm * 256 + r) * (unsigned)(K * 2);
    }
    __device__ __forceinline__ const char* b_tile(const Unit& u) const { return Bt + ((size_t)u.e * nB + (size_t)u.pn * 256) * K * 2; }
};

#define EPI_DEFAULTS static constexpr bool MID = false; __device__ __forceinline__ void begin(const Unit&, int, int, LAS unsigned char*) const {}
#define EPI_NOMID static constexpr bool MID = false;
constexpr int RTAB_OFF = pg8::STAGE_BYTES + 1024 + 8192;
__device__ __forceinline__ void rtab_put(LAS unsigned char* lds, int ui, int r, float a, float b) { asm volatile("" : "+v"(r));
    ((LAS f32x2*)(lds + RTAB_OFF))[(ui & 1) * 256 + r] = (f32x2){a, b}; }
__device__ __forceinline__ f32x2 rtab_get(LAS unsigned char* lds, int ui, int r) { return ((const LAS f32x2*)(lds + RTAB_OFF))[(ui & 1) * 256 + r]; }
struct EpiIn {
    EPI_NOMID
    __device__ __forceinline__ void begin(const Unit& u, int ui, int tid, LAS unsigned char* lds) const { if (tid < 256) rtab_put(lds, ui, tid, rstd_part16(SSQ + (size_t)(u.pm * 256 + tid) * 16, 1.f / DM), 0.f); }
    const float* SSQ; bf16_t* QKV; bf16_t* CKV; bf16_t* CQ; bf16_t* KR; const float* COS; const float* SIN; float* SQQ; float* SQK;
    __device__ __forceinline__ void operator()(const f32x4 (&acc)[2][2][4][2], const Unit& u, int ui, int wr, int wc, int fr, int fq, LAS unsigned char* lds) const {
        const int pn = u.pn;
#pragma unroll
        for (int ai = 0; ai < 2; ++ai)
#pragma unroll
            for (int m = 0; m < 4; ++m) {
                const int rr = ai * 128 + wr * 64 + m * 16 + fr, row = u.pm * 256 + rr; const float rs = rtab_get(lds, ui, rr)[0];
                float sq = 0.f;
#pragma unroll
                for (int bj = 0; bj < 2; ++bj) {
                    const int c = bj * 128 + wc * 32 + fq * 8;
                    f32x4 v0 = acc[ai][bj][m][0] * rs, v1 = acc[ai][bj][m][1] * rs;
                    if (pn < 6) { if (pn < 2) { v0 = v0 * QS_SB; v1 = v1 * QS_SB; } *(u32x4*)(QKV + (size_t)row * 1536 + pn * 256 + c) = pack8(v0, v1); }
                    else if (pn == 6) { *(u32x4*)(CKV + (size_t)row * 256 + c) = pack8(v0, v1); sq += sq8(v0, v1); }
                    else if (pn == 7) { *(u32x4*)(CQ + (size_t)row * 384 + c) = pack8(v0, v1); sq += sq8(v0, v1); }
                    else if (bj == 0) { *(u32x4*)(CQ + (size_t)row * 384 + 256 + c) = pack8(v0, v1); sq += sq8(v0, v1); }
                    else if (wc == 0) {
                        const int ib = 8 * (fq & 1);
                        const f32x4 c0 = *(const f32x4*)(COS + (size_t)row * 16 + ib), c1 = *(const f32x4*)(COS + (size_t)row * 16 + ib + 4);
                        const f32x4 s0 = *(const f32x4*)(SIN + (size_t)row * 16 + ib), s1 = *(const f32x4*)(SIN + (size_t)row * 16 + ib + 4);
                        f32x4 p0, p1;
#pragma unroll
                        for (int i = 0; i < 4; ++i) { p0[i] = xor32(v0[i]); p1[i] = xor32(v1[i]); }
                        const float sg = (fq < 2) ? -1.f : 1.f;
                        const f32x4 o0 = v0 * c0 + p0 * s0 * sg, o1 = v1 * c1 + p1 * s1 * sg;
                        *(u32x4*)(KR + (size_t)row * 32 + fq * 8) = pack8(o0, o1);
                    }
                }
                if (pn >= 6) {
                    sq = fq_sum(sq);
                    if (fq == 0) { if (pn == 6) SQK[(size_t)row * 4 + wc] = sq; else SQQ[(size_t)row * 8 + (pn - 7) * 4 + wc] = sq; }
                }
                asm volatile("" ::: "memory");
            }
    }
};
struct EpiUq {
    EPI_NOMID
    __device__ __forceinline__ void begin(const Unit& u, int ui, int tid, LAS unsigned char* lds) const { if (tid < 256) rtab_put(lds, ui, tid, rstd_part8(RS + (size_t)(u.pm * 256 + tid) * 8, 1.f / QRANK) * QS_MLA, 0.f); }
    const float* RS; bf16_t* QM; const float* COS; const float* SIN;
    __device__ __forceinline__ void operator()(const f32x4 (&acc)[2][2][4][2], const Unit& u, int ui, int wr, int wc, int fr, int fq, LAS unsigned char* lds) const {
#pragma unroll
        for (int ai = 0; ai < 2; ++ai)
#pragma unroll
            for (int m = 0; m < 4; ++m) {
                const int rr = ai * 128 + wr * 64 + m * 16 + fr, row = u.pm * 256 + rr; const float rs = rtab_get(lds, ui, rr)[0];
#pragma unroll
                for (int bj = 0; bj < 2; ++bj) {
                    const int c = u.pn * 256 + bj * 128 + wc * 32 + fq * 8; const int g32 = u.pn * 8 + bj * 4 + wc;
                    f32x4 v0 = acc[ai][bj][m][0] * rs, v1 = acc[ai][bj][m][1] * rs;
                    if ((g32 % 3) == 2) {
                        const int ib = 8 * (fq & 1);
                        const f32x4 c0 = *(const f32x4*)(COS + (size_t)row * 16 + ib), c1 = *(const f32x4*)(COS + (size_t)row * 16 + ib + 4);
                        const f32x4 s0 = *(const f32x4*)(SIN + (size_t)row * 16 + ib), s1 = *(const f32x4*)(SIN + (size_t)row * 16 + ib + 4);
                        f32x4 p0, p1;
#pragma unroll
                        for (int i = 0; i < 4; ++i) { p0[i] = xor32(v0[i]); p1[i] = xor32(v1[i]); }
                        const float sg = (fq < 2) ? -1.f : 1.f;
                        v0 = v0 * c0 + p0 * s0 * sg; v1 = v1 * c1 + p1 * s1 * sg;
                    }
                    *(u32x4*)(QM + (size_t)row * 768 + c) = pack8(v0, v1);
                }
                asm volatile("" ::: "memory");
            }
    }
};
struct EpiUkv {
    EPI_NOMID
    __device__ __forceinline__ void begin(const Unit& u, int ui, int tid, LAS unsigned char* lds) const { if (tid < 256) rtab_put(lds, ui, tid, rstd_part4(RS + (size_t)(u.pm * 256 + tid) * 4, 1.f / KVRANK), 0.f); }
    const float* RS; bf16_t* KN; bf16_t* VM;
    __device__ __forceinline__ void operator()(const f32x4 (&acc)[2][2][4][2], const Unit& u, int ui, int wr, int wc, int fr, int fq, LAS unsigned char* lds) const {
        bf16_t* dst = u.pn < 2 ? KN : VM; const int cb = (u.pn & 1) * 256;
#pragma unroll
        for (int ai = 0; ai < 2; ++ai)
#pragma unroll
            for (int m = 0; m < 4; ++m) {
                const int rr = ai * 128 + wr * 64 + m * 16 + fr, row = u.pm * 256 + rr; const float rs = rtab_get(lds, ui, rr)[0];
#pragma unroll
                for (int bj = 0; bj < 2; ++bj) { const int c = cb + bj * 128 + wc * 32 + fq * 8;
                    *(u32x4*)(dst + (size_t)row * 512 + c) = pack8(acc[ai][bj][m][0] * rs, acc[ai][bj][m][1] * rs); }
            }
    }
};
struct EpiBf {
    EPI_DEFAULTS
    bf16_t* O; int ldc;
    __device__ __forceinline__ void operator()(const f32x4 (&acc)[2][2][4][2], const Unit& u, int ui, int wr, int wc, int fr, int fq, LAS unsigned char* lds) const {
#pragma unroll
        for (int ai = 0; ai < 2; ++ai)
#pragma unroll
            for (int m = 0; m < 4; ++m) {
                const int row = u.pm * 256 + ai * 128 + wr * 64 + m * 16 + fr;
#pragma unroll
                for (int bj = 0; bj < 2; ++bj) { const int c = u.pn * 256 + bj * 128 + wc * 32 + fq * 8;
                    *(u32x4*)(O + (size_t)row * ldc + c) = pack8(acc[ai][bj][m][0], acc[ai][bj][m][1]); }
            }
    }
};
constexpr int OTAB_OFF = RTAB_OFF;
struct EpiOut {
    static constexpr bool MID = true;
    const float* xin; const bf16_t* hin; bf16_t* hout; const float* OSS;
    __device__ __forceinline__ void begin(const Unit& u, int ui, int tid, LAS unsigned char* lds) const {
        if (tid < 256) { const float* p = OSS + (size_t)(u.pm * 256 + tid) * 16; const f32x4 a = ((const f32x4*)p)[0], b = ((const f32x4*)p)[1], c = ((const f32x4*)p)[2], d = ((const f32x4*)p)[3];
            const f32x4 s1 = a + b, s2 = c + d; const float rs = 1.0f / sqrtf(((s1[0] + s1[1]) + (s1[2] + s1[3])) * (1.f / 512.f) + EPS), rm = 1.0f / sqrtf(((s2[0] + s2[1]) + (s2[2] + s2[3])) * (1.f / 512.f) + EPS);
            ((LAS f32x2*)(lds + OTAB_OFF))[(ui & 1) * 256 + tid] = (f32x2){rs / rm, rm}; }
    }
    __device__ __forceinline__ void mid(f32x4 (&acc)[2][2][4][2], int ui, int wr, int fr, LAS unsigned char* lds) const {
#pragma unroll
        for (int ai = 0; ai < 2; ++ai)
#pragma unroll
            for (int m = 0; m < 4; ++m) { const float f = ((const LAS f32x2*)(lds + OTAB_OFF))[(ui & 1) * 256 + ai * 128 + wr * 64 + m * 16 + fr][0];
#pragma unroll
                for (int bj = 0; bj < 2; ++bj)
#pragma unroll
                    for (int n = 0; n < 2; ++n) acc[ai][bj][m][n] = acc[ai][bj][m][n] * f; }
    }
    __device__ __forceinline__ void operator()(const f32x4 (&acc)[2][2][4][2], const Unit& u, int ui, int wr, int wc, int fr, int fq, LAS unsigned char* lds) const {
#pragma unroll
        for (int ai = 0; ai < 2; ++ai) {
            if (xin) {
#pragma unroll
                for (int m = 0; m < 4; ++m) { const int r = ai * 128 + wr * 64 + m * 16 + fr, row = u.pm * 256 + r; const float rm = rtab_get(lds, ui, r)[1];
#pragma unroll
                    for (int bj = 0; bj < 2; ++bj) { const size_t o = (size_t)row * DM + u.pn * 256 + bj * 128 + wc * 32 + fq * 8;
                        const f32x4 a = *(const f32x4*)(xin + o), b = *(const f32x4*)(xin + o + 4);
                        *(u32x4*)(hout + o) = pack8(a + acc[ai][bj][m][0] * rm, b + acc[ai][bj][m][1] * rm); }
                    asm volatile("" ::: "memory"); }
            } else {
                u32x4 hb[4][2];
#pragma unroll
                for (int m = 0; m < 4; ++m)
#pragma unroll
                    for (int bj = 0; bj < 2; ++bj) hb[m][bj] = *(const u32x4*)(hin + (size_t)(u.pm * 256 + ai * 128 + wr * 64 + m * 16 + fr) * DM + u.pn * 256 + bj * 128 + wc * 32 + fq * 8);
#pragma unroll
                for (int m = 0; m < 4; ++m) { const int r = ai * 128 + wr * 64 + m * 16 + fr, row = u.pm * 256 + r; const float rm = rtab_get(lds, ui, r)[1];
#pragma unroll
                    for (int bj = 0; bj < 2; ++bj) { const size_t o = (size_t)row * DM + u.pn * 256 + bj * 128 + wc * 32 + fq * 8;
                        float f[8]; unpack8(hb[m][bj], f);
                        *(u32x4*)(hout + o) = pack8((f32x4){f[0], f[1], f[2], f[3]} + acc[ai][bj][m][0] * rm, (f32x4){f[4], f[5], f[6], f[7]} + acc[ai][bj][m][1] * rm); } }
            }
            asm volatile("" ::: "memory");
        }
    }
};
struct EpiG1 {
    EPI_NOMID
    __device__ __forceinline__ void begin(const Unit& u, int ui, int tid, LAS unsigned char* lds) const {
        if (tid < 256) { float rs = 0.f; if (tid < u.nrows) rs = RS[liste[(size_t)u.e * T + 256 * u.tile + tid] >> 1]; rtab_put(lds, ui, tid, rs, 0.f); } }
    const float* RS; const int* liste; bf16_t* HID;
    __device__ __forceinline__ void operator()(const f32x4 (&acc)[2][2][4][2], const Unit& u, int ui, int wr, int wc, int fr, int fq, LAS unsigned char* lds) const {
#pragma unroll
        for (int ai = 0; ai < 2; ++ai)
#pragma unroll
            for (int m = 0; m < 4; ++m) {
                const int r = ai * 128 + wr * 64 + m * 16 + fr;
                if (r < u.nrows) {
                    const float rs = rtab_get(lds, ui, r)[0];
                    f32x4 h[2];
#pragma unroll
                    for (int n = 0; n < 2; ++n) { const f32x4 g = acc[ai][0][m][n] * rs, up = acc[ai][1][m][n] * rs;
#pragma unroll
                        for (int i = 0; i < 4; ++i) h[n][i] = g[i] * frcp(1.f + fexp2(-g[i] * LOG2E)) * up[i]; }
                    *(u32x4*)(HID + (size_t)(u.pm * 256 + r) * 256 + u.pn * 128 + wc * 32 + fq * 8) = pack8(h[0], h[1]);
                }
                asm volatile("" ::: "memory");
            }
    }
};
struct EpiDn {
    EPI_NOMID
    __device__ __forceinline__ void begin(const Unit& u, int ui, int tid, LAS unsigned char* lds) const {
        asm volatile("" : "+v"(tid));
        if (tid < 256) { int ent = 0; float w = 0.f; if (tid < u.nrows) { const size_t li = (size_t)u.e * T + 256 * u.tile + tid; ent = liste[li]; w = listw[li]; } rtab_put(lds, ui, tid, __int_as_float(ent), w); } }
    const int* liste; const float* listw; bf16_t* Y;
    __device__ __forceinline__ void operator()(const f32x4 (&acc)[2][2][4][2], const Unit& u, int ui, int wr, int wc, int fr, int fq, LAS unsigned char* lds) const {
#pragma unroll
        for (int ai = 0; ai < 2; ++ai)
#pragma unroll
            for (int m = 0; m < 4; ++m) {
                const int r = ai * 128 + wr * 64 + m * 16 + fr;
                if (r < u.nrows) {
                    const f32x2 te = rtab_get(lds, ui, r); const int ent = __float_as_int(te[0]); const float w = te[1];
#pragma unroll
                    for (int bj = 0; bj < 2; ++bj) { const int c = u.pn * 256 + bj * 128 + wc * 32 + fq * 8;
                        *(u32x4*)(Y + (size_t)ent * DM + c) = pack8(acc[ai][bj][m][0] * w, acc[ai][bj][m][1] * w); }
                }
                asm volatile("" ::: "memory");
            }
    }
};
struct EpiPle {
    EPI_NOMID
    __device__ __forceinline__ void begin(const Unit& u, int ui, int tid, LAS unsigned char* lds) const { if (tid < 256) rtab_put(lds, ui, tid, RS[u.pm * 256 + tid], 0.f); }
    const float* RS; const bf16_t* PE; const bf16_t* H; bf16_t* HO; float* SSQ;
    __device__ __forceinline__ void operator()(const f32x4 (&acc)[2][2][4][2], const Unit& u, int ui, int wr, int wc, int fr, int fq, LAS unsigned char* lds) const {
#pragma unroll
        for (int ai = 0; ai < 2; ++ai) {
            u32x4 hb[4][2], pb[4][2];
#pragma unroll
            for (int m = 0; m < 4; ++m)
#pragma unroll
                for (int bj = 0; bj < 2; ++bj) { const size_t o = (size_t)(u.pm * 256 + ai * 128 + wr * 64 + m * 16 + fr) * DM + u.pn * 256 + bj * 128 + wc * 32 + fq * 8;
                    hb[m][bj] = *(const GAS u32x4*)(H + o); pb[m][bj] = *(const GAS u32x4*)(PE + o); }
#pragma unroll
            for (int m = 0; m < 4; ++m) {
                const int rr = ai * 128 + wr * 64 + m * 16 + fr, row = u.pm * 256 + rr; const float rs = rtab_get(lds, ui, rr)[0];
                float sq = 0.f;
#pragma unroll
                for (int bj = 0; bj < 2; ++bj) { const size_t o = (size_t)row * DM + u.pn * 256 + bj * 128 + wc * 32 + fq * 8;
                    float pe[8], hv[8]; unpack8(pb[m][bj], pe); unpack8(hb[m][bj], hv);
#pragma unroll
                    for (int i = 0; i < 4; ++i) { hv[i] += frcp(1.f + fexp2(-acc[ai][bj][m][0][i] * rs * LOG2E)) * pe[i]; hv[4 + i] += frcp(1.f + fexp2(-acc[ai][bj][m][1][i] * rs * LOG2E)) * pe[4 + i]; }
                    const u32x4 w = (u32x4){pk2(hv[0], hv[1]), pk2(hv[2], hv[3]), pk2(hv[4], hv[5]), pk2(hv[6], hv[7])};
                    *(GAS u32x4*)(HO + o) = w; unpack8(w, hv);
#pragma unroll
                    for (int i = 0; i < 8; ++i) sq += hv[i] * hv[i]; }
                sq = fq_sum(sq);
                if (fq == 0) *(GAS float*)(SSQ + (size_t)row * 16 + u.pn * 4 + wc) = sq;
            }
            asm volatile("" ::: "memory");
        }
    }
};


#define XB_TMO      128
#define XB_XCNT(j)  (256  + 64 * (j))
#define XB_XSUB(j)  (1280 + 64 * (j))
#define XB_XGEN(j)  (2304 + 64 * (j))
#define XB_TOP      3328
#define XB_TOPGEN   3392
#define XCD_BAR_WORDS 3456
#define XB_SPIN_CAP (1u << 18)

__device__ __forceinline__ unsigned xb_ld(unsigned* p)              { return __hip_atomic_load(p, __ATOMIC_RELAXED, __HIP_MEMORY_SCOPE_AGENT); }
__device__ __forceinline__ unsigned xb_add(unsigned* p, unsigned v) { return __hip_atomic_fetch_add(p, v, __ATOMIC_RELAXED, __HIP_MEMORY_SCOPE_AGENT); }
__device__ __forceinline__ unsigned xb_xcc_id() { return (unsigned)__builtin_amdgcn_s_getreg((3 << 11) | 20) & 0xFu; }
#define XB_SPIN(cond, bar) do { unsigned _sp = 0; while (cond) { __builtin_amdgcn_s_sleep(1); \
    if ((++_sp & 255u) == 0u) { if (xb_ld(&(bar)[XB_TMO])) break; if (_sp > XB_SPIN_CAP) { atomicAdd(&(bar)[XB_TMO], 1u); break; } } } } while (0)

struct XcdBarrier {
    unsigned* bar; unsigned x;
    volatile LAS unsigned* st;
};

__device__ __forceinline__ XcdBarrier xcd_barrier_post(unsigned* bar, volatile LAS unsigned* st) {
    XcdBarrier b; b.bar = bar; b.x = xb_xcc_id(); b.st = st;
    if (threadIdx.x == 0) (void)xb_add(&bar[XB_XCNT(b.x)], 1u);
    return b;
}
__device__ __forceinline__ void xcd_barrier_complete(unsigned* bar, unsigned x, unsigned& nloc, unsigned& nx) {
    const unsigned G = gridDim.x * gridDim.y * gridDim.z;
    unsigned sum, cnt, mine, sp = 0u;
    for (;;) {
        sum = 0u; cnt = 0u; mine = 0u;
#pragma unroll
        for (unsigned j = 0; j < 16; ++j) { const unsigned c = xb_ld(&bar[XB_XCNT(j)]); sum += c; cnt += (c > 0u) ? 1u : 0u; mine = (j == x) ? c : mine; }
        if (sum == G) break;
        __builtin_amdgcn_s_sleep(1);
        if ((++sp & 255u) == 0u) { if (xb_ld(&bar[XB_TMO])) break; if (sp > XB_SPIN_CAP) { atomicAdd(&bar[XB_TMO], 1u); break; } }
    }
    nloc = mine > 0u ? mine : 1u; nx = cnt > 0u ? cnt : 1u;
}

__device__ __forceinline__ void xcd_barrier(const XcdBarrier& b) {
    asm volatile("s_waitcnt vmcnt(0)" ::: "memory");
    __syncthreads();
    if (threadIdx.x == 0) {
        unsigned* bar = b.bar;
        __builtin_amdgcn_s_waitcnt(0);
        unsigned nloc = b.st[0], nx = b.st[1];
        if (nloc == 0u) { xcd_barrier_complete(bar, b.x, nloc, nx); b.st[0] = nloc; b.st[1] = nx; }
        const unsigned old = xb_add(&bar[XB_XSUB(b.x)], 1u);
        const unsigned gen = old / nloc;
        if (old + 1u == (gen + 1u) * nloc) {
            __builtin_amdgcn_fence(__ATOMIC_RELEASE, "agent");
            asm volatile("s_waitcnt vmcnt(0)" ::: "memory");
            const unsigned og = xb_add(&bar[XB_TOP], 1u);
            const unsigned tg = og / nx;
            if (og + 1u == (tg + 1u) * nx) xb_add(&bar[XB_TOPGEN], 1u);
            else XB_SPIN(xb_ld(&bar[XB_TOPGEN]) == tg, bar);
            __builtin_amdgcn_fence(__ATOMIC_ACQUIRE, "agent");
            xb_add(&bar[XB_XGEN(b.x)], 1u);
            asm volatile("s_waitcnt vmcnt(0)" ::: "memory");
        } else {
            XB_SPIN(xb_ld(&bar[XB_XGEN(b.x)]) == gen, bar);
            __builtin_amdgcn_fence(__ATOMIC_ACQUIRE, "agent");
            asm volatile("s_waitcnt vmcnt(0)" ::: "memory");
        }
    }
    __syncthreads();
}


struct Frame {
    LAS unsigned char* lds; int tid, lane, wave, G, bx;
    const Params* P; unsigned char* ws;
    __device__ __forceinline__ int gw() const { return bx * NWAVES + wave; }
    __device__ __forceinline__ int ngw() const { return G * NWAVES; }
};
template <class Tp> __device__ __forceinline__ Tp* wsp(const Frame& F, size_t off) { return (Tp*)(F.ws + off); }

__device__ __forceinline__ void prep_item(const float* W, int ldw, int srccol0, const float* g, bf16_t* dstrow0, int K, int k0, LAS float* scr, int lane) {
    const int c = lane & 7;
    if (srccol0 < 0) {
#pragma unroll
        for (int j = 0; j < 4; ++j) { const int n = (lane >> 3) + 8 * j; *(u32x4*)(dstrow0 + (size_t)n * K + k0 + 8 * c) = (u32x4){0u, 0u, 0u, 0u}; }
        return;
    }
#pragma unroll 8
    for (int i = 0; i < 32; ++i) { const int kk = 2 * i + (lane >> 5); float v = W[(size_t)(k0 + kk) * ldw + srccol0 + (lane & 31)]; if (g) v *= g[k0 + kk]; scr[kk * 33 + (lane & 31)] = v; }
    asm volatile("s_waitcnt lgkmcnt(0)" ::: "memory");
#pragma unroll
    for (int j = 0; j < 4; ++j) { const int n = (lane >> 3) + 8 * j; const LAS float* s = scr + (8 * c) * 33 + n;
        u32x4 o; o.x = pk2(s[0 * 33], s[1 * 33]); o.y = pk2(s[2 * 33], s[3 * 33]); o.z = pk2(s[4 * 33], s[5 * 33]); o.w = pk2(s[6 * 33], s[7 * 33]);
        *(u32x4*)(dstrow0 + (size_t)n * K + k0 + 8 * c) = o; }
    asm volatile("s_waitcnt lgkmcnt(0)" ::: "memory");
}
__device__ __forceinline__ void phase_prep_small(Frame& F) {
    const Params& P = *F.P;
    LAS float* scr = (LAS float*)(F.lds + F.wave * 16384);
    constexpr int I_IN = 16 * 72, I_UQ = 6 * 24, I_UKV = 4 * 32, I_OUT = 16 * 32, I_PG = 16 * 32, I_PE = 4 * 32, I_L = I_IN + I_UQ + I_UKV + I_OUT + I_PG + I_PE;
    for (int it = F.gw(); it < NLAYER * I_L; it += F.ngw()) {
        const int l = it / I_L; int r = it % I_L;
        unsigned char* wb = F.ws + WS_WSM + (size_t)l * WSM_STRIDE;
        if (r < I_IN) { const int kb = r / 72, gi = r % 72, n0 = gi * 32; int src;
            if (n0 < 1536) src = n0; else if (n0 < 1792) src = 1920 + (n0 - 1536); else if (n0 < 2176) src = 1536 + (n0 - 1792); else if (n0 < 2208) src = n0; else src = -1;
            prep_item(P.in[4] + (size_t)l * DM * INC, INC, src, P.in[3] + l * DM, (bf16_t*)(wb + WSM_IN) + (size_t)n0 * DM, DM, kb * 64, scr, F.lane); continue; }
        r -= I_IN;
        if (r < I_UQ) { const int kb = r / 24, n0 = (r % 24) * 32;
            prep_item(P.in[6] + (size_t)l * QRANK * 768, 768, n0, P.in[5] + l * QRANK, (bf16_t*)(wb + WSM_UQ) + (size_t)n0 * QRANK, QRANK, kb * 64, scr, F.lane); continue; }
        r -= I_UQ;
        if (r < I_UKV) { const int kb = r / 32, n0 = (r % 32) * 32; const int hh = (n0 & 511) >> 6, d = n0 & 63; const int src = hh * 128 + (n0 >= 512 ? 64 : 0) + d;
            prep_item(P.in[8] + (size_t)l * KVRANK * 1024, 1024, src, P.in[7] + l * KVRANK, (bf16_t*)(wb + WSM_UKV) + (size_t)n0 * KVRANK, KVRANK, kb * 64, scr, F.lane); continue; }
        r -= I_UKV;
        if (r < I_OUT) { const int kb = r / 32, n0 = (r % 32) * 32; const int k0 = kb * 64;
            const float* g = k0 < 512 ? P.in[9] + l * 512 : P.in[10] + l * 512 - 512;
            prep_item(P.in[11] + (size_t)l * DM * DM, DM, n0, g, (bf16_t*)(wb + WSM_OUT) + (size_t)n0 * DM, DM, k0, scr, F.lane); continue; }
        r -= I_OUT;
        if (r < I_PG) { const int kb = r / 32, n0 = (r % 32) * 32;
            prep_item(P.in[21] + (size_t)l * DM * DM, DM, n0, P.in[20] + l * DM, (bf16_t*)(wb + WSM_PG) + (size_t)n0 * DM, DM, kb * 64, scr, F.lane); continue; }
        r -= I_PG;
        { const int kb = r / 32, n0 = (r % 32) * 32;
            prep_item(P.in[22] + (size_t)l * DPLE * DM, DM, n0, nullptr, (bf16_t*)(wb + WSM_PE) + (size_t)n0 * DPLE, DPLE, kb * 64, scr, F.lane); }
    }
    bf16_t* WRT = wsp<bf16_t>(F, WS_WR);
    for (int i = F.bx * NTHREADS + F.tid; i < NLAYER * 36 * DM; i += F.G * NTHREADS) {
        const int l = i / (36 * DM), c = (i / DM) % 36, k = i % DM;
        const float w = (c < 32 ? P.in[15][((size_t)l * DM + k) * 32 + c] : P.in[13][((size_t)l * DM + k) * 4 + (c - 32)]) * P.in[12][l * DM + k];
        const unsigned hb = f2bf(w); const float lo = w - bf2f(hb);
        bf16_t* tb = WRT + (size_t)l * (2 * RT_STRIDE / 2);
        tb[c * RT_PITCH + k] = (bf16_t)hb; tb[RT_STRIDE / 2 + c * RT_PITCH + k] = (bf16_t)f2bf(lo);
    }
    float* COS = wsp<float>(F, WS_COS); float* SIN = wsp<float>(F, WS_SIN); const int* pos = (const int*)P.in[2];
    for (int i = F.bx * NTHREADS + F.tid; i < T * 16; i += F.G * NTHREADS) {
        const float ang = (float)pos[i >> 4] * P.inv_freq[i & 15];
        const double a = (double)ang; const double q = __builtin_rint(a * 0.63661977236758134308);
        double r = __builtin_fma(-q, 1.57079632679489655800, a); r = __builtin_fma(-q, 6.12323399573676603587e-17, r);
        const double z = r * r;
        const double sp = r + r * z * (-0.166666666416265235595 + z * (0.0083333293858894631756 + z * (-0.000198393348360966317347 + z * 0.0000027183114939898219064)));
        const double cp = 1.0 + z * (-0.499999997251031003120 + z * (0.0416666233237390631894 + z * (-0.00138867637746099294692 + z * 0.0000243904487962774090654)));
        const int qi = (int)((long long)q & 3);
        const double sv = (qi == 0) ? sp : (qi == 1) ? cp : (qi == 2) ? -sp : -cp;
        const double cv = (qi == 0) ? cp : (qi == 1) ? -sp : (qi == 2) ? -cp : sp;
        COS[i] = (float)cv; SIN[i] = (float)sv;
    }
}
__device__ __forceinline__ void prep_item64(const float* W, int ldw, int srccol0, const float* g, bf16_t* dstrow0, int K, int k0, LAS float* scr, int lane) {
    f32x4 v[16];
    const int kq = lane >> 4, n4 = (lane & 15) * 4;
#pragma unroll
    for (int i = 0; i < 16; ++i) v[i] = __builtin_nontemporal_load((const f32x4*)(W + (size_t)(k0 + 4 * i + kq) * ldw + srccol0 + n4));
#pragma unroll
    for (int i = 0; i < 16; ++i) { const float gg = g ? g[k0 + 4 * i + kq] : 1.f; LAS float* d = scr + (4 * i + kq) * 65 + n4; d[0] = v[i][0] * gg; d[1] = v[i][1] * gg; d[2] = v[i][2] * gg; d[3] = v[i][3] * gg; }
    asm volatile("s_waitcnt lgkmcnt(0)" ::: "memory");
    const int c = lane & 7;
#pragma unroll
    for (int j = 0; j < 8; ++j) { const int n = (lane >> 3) + 8 * j; const LAS float* s = scr + (8 * c) * 65 + n;
        u32x4 o; o.x = pk2(s[0 * 65], s[1 * 65]); o.y = pk2(s[2 * 65], s[3 * 65]); o.z = pk2(s[4 * 65], s[5 * 65]); o.w = pk2(s[6 * 65], s[7 * 65]);
        *(u32x4*)(dstrow0 + (size_t)n * K + k0 + 8 * c) = o; }
    asm volatile("s_waitcnt lgkmcnt(0)" ::: "memory");
}
__device__ __forceinline__ void phase_prep_moe(Frame& F, int l) {
    const Params& P = *F.P;
    LAS float* scr = (LAS float*)(F.lds + F.wave * 16640);
    constexpr int I_G1 = 16 * 8, I_DN = 4 * 16, I_E = I_G1 + I_DN;
    bf16_t* WG1 = wsp<bf16_t>(F, WS_WG1); bf16_t* WD = wsp<bf16_t>(F, WS_WD);
    const int nextra = ((T / 256) * (INP / 256)) % F.G, nlight = F.G - nextra;
    const int slots = (nextra ? nextra : 0) * NWAVES + nlight * NWAVES * (nextra ? 5 : 1);
    const bool light = F.bx >= nextra; const int mult = (light && nextra) ? 5 : 1;
    const int base = light ? nextra * NWAVES + ((F.bx - nextra) * NWAVES + F.wave) * mult : F.bx * NWAVES + F.wave;
    for (int rnd = 0; rnd * slots < NEXP * I_E; ++rnd)
      for (int k = 0; k < mult; ++k) {
        const int it = rnd * slots + base + k; if (it >= NEXP * I_E) break;
        const int e = it / I_E; int r = it % I_E;
        if (r < I_G1) { const int kb = r >> 3, n0 = (r & 7) * 64; const int pn = n0 >> 8, c = n0 & 255;
            const float* W = (c < 128 ? P.in[17] : P.in[18]) + ((size_t)l * NEXP + e) * DM * DEXP; const int src = pn * 128 + (c & 127);
            prep_item64(W, DEXP, src, P.in[12] + l * DM, WG1 + ((size_t)e * 512 + n0) * DM, DM, kb * 64, scr, F.lane); }
        else { r -= I_G1; const int kb = r >> 4, n0 = (r & 15) * 64;
            prep_item64(P.in[19] + ((size_t)l * NEXP + e) * DEXP * DM, DM, n0, nullptr, WD + ((size_t)e * DM + n0) * DEXP, DEXP, kb * 64, scr, F.lane); }
      }
}

__device__ __forceinline__ void phase_norm(Frame& F, const float* hin) {
    bf16_t* HB = wsp<bf16_t>(F, WS_HBI); float* SSQ = wsp<float>(F, WS_SSQ);
    for (int row = F.gw(); row < T; row += F.ngw()) {
        const f32x4* xr = (const f32x4*)(hin + (size_t)row * DM) + F.lane; f32x4 v[4]; float s = 0.f;
#pragma unroll
        for (int j = 0; j < 4; ++j) { v[j] = xr[64 * j]; s += (v[j][0] * v[j][0] + v[j][1] * v[j][1]) + (v[j][2] * v[j][2] + v[j][3] * v[j][3]); }
        s = wave_sum(s);
        u32x2* o = (u32x2*)(HB + (size_t)row * DM) + F.lane;
#pragma unroll
        for (int j = 0; j < 4; ++j) o[64 * j] = (u32x2){pk2(v[j][0], v[j][1]), pk2(v[j][2], v[j][3])};
        if (F.lane < 16) SSQ[(size_t)row * 16 + F.lane] = F.lane == 0 ? s : 0.f;
    }
}
__device__ __forceinline__ void lds_dma16(const void* g, LAS unsigned char* l) {
    unsigned keep; const unsigned dst = (unsigned)__builtin_amdgcn_readfirstlane((int)(unsigned)(uintptr_t)l);
    asm volatile("s_mov_b32 %0, m0\n\ts_mov_b32 m0, %2\n\ts_nop 0\n\tglobal_load_lds_dwordx4 %1, off\n\ts_mov_b32 m0, %0" : "=&s"(keep) : "v"(g), "s"(dst) : "memory"); }
__device__ __forceinline__ void phase_route(Frame& F, int l, bool dummy = false) {
    const Params& P = *F.P; bf16_t* PB = wsp<bf16_t>(F, WS_PB); const float* pl = P.in[1] + (size_t)l * T * DPLE;
    const char* WRT = (const char*)(F.ws + WS_WR) + (size_t)l * 2 * RT_STRIDE;
    const bf16_t* HB = wsp<bf16_t>(F, WS_HB); float* RS = wsp<float>(F, WS_RS);
    unsigned* cnt = wsp<unsigned>(F, WS_CTL) + CW_CNT + 64 * 32 * (dummy ? NLAYER + l : l); int* liste = dummy ? wsp<int>(F, WS_Y) : wsp<int>(F, WS_LISTE); float* listw = dummy ? wsp<float>(F, WS_Y + 4 * MiB) : wsp<float>(F, WS_LISTW);
    const float* brg = P.in[14] + l * 4; const float* bre = P.in[16] + l * 32;
    constexpr int SC_OFF = RT_STRIDE, SC_WAVE = 16 * 49 * 4, RK_OFF = SC_OFF + NWAVES * SC_WAVE;
    LAS unsigned* lcnt = (LAS unsigned*)(F.lds + RK_OFF); LAS unsigned* lbase = lcnt + 32; LAS unsigned* ent = lcnt + 64;
    LAS float* sc = (LAS float*)(F.lds + SC_OFF + F.wave * SC_WAVE);
    const int step = F.ngw(), ri = F.lane & 15, kq = F.lane >> 4;
    for (int pc = F.wave; pc < 73; pc += NWAVES) lds_dma16(WRT + (size_t)pc * 1024 + F.lane * 16, F.lds + pc * 1024);
    if (F.tid < 32) lcnt[F.tid] = 0u;
    int nent = 0;
    for (int row0 = F.gw(); row0 < T; row0 += 16 * step) {
        const int myrow = row0 + ri * step; const bool rv = myrow < T;
        const bf16_t* xr = HB + (size_t)(rv ? myrow : row0) * DM + 8 * kq;
        bf16x8 af[32]; float ssq = 0.f;
#pragma unroll
        for (int sI = 0; sI < 32; ++sI) af[sI] = *(const bf16x8*)(xr + 32 * sI);
        if (rv) {
#pragma unroll
            for (int q = 0; q < 4; ++q) { const float* pp = pl + (size_t)myrow * DPLE + 64 * kq + 16 * q; const f32x4 a = ((const f32x4*)pp)[0], b2 = ((const f32x4*)pp)[1], c2 = ((const f32x4*)pp)[2], d2 = ((const f32x4*)pp)[3];
                u32x4* dst = (u32x4*)(PB + (size_t)myrow * DPLE + 64 * kq + 16 * q); dst[0] = pack8(a, b2); dst[1] = pack8(c2, d2); } }
#pragma unroll
        for (int sI = 0; sI < 32; ++sI) { float f[8]; unpack8(__builtin_bit_cast(u32x4, af[sI]), f);
#pragma unroll
            for (int i = 0; i < 8; ++i) ssq += f[i] * f[i]; }
        ssq += xor16(ssq); ssq += xor32(ssq);
        f32x4 acc[3] = {{0.f, 0.f, 0.f, 0.f}, {0.f, 0.f, 0.f, 0.f}, {0.f, 0.f, 0.f, 0.f}};
#pragma unroll 1
        for (int pass = 0; pass < 2; ++pass) {
            asm volatile("s_waitcnt vmcnt(0)" ::: "memory"); __syncthreads();
            const LAS unsigned char* tb = F.lds + (size_t)ri * (RT_PITCH * 2) + kq * 16;
#pragma unroll
            for (int sI = 0; sI < 32; ++sI) {
#pragma unroll
                for (int blk = 0; blk < 3; ++blk) { const int cb = blk < 2 ? blk * 16 : 20;
                    const bf16x8 bfr = *(const LAS bf16x8*)(tb + (size_t)cb * (RT_PITCH * 2) + sI * 64);
                    acc[blk] = __builtin_amdgcn_mfma_f32_16x16x32_bf16(af[sI], bfr, acc[blk], 0, 0, 0); }
            }
            __syncthreads();
            if (pass == 0) { for (int pc = F.wave; pc < 73; pc += NWAVES) lds_dma16(WRT + RT_STRIDE + (size_t)pc * 1024 + F.lane * 16, F.lds + pc * 1024); }
            else if (row0 + 16 * step < T) { for (int pc = F.wave; pc < 73; pc += NWAVES) lds_dma16(WRT + (size_t)pc * 1024 + F.lane * 16, F.lds + pc * 1024); }
        }
#pragma unroll
        for (int blk = 0; blk < 3; ++blk)
#pragma unroll
            for (int i = 0; i < 4; ++i) sc[(4 * kq + i) * 49 + 16 * blk + ri] = acc[blk][i];
        asm volatile("s_waitcnt lgkmcnt(0)" ::: "memory");
        if (F.lane < 16 && rv) {
            const LAS float* lr = sc + F.lane * 49;
            const float rs = 1.0f / sqrtf(ssq * (1.f / DM) + EPS);
            const float g0 = lr[44] * rs + brg[0], g1 = lr[45] * rs + brg[1], g2 = lr[46] * rs + brg[2], g3 = lr[47] * rs + brg[3];
            int g = 0; float gm = g0; if (g1 > gm) { gm = g1; g = 1; } if (g2 > gm) { gm = g2; g = 2; } if (g3 > gm) { gm = g3; g = 3; }
            const float gp = 1.0f / (fexp2((g0 - gm) * LOG2E) + fexp2((g1 - gm) * LOG2E) + fexp2((g2 - gm) * LOG2E) + fexp2((g3 - gm) * LOG2E));
            float le[8];
#pragma unroll
            for (int q = 0; q < 8; ++q) le[q] = lr[8 * g + q] * rs + bre[8 * g + q];
            int i1 = 0; float l1 = le[0];
#pragma unroll
            for (int j = 1; j < 8; ++j) if (le[j] > l1) { l1 = le[j]; i1 = j; }
            int i2 = (i1 == 0) ? 1 : 0; float l2 = (i1 == 0) ? le[1] : le[0];
#pragma unroll
            for (int j = 1; j < 8; ++j) if (j != i1 && le[j] > l2) { l2 = le[j]; i2 = j; }
            const float e2 = fexp2((l2 - l1) * LOG2E); const float w1 = gp / (1.f + e2), w2 = gp * e2 / (1.f + e2);
            const int ea = g * 8 + i1, eb = g * 8 + i2;
            RS[myrow] = rs;
            if (nent == 0) {
                const unsigned pa = atomicAdd((unsigned*)(lcnt + ea), 1u), pb = atomicAdd((unsigned*)(lcnt + eb), 1u);
                LAS unsigned* en = ent + (size_t)(F.wave * 32 + F.lane * 2) * 4;
                en[0] = (unsigned)ea; en[1] = pa; en[2] = (unsigned)(myrow * 2); en[3] = __float_as_uint(w1);
                en[4] = (unsigned)eb; en[5] = pb; en[6] = (unsigned)(myrow * 2 + 1); en[7] = __float_as_uint(w2);
            } else {
                const unsigned pa = atomicAdd(cnt + 64 * ea, 1u); liste[(size_t)ea * T + pa] = myrow * 2; listw[(size_t)ea * T + pa] = w1;
                const unsigned pb = atomicAdd(cnt + 64 * eb, 1u); liste[(size_t)eb * T + pb] = myrow * 2 + 1; listw[(size_t)eb * T + pb] = w2;
            }
        }
        if (nent == 0) { int nv = 0; for (int r = 0; r < 16; ++r) nv += (row0 + r * step < T) ? 1 : 0; nent = nv > 0 ? nv : 1; }
    }
    asm volatile("s_waitcnt vmcnt(0) lgkmcnt(0)" ::: "memory");
    __syncthreads();
    if (F.tid < 32) lbase[F.tid] = lcnt[F.tid] ? atomicAdd(cnt + 64 * F.tid, lcnt[F.tid]) : 0u;
    __syncthreads();
    { const int r = F.lane >> 1; const bool v = F.lane < 32 && (F.gw() + r * step < T);
      if (v) { const LAS unsigned* en = ent + (size_t)(F.wave * 32 + F.lane) * 4;
          const size_t li = (size_t)en[0] * T + lbase[en[0]] + en[1];
          liste[li] = (int)en[2]; listw[li] = __uint_as_float(en[3]); } }
}
__device__ __forceinline__ void phase_norm2(Frame& F, int l, float ysc) {
    bf16_t* HB = wsp<bf16_t>(F, WS_HB); float* RS = wsp<float>(F, WS_RS); const bf16_t* Y = wsp<bf16_t>(F, WS_Y);
    for (int row = F.gw(); row < T; row += F.ngw()) {
        u32x2* xr = (u32x2*)(HB + (size_t)row * DM) + F.lane; float s = 0.f;
        const u32x2* y0 = (const u32x2*)(Y + (size_t)row * 2 * DM) + F.lane; const u32x2* y1 = y0 + DM / 4;
        u32x2 hw[4], ya[4], yb[4];
#pragma unroll
        for (int j = 0; j < 4; ++j) { hw[j] = xr[64 * j]; ya[j] = y0[64 * j]; yb[j] = y1[64 * j]; }
#pragma unroll
        for (int j = 0; j < 4; ++j) { const u32x2 a = ya[j], b = yb[j];
            float v0 = bf2f(hw[j].x & 0xffffu) + ysc * (bf2f(a.x & 0xffffu) + bf2f(b.x & 0xffffu)), v1 = bf2f(hw[j].x >> 16) + ysc * (bf2f(a.x >> 16) + bf2f(b.x >> 16));
            float v2 = bf2f(hw[j].y & 0xffffu) + ysc * (bf2f(a.y & 0xffffu) + bf2f(b.y & 0xffffu)), v3 = bf2f(hw[j].y >> 16) + ysc * (bf2f(a.y >> 16) + bf2f(b.y >> 16));
            const u32x2 o = (u32x2){pk2(v0, v1), pk2(v2, v3)}; xr[64 * j] = o;
            v0 = bf2f(o.x & 0xffffu); v1 = bf2f(o.x >> 16); v2 = bf2f(o.y & 0xffffu); v3 = bf2f(o.y >> 16);
            s += (v0 * v0 + v1 * v1) + (v2 * v2 + v3 * v3); }
        s = wave_sum(s);
        if (F.lane == 0) RS[row] = 1.0f / sqrtf(s * (1.f / DM) + EPS);
    }
}
__device__ __forceinline__ void phase_final(Frame& F) {
    const Params& P = *F.P; const bf16_t* H = wsp<bf16_t>(F, WS_HBI); const float* g = P.in[23];
    for (int row = F.gw(); row < T; row += F.ngw()) {
        const u32x2* xr = (const u32x2*)(H + (size_t)row * DM) + F.lane; f32x4 v[4]; float s = 0.f;
#pragma unroll
        for (int j = 0; j < 4; ++j) { const u32x2 w = xr[64 * j]; v[j] = (f32x4){bf2f(w.x & 0xffffu), bf2f(w.x >> 16), bf2f(w.y & 0xffffu), bf2f(w.y >> 16)}; s += (v[j][0] * v[j][0] + v[j][1] * v[j][1]) + (v[j][2] * v[j][2] + v[j][3] * v[j][3]); }
        s = wave_sum(s); const float rs = 1.0f / sqrtf(s * (1.f / DM) + EPS);
        f32x4* o = (f32x4*)(P.out + (size_t)row * DM) + F.lane;
#pragma unroll
        for (int j = 0; j < 4; ++j) o[64 * j] = v[j] * rs * ((const f32x4*)g)[F.lane + 64 * j];
    }
}

namespace att {
typedef float f32x16 __attribute__((ext_vector_type(16)));
typedef short s16x4 __attribute__((ext_vector_type(4)));
typedef short v4i16_t __attribute__((ext_vector_type(4)));
typedef __bf16 bf16x2_t __attribute__((ext_vector_type(2)));
constexpr int NS = 6, PF = 5;
constexpr int FLAG_OFF = 131072 + 512;
__device__ __forceinline__ int crow(int r, int hi) { return (r & 3) + 8 * (r >> 2) + 4 * hi; }
__device__ __forceinline__ unsigned cvtpk(float lo, float hi) { f32x2 v = {lo, hi}; bf16x2_t b = __builtin_convertvector(v, bf16x2_t); return __builtin_bit_cast(unsigned, b); }
__device__ __forceinline__ s16x4 vtr(const LAS unsigned char* p) { return __builtin_bit_cast(s16x4, __builtin_amdgcn_ds_read_tr16_b64_v4i16((LAS v4i16_t*)p)); }
__device__ __forceinline__ void dma16(const void* g, LAS unsigned char* l) {
    unsigned keep; const unsigned dst = (unsigned)__builtin_amdgcn_readfirstlane((int)(unsigned)(uintptr_t)l);
    asm volatile("s_mov_b32 %0, m0\n\ts_mov_b32 m0, %2\n\ts_nop 0\n\tglobal_load_lds_dwordx4 %1, off\n\ts_mov_b32 m0, %0" : "=&s"(keep) : "v"(g), "s"(dst) : "memory"); }
__device__ __forceinline__ float vmul(float a, float b) { float r; asm("v_mul_f32 %0, %1, %2" : "=v"(r) : "v"(a), "v"(b)); return r; }
__device__ __forceinline__ float vsub(float a, float b) { float r; asm("v_sub_f32 %0, %1, %2" : "=v"(r) : "v"(a), "v"(b)); return r; }
#define exp2_acc2(a, b, sa, sb) do { float a_ = (a), b_ = (b); \
    asm("v_exp_f32 %0, %0\n\tv_exp_f32 %1, %1\n\tv_add_f32 %2, %2, %0\n\tv_add_f32 %3, %3, %1" : "+v"(a_), "+v"(b_), "+v"(sa), "+v"(sb)); (a) = a_; (b) = b_; } while (0)
#define rcp4_suffix(a, b, c, d) do { float a_ = (a), b_ = (b), c_ = (c), d_ = (d); \
    asm("v_rcp_f32 %3, %3\n\tv_rcp_f32 %2, %2\n\tv_rcp_f32 %1, %1\n\tv_rcp_f32 %0, %0\n\tv_mul_f32 %2, %2, %3\n\tv_mul_f32 %1, %1, %2\n\tv_mul_f32 %0, %0, %1" : "+v"(a_), "+v"(b_), "+v"(c_), "+v"(d_)); \
    (a) = a_; (b) = b_; (c) = c_; (d) = d_; } while (0)
__device__ __forceinline__ float vadd(float a, float b) { float r; asm("v_add_f32 %0, %1, %2" : "=v"(r) : "v"(a), "v"(b)); return r; }
__device__ __forceinline__ float swap32(float x) { auto rr = __builtin_amdgcn_permlane32_swap(__float_as_uint(x), __float_as_uint(x), false, false); return __uint_as_float(((unsigned)(threadIdx.x & 32)) ? rr[0] : rr[1]); }
__device__ __forceinline__ float swap_sel(float a, float b) { auto rr = __builtin_amdgcn_permlane32_swap(__float_as_uint(a), __float_as_uint(b), false, false); return __uint_as_float(((unsigned)(threadIdx.x & 32)) ? rr[0] : rr[1]); }
#define ATT_WAIT_BAR(N) asm volatile("s_waitcnt vmcnt(%0) lgkmcnt(0)\n\ts_barrier" :: "n"(N) : "memory")
__device__ __forceinline__ bf16x8 pfrag(const f32x16& w, int b8) { u32x4 u; u.x = cvtpk(w[b8], w[b8 + 1]); u.y = cvtpk(w[b8 + 2], w[b8 + 3]); u.z = cvtpk(w[b8 + 4], w[b8 + 5]); u.w = cvtpk(w[b8 + 6], w[b8 + 7]); return __builtin_bit_cast(bf16x8, u); }
#define VTR_(dst, OFF) asm volatile("ds_read_b64_tr_b16 %0, %1 offset:" #OFF : "=v"(dst) : "v"(a_))
#define VLD_(i, O0, O1) do { u32x2 lo_, hi_; VTR_(lo_, O0); VTR_(hi_, O1); vf[i] = __builtin_bit_cast(bf16x8, (u32x4){lo_.x, lo_.y, hi_.x, hi_.y}); } while (0)
__device__ __forceinline__ void v_load(bf16x8 (&vf)[8], const LAS unsigned char* vp) {
    const unsigned a_ = (unsigned)(uintptr_t)vp;
    VLD_(0, 0, 512);    VLD_(1, 4096, 4608);
    VLD_(2, 1024, 1536); VLD_(3, 5120, 5632);
    VLD_(4, 2048, 2560); VLD_(5, 6144, 6656);
    VLD_(6, 3072, 3584); VLD_(7, 7168, 7680);
}
#undef VLD_
#undef VTR_
#define V_WAIT(vf) asm volatile("s_waitcnt lgkmcnt(0)" : "+v"(vf[0]), "+v"(vf[1]), "+v"(vf[2]), "+v"(vf[3]), "+v"(vf[4]), "+v"(vf[5]), "+v"(vf[6]), "+v"(vf[7]))
__device__ __forceinline__ void pv_tile(f32x16& o0, f32x16& o1, const bf16x8 (&vf)[8], const f32x16& w0, const f32x16& w1) {
#pragma unroll
    for (int ks = 0; ks < 4; ++ks) {
        const bf16x8 pf = pfrag(ks < 2 ? w0 : w1, 8 * (ks & 1));
        o0 = __builtin_amdgcn_mfma_f32_32x32x16_bf16(vf[2 * ks], pf, o0, 0, 0, 0);
        o1 = __builtin_amdgcn_mfma_f32_32x32x16_bf16(vf[2 * ks + 1], pf, o1, 0, 0, 0);
    }
}
__device__ __forceinline__ void store_o(bf16_t* orow, const f32x16& o0, const f32x16& o1, int hi, float sc, float* oss) {
    float sq = 0.f;
#pragma unroll
    for (int r = 0; r < 16; ++r) sq += o0[r] * o0[r] + o1[r] * o1[r];
    sq = (sq + xor32(sq)) * (sc * sc);
    if (hi == 0) *(GAS float*)oss = sq;
#pragma unroll
    for (int half = 0; half < 2; ++half) {
        const f32x16& o = half ? o1 : o0;
#pragma unroll
        for (int k = 0; k < 4; k += 2) {
            unsigned ax = cvtpk(o[4 * k] * sc, o[4 * k + 1] * sc), ay = cvtpk(o[4 * k + 2] * sc, o[4 * k + 3] * sc);
            unsigned bx = cvtpk(o[4 * k + 4] * sc, o[4 * k + 5] * sc), by = cvtpk(o[4 * k + 6] * sc, o[4 * k + 7] * sc);
            { auto r = __builtin_amdgcn_permlane32_swap(ax, bx, false, false); ax = r[0]; bx = r[1]; }
            { auto r = __builtin_amdgcn_permlane32_swap(ay, by, false, false); ay = r[0]; by = r[1]; }
            *(GAS u32x4*)(orow + 32 * half + 8 * k + 8 * hi) = (u32x4){ax, ay, bx, by};
        }
    }
}

template <bool DIAG> __device__ __forceinline__ void sb_tile(const LAS unsigned char* ks, int vpo, const bf16x8 (&qr)[4], f32x16& o0, f32x16& o1, float& carry, int kb, int q, int r32, int hi) {
    f32x16 z0 = {}, z1 = {};
    bf16x8 kf[8], vf[8];
#pragma unroll
    for (int d0 = 0; d0 < 4; ++d0) { kf[2 * d0] = *(const LAS bf16x8*)(ks + (2 * d0 + hi) * 1024 + r32 * 16); kf[2 * d0 + 1] = *(const LAS bf16x8*)(ks + (2 * d0 + hi) * 1024 + 512 + r32 * 16); }
    __builtin_amdgcn_sched_barrier(0);
#pragma unroll
    for (int d0 = 0; d0 < 4; ++d0) { z0 = __builtin_amdgcn_mfma_f32_32x32x16_bf16(kf[2 * d0], qr[d0], z0, 0, 0, 0); z1 = __builtin_amdgcn_mfma_f32_32x32x16_bf16(kf[2 * d0 + 1], qr[d0], z1, 0, 0, 0); }
    v_load(vf, ks + 8192 + vpo);
    __builtin_amdgcn_sched_barrier(0);
    f32x16 s0, s1;
#pragma unroll
    for (int r = 0; r < 16; ++r) { s0[r] = 1.f + fexp2(z0[r]); s1[r] = 1.f + fexp2(z1[r]); }
    if (DIAG) {
        const int dq = q - kb - 4 * hi;
#pragma unroll
        for (int r = 0; r < 16; ++r) { if (crow(r, 0) >= dq) s0[r] = 1.f; if (32 + crow(r, 0) >= dq) s1[r] = 1.f; }
    }
#pragma unroll
    for (int g = 0; g < 4; ++g) { rcp4_suffix(s0[4 * g], s0[4 * g + 1], s0[4 * g + 2], s0[4 * g + 3]); rcp4_suffix(s1[4 * g], s1[4 * g + 1], s1[4 * g + 2], s1[4 * g + 3]); }
    float I[9]; I[8] = 1.f; I[7] = s1[12];
#pragma unroll
    for (int g = 6; g >= 0; --g) I[g] = vmul(I[g + 1], g < 4 ? s0[4 * g] : s1[4 * (g - 4)]);
    float off[8];
#pragma unroll
    for (int g = 0; g < 8; ++g) {
        const float x = swap_sel(I[g], I[g + 1]);
        off[g] = (g == 7) ? vmul(carry, x) : vmul(vmul(carry, I[g + 1]), x);
    }
    carry = vmul(carry, vmul(I[0], swap32(I[0])));
    f32x16 w0, w1;
#pragma unroll
    for (int g = 0; g < 4; ++g) {
        { const float o = off[g]; const float S3 = vmul(s0[4 * g + 3], o), S2 = vmul(s0[4 * g + 2], o), S1 = vmul(s0[4 * g + 1], o), S0 = vmul(s0[4 * g], o);
          w0[4 * g + 3] = vsub(o, S3); w0[4 * g + 2] = vsub(S3, S2); w0[4 * g + 1] = vsub(S2, S1); w0[4 * g] = vsub(S1, S0); }
        { const float o = off[4 + g]; const float S3 = vmul(s1[4 * g + 3], o), S2 = vmul(s1[4 * g + 2], o), S1 = vmul(s1[4 * g + 1], o), S0 = vmul(s1[4 * g], o);
          w1[4 * g + 3] = vsub(o, S3); w1[4 * g + 2] = vsub(S3, S2); w1[4 * g + 1] = vsub(S2, S1); w1[4 * g] = vsub(S1, S0); }
    }
    V_WAIT(vf);
    pv_tile(o0, o1, vf, w0, w1);
}
__device__ __forceinline__ void sb_unit(LAS unsigned char* lds, int tid, const bf16_t* QKV, bf16_t* OA, float* OSS, int b, int h, int qb) {
    asm volatile("" : "+v"(tid));
    const int lane = tid & 63, r32 = lane & 31, hi = lane >> 5, wid = __builtin_amdgcn_readfirstlane(tid >> 6);
    const size_t rowb = (size_t)b * SEQ; const int q0 = qb * 256;
    const bf16_t* Qw = QKV + (rowb + q0 + wid * 32) * 1536 + h * 64;
    const bf16_t* Kh = QKV + rowb * 1536 + 512 + h * 64; const bf16_t* Vh = Kh + 512;
    const int kt_hi = (q0 >> 6) + 3, NT = kt_hi + 1, jd = 3 - (wid >> 1);
    const bf16_t* ksrc = Kh + (size_t)lane * 1536 + wid * 8;
    const bf16_t* vsrc = Vh + (size_t)(16 * (wid & 3) + (lane >> 2)) * 1536 + (wid >> 2) * 32 + (lane & 3) * 8;
#define SB_ISSUE(j) do { int kt_ = kt_hi - (j); kt_ = kt_ < 0 ? 0 : kt_; LAS unsigned char* sl_ = lds + ((j) % NS) * 16384 + wid * 1024; \
        dma16(ksrc + (size_t)kt_ * 64 * 1536, sl_); dma16(vsrc + (size_t)kt_ * 64 * 1536, sl_ + 8192); } while (0)
    bf16x8 qr[4];
#pragma unroll
    for (int d0 = 0; d0 < 4; ++d0) qr[d0] = *(const GAS bf16x8*)(Qw + (size_t)r32 * 1536 + d0 * 16 + hi * 8);
#pragma unroll
    for (int j = 0; j < PF; ++j) SB_ISSUE(j);
    asm volatile("" : "+v"(qr[0]), "+v"(qr[1]), "+v"(qr[2]), "+v"(qr[3]));
    f32x16 o0 = {}, o1 = {}; float carry = 1.f; bool mydone = false;
    const int q = q0 + wid * 32 + r32;
    volatile LAS unsigned* flags = (volatile LAS unsigned*)(lds + FLAG_OFF);
    const int vpo = ((lane >> 4) & 1) * 32 + (lane & 3) * 8 + (4 * hi + ((lane & 15) >> 2)) * 64;
    for (int j = 0; j < NT; ++j) {
        ATT_WAIT_BAR(2);
        if (j >= 1) { const u32x4 fa = *(const LAS u32x4*)(lds + FLAG_OFF + ((j - 1) & 1) * 32), fb = *(const LAS u32x4*)(lds + FLAG_OFF + ((j - 1) & 1) * 32 + 16);
            if ((fa.x & fa.y & fa.z & fa.w & fb.x & fb.y & fb.z & fb.w) != 0u) break; }
        SB_ISSUE(j + PF);
        const int tj = j + jd;
        if (tj < NT && !mydone) {
            const LAS unsigned char* ks = lds + (tj % NS) * 16384; const int kb = (kt_hi - tj) * 64;
            if (j == 0) sb_tile<true>(ks, vpo, qr, o0, o1, carry, kb, q, r32, hi); else sb_tile<false>(ks, vpo, qr, o0, o1, carry, kb, q, r32, hi);
        }
        mydone = __all(carry < 1.17549435e-38f) || (tj + 1 >= NT);
        if (lane == 0) flags[(j & 1) * 8 + wid] = mydone ? 1u : 0u;
    }
    store_o(OA + (rowb + q) * DM + h * 64, o0, o1, hi, 1.f, OSS + (rowb + q) * 16 + h);
    asm volatile("s_waitcnt lgkmcnt(0)\n\ts_barrier" ::: "memory");
#undef SB_ISSUE
}

__device__ __forceinline__ void mla_kload(bf16x8 (&kf)[12], const LAS unsigned char* ks, int r32, int hi, int g) {
#pragma unroll
    for (int i = 0; i < 2; ++i) { const int d0 = 2 * g + i; kf[2 * d0] = *(const LAS bf16x8*)(ks + (2 * d0 + hi) * 1024 + r32 * 16); kf[2 * d0 + 1] = *(const LAS bf16x8*)(ks + (2 * d0 + hi) * 1024 + 512 + r32 * 16); }
}
struct AU { int b, h, qb; };
constexpr int MLA_SLOT = 20480;
__device__ __forceinline__ void mla_issue(LAS unsigned char* lds, int wid, const bf16_t* ksrc, const bf16_t* rsrc, const bf16_t* vsrc, int kt) {
    LAS unsigned char* sl_ = lds + (kt % NS) * MLA_SLOT;
    dma16(ksrc + (size_t)kt * 64 * 512, sl_ + wid * 1024); if (wid < 4) dma16(rsrc + (size_t)kt * 64 * 32, sl_ + (8 + wid) * 1024);
    dma16(vsrc + (size_t)kt * 64 * 512, sl_ + 12288 + wid * 1024);
}
#define MLA_ADDR(u) const int lane = tid & 63, r32 = lane & 31, hi = lane >> 5, wid = __builtin_amdgcn_readfirstlane(tid >> 6); \
    const size_t rowb = (size_t)(u).b * SEQ; const int q0 = (u).qb * 256, h = (u).h; \
    const int NT = (q0 >> 6) + 4; \
    const bf16_t* ksrc = KN + (rowb + lane) * 512 + h * 64 + wid * 8; \
    const bf16_t* rsrc = KR + (rowb + lane) * 32 + (wid & 3) * 8; \
    const bf16_t* vsrc = VM + (rowb + 16 * (wid & 3) + (lane >> 2)) * 512 + h * 64 + (wid >> 2) * 32 + (lane & 3) * 8;
__device__ __forceinline__ void mla_prologue(LAS unsigned char* lds, int tid, const bf16_t* QM, const bf16_t* KN, const bf16_t* KR, const bf16_t* VM, AU u, bf16x8 (&qr)[6]) {
    asm volatile("" : "+v"(tid));
    MLA_ADDR(u)
    const bf16_t* Qw = QM + (rowb + q0 + wid * 32) * 768 + h * 96;
#pragma unroll
    for (int d0 = 0; d0 < 6; ++d0) qr[d0] = *(const GAS bf16x8*)(Qw + (size_t)r32 * 768 + d0 * 16 + hi * 8);
#pragma unroll
    for (int j = 0; j < 5; ++j) if (j < NT) mla_issue(lds, wid, ksrc, rsrc, vsrc, j);
}
__device__ __forceinline__ void mla_unit(LAS unsigned char* lds, int tid, const bf16_t* QM, const bf16_t* KN, const bf16_t* KR, const bf16_t* VM, bf16_t* OA, float* OSS, AU u, bool has_next, AU nx, bf16x8 (&qr)[6]) {
    asm volatile("" : "+v"(tid));
    MLA_ADDR(u)
    const int mych = (q0 >> 6) + (wid >> 1);
    constexpr int SLOT = MLA_SLOT;
#define MLA_ISSUE(j) mla_issue(lds, wid, ksrc, rsrc, vsrc, (j))
#define MLA_WAITN(n) do { if (wid < 4) ATT_WAIT_BAR(3 * (n)); else ATT_WAIT_BAR(2 * (n)); } while (0)
#define MLA_WAIT_DYN(nf) do { const int nf_ = (nf); if (nf_ >= 3) MLA_WAITN(3); else if (nf_ == 2) MLA_WAITN(2); else if (nf_ == 1) MLA_WAITN(1); else MLA_WAITN(0); } while (0)
    asm volatile("s_waitcnt vmcnt(0)" : "+v"(qr[0]), "+v"(qr[1]), "+v"(qr[2]), "+v"(qr[3]), "+v"(qr[4]), "+v"(qr[5]));
    f32x16 o0 = {}, o1 = {}, negm = {}; float mref = 0.f, lsum = 0.f;
    const int vpo = ((lane >> 4) & 1) * 32 + (lane & 3) * 8 + (4 * hi + ((lane & 15) >> 2)) * 64;
    MLA_WAIT_DYN((NT < 5 ? NT - 1 : 4) - 1);
    if (5 < NT) MLA_ISSUE(5);
    bf16x8 kf[12];
    mla_kload(kf, lds, r32, hi, 0); mla_kload(kf, lds, r32, hi, 1); mla_kload(kf, lds, r32, hi, 2);
    for (int j = 0; j < NT; ++j) {
        const LAS unsigned char* sl = lds + (j % NS) * SLOT; const LAS unsigned char* sn = lds + ((j + 1) % NS) * SLOT;
        if (j <= mych) {
            f32x16 z0, z1;
            z0 = __builtin_amdgcn_mfma_f32_32x32x16_bf16(kf[0], qr[0], negm, 0, 0, 0); z1 = __builtin_amdgcn_mfma_f32_32x32x16_bf16(kf[1], qr[0], negm, 0, 0, 0);
#pragma unroll
            for (int d0 = 1; d0 < 6; ++d0) { z0 = __builtin_amdgcn_mfma_f32_32x32x16_bf16(kf[2 * d0], qr[d0], z0, 0, 0, 0); z1 = __builtin_amdgcn_mfma_f32_32x32x16_bf16(kf[2 * d0 + 1], qr[d0], z1, 0, 0, 0); }
            bf16x8 vf[8];
            v_load(vf, sl + 12288 + vpo);
            __builtin_amdgcn_sched_barrier(0);
#define MLA_MOVE_REF(FIRST) do { float tm = fmaxf(z0[0], z1[0]); _Pragma("unroll") for (int r = 1; r < 16; ++r) tm = fmaxf(tm, fmaxf(z0[r], z1[r])); tm = fmaxf(tm, swap32(tm)); \
                const float dl = (FIRST) ? tm : fmaxf(tm, 0.f); mref += dl; const float al = fexp2(-dl); lsum *= al; \
                _Pragma("unroll") for (int r = 0; r < 16; ++r) { z0[r] -= dl; z1[r] -= dl; negm[r] = -mref; o0[r] *= al; o1[r] *= al; } } while (0)
            if (j == 0) MLA_MOVE_REF(true);
            float ps = 0.f, pb = 0.f;
            asm volatile("s_nop 15\n\ts_nop 7" : "+v"(z0), "+v"(z1));
#pragma unroll
            for (int r = 0; r < 16; ++r) exp2_acc2(z0[r], z1[r], ps, pb);
            ps += pb;
            if (__builtin_expect(__any(!(ps < 1.8446744e19f)), 0)) {
                z0 = __builtin_amdgcn_mfma_f32_32x32x16_bf16(kf[0], qr[0], negm, 0, 0, 0); z1 = __builtin_amdgcn_mfma_f32_32x32x16_bf16(kf[1], qr[0], negm, 0, 0, 0);
#pragma unroll
                for (int d0 = 1; d0 < 6; ++d0) { z0 = __builtin_amdgcn_mfma_f32_32x32x16_bf16(kf[2 * d0], qr[d0], z0, 0, 0, 0); z1 = __builtin_amdgcn_mfma_f32_32x32x16_bf16(kf[2 * d0 + 1], qr[d0], z1, 0, 0, 0); }
                MLA_MOVE_REF(false);
                ps = 0.f;
#pragma unroll
                for (int r = 0; r < 16; ++r) { z0[r] = fexp2(z0[r]); z1[r] = fexp2(z1[r]); ps += z0[r] + z1[r]; }
            }
#undef MLA_MOVE_REF
            lsum += ps;
            __builtin_amdgcn_sched_barrier(0);
            V_WAIT(vf);
#pragma unroll
            for (int ks2 = 0; ks2 < 4; ++ks2) {
                const bf16x8 pf = pfrag(ks2 < 2 ? z0 : z1, 8 * (ks2 & 1));
                o0 = __builtin_amdgcn_mfma_f32_32x32x16_bf16(vf[2 * ks2], pf, o0, 0, 0, 0);
                o1 = __builtin_amdgcn_mfma_f32_32x32x16_bf16(vf[2 * ks2 + 1], pf, o1, 0, 0, 0);
                if (ks2 < 3) mla_kload(kf, sn, r32, hi, ks2);
                __builtin_amdgcn_sched_barrier(0);
            }
        } else if (j + 1 <= mych) {   }
        { const int im = (j + 5 < NT - 1) ? j + 5 : NT - 1; MLA_WAIT_DYN(im - (j + 2)); }
        if (j + 6 < NT) MLA_ISSUE(j + 6);
    }
    lsum += swap32(lsum);
    bf16_t* orow = OA + (rowb + q0 + wid * 32 + r32) * DM + 512 + h * 64; float* oss = OSS + (rowb + q0 + wid * 32 + r32) * 16 + 8 + h; const int hi2 = hi;
    store_o(orow, o0, o1, hi2, 1.0f / lsum, oss);
    asm volatile("s_waitcnt lgkmcnt(0)\n\ts_barrier" ::: "memory");
    if (has_next) mla_prologue(lds, tid, QM, KN, KR, VM, nx, qr);
#undef MLA_ISSUE
#undef MLA_WAITN
#undef MLA_WAIT_DYN
}
}

__device__ __forceinline__ void phase_attn(Frame& F) {
    const bf16_t* QKV = wsp<bf16_t>(F, WS_QKV); bf16_t* OA = wsp<bf16_t>(F, WS_OA); float* OSS = wsp<float>(F, WS_OSS);
    const bf16_t* QM = wsp<bf16_t>(F, WS_QM); const bf16_t* KN = wsp<bf16_t>(F, WS_KN); const bf16_t* KR = wsp<bf16_t>(F, WS_KR); const bf16_t* VM = wsp<bf16_t>(F, WS_VM);
    const int vcu = (F.G % 8 == 0) ? (F.bx % 8) * (F.G / 8) + F.bx / 8 : F.bx;
    { const int nu = vcu < 512 ? 2 * ((512 - vcu + F.G - 1) / F.G) : 0;
      auto unit = [&](int i) { const int p = vcu + (i >> 1) * F.G, bh = p >> 3, s = p & 7; return att::AU{bh >> 3, bh & 7, (i & 1) ? s : 15 - s}; };
      if (nu > 0) {
          bf16x8 qr[6];
          att::mla_prologue(F.lds, F.tid, QM, KN, KR, VM, unit(0), qr);
#pragma unroll 1
          for (int i = 0; i < nu; ++i) att::mla_unit(F.lds, F.tid, QM, KN, KR, VM, OA, OSS, unit(i), i + 1 < nu, unit(i + 1 < nu ? i + 1 : i), qr);
      } }
    for (int u = vcu; u < 1024; u += F.G) { const int bh = u >> 4; att::sb_unit(F.lds, F.tid, QKV, OA, OSS, bh >> 3, bh & 7, u & 15); }
}

__device__ __forceinline__ DenseSched dense_sched(const Frame& F, int N, const void* Bt, int K) { DenseSched S; S.o.init(T, N, F.G, F.bx); S.Bt = (const char*)Bt; S.K = K; return S; }
__device__ __forceinline__ void phase_inproj(Frame& F, int l) {
    const DenseSched S = dense_sched(F, INP, F.ws + WS_WSM + (size_t)l * WSM_STRIDE + WSM_IN, DM);
    const EpiIn E{wsp<float>(F, WS_SSQ), wsp<bf16_t>(F, WS_QKV), wsp<bf16_t>(F, WS_CKV), wsp<bf16_t>(F, WS_CQ), wsp<bf16_t>(F, WS_KR), wsp<float>(F, WS_COS), wsp<float>(F, WS_SIN), wsp<float>(F, WS_RSCQ), wsp<float>(F, WS_RSCKV)};
    pg8::gemm_phase(F.lds, F.tid, (const char*)(F.ws + WS_HBI), DM, S, E);
}
__device__ __forceinline__ void phase_uq(Frame& F, int l, int Gp, int cp) {
    DenseSched S; S.o.init(T, 768, Gp, cp); S.Bt = (const char*)(F.ws + WS_WSM + (size_t)l * WSM_STRIDE + WSM_UQ); S.K = QRANK;
    const EpiUq E{wsp<float>(F, WS_RSCQ), wsp<bf16_t>(F, WS_QM), wsp<float>(F, WS_COS), wsp<float>(F, WS_SIN)};
    pg8::gemm_phase(F.lds, F.tid, (const char*)(F.ws + WS_CQ), QRANK, S, E);
}
__device__ __forceinline__ void phase_ukv(Frame& F, int l, int Gp, int cp) {
    DenseSched S; S.o.init(T, 1024, Gp, cp); S.Bt = (const char*)(F.ws + WS_WSM + (size_t)l * WSM_STRIDE + WSM_UKV); S.K = KVRANK;
    const EpiUkv E{wsp<float>(F, WS_RSCKV), wsp<bf16_t>(F, WS_KN), wsp<bf16_t>(F, WS_VM)};
    pg8::gemm_phase(F.lds, F.tid, (const char*)(F.ws + WS_CKV), KVRANK, S, E);
}
__device__ __forceinline__ void phase_outproj(Frame& F, int l) {
    const DenseSched S = dense_sched(F, DM, F.ws + WS_WSM + (size_t)l * WSM_STRIDE + WSM_OUT, DM);
    EpiOut E; E.xin = l == 0 ? F.P->in[0] : nullptr; E.hin = wsp<bf16_t>(F, WS_HBI); E.hout = wsp<bf16_t>(F, WS_HB); E.OSS = wsp<float>(F, WS_OSS);
    pg8::gemm_phase(F.lds, F.tid, (const char*)(F.ws + WS_OA), DM, S, E);
}
__device__ __forceinline__ void moe_table(Frame& F, int l) {
    LAS int* tb = (LAS int*)(F.lds + pg8::STAGE_BYTES);
    __syncthreads();
    if (F.tid == 0) { const unsigned* cnt = wsp<unsigned>(F, WS_CTL) + CW_CNT + 64 * 32 * l; int acc = 0;
        for (int e = 0; e < NEXP; ++e) { const int c = (int)__hip_atomic_load(cnt + 64 * e, __ATOMIC_RELAXED, __HIP_MEMORY_SCOPE_AGENT); tb[e] = acc; tb[40 + e] = c; acc += (c + 255) >> 8; }
        tb[32] = acc; }
    __syncthreads();
}
__device__ __forceinline__ void phase_moe1(Frame& F, int l) {
    moe_table(F, l);
    MoeSched S; S.G = F.G; S.c = F.bx; S.npn = 2; S.gather = 1; S.tb = (const LAS int*)(F.lds + pg8::STAGE_BYTES); S.liste = wsp<int>(F, WS_LISTE); S.Bt = (const char*)(F.ws + WS_WG1); S.K = DM; S.nB = 512;
    const EpiG1 E{wsp<float>(F, WS_RS), wsp<int>(F, WS_LISTE), wsp<bf16_t>(F, WS_HID)};
    pg8::gemm_phase(F.lds, F.tid, (const char*)(F.ws + WS_HB), DM, S, E);
}
__device__ __forceinline__ void phase_moe2(Frame& F, int l) {
    moe_table(F, l);
    MoeSched S; S.G = F.G; S.c = F.bx; S.npn = 4; S.gather = 0; S.tb = (const LAS int*)(F.lds + pg8::STAGE_BYTES); S.liste = wsp<int>(F, WS_LISTE); S.Bt = (const char*)(F.ws + WS_WD); S.K = DEXP; S.nB = 1024;
    const EpiDn E{wsp<int>(F, WS_LISTE), wsp<float>(F, WS_LISTW), wsp<bf16_t>(F, WS_Y)};
    pg8::gemm_phase(F.lds, F.tid, (const char*)(F.ws + WS_HID), DEXP, S, E);
}
__device__ __forceinline__ void phase_pe(Frame& F, int l) {
    if ((F.G & 7) != 0 || F.G < 128) { const DenseSched S = dense_sched(F, DM, F.ws + WS_WSM + (size_t)l * WSM_STRIDE + WSM_PE, DPLE); const EpiBf E{wsp<bf16_t>(F, WS_PE), DM}; pg8::gemm_phase(F.lds, F.tid, (const char*)(F.ws + WS_PB), DPLE, S, E); return; }
    const int rank = F.bx >> 3; if (rank < 8) return;
    DenseSched S; S.o.init(T, DM, F.G - 64, (F.bx & 7) + 8 * (rank - 8)); S.Bt = (const char*)(F.ws + WS_WSM + (size_t)l * WSM_STRIDE + WSM_PE); S.K = DPLE;
    const EpiBf E{wsp<bf16_t>(F, WS_PE), DM};
    pg8::gemm_phase(F.lds, F.tid, (const char*)(F.ws + WS_PB), DPLE, S, E);
}
__device__ __forceinline__ void phase_ple(Frame& F, int l) {
    const DenseSched S = dense_sched(F, DM, F.ws + WS_WSM + (size_t)l * WSM_STRIDE + WSM_PG, DM);
    const EpiPle E{wsp<float>(F, WS_RS), wsp<bf16_t>(F, WS_PE), wsp<bf16_t>(F, WS_HB), wsp<bf16_t>(F, WS_HBI), wsp<float>(F, WS_SSQ)};
    pg8::gemm_phase(F.lds, F.tid, (const char*)(F.ws + WS_HB), DM, S, E);
}

#ifndef PROBE
#define PROBE 0
#endif
constexpr int CW_BAR = 4096;
constexpr int MISC_OFF = 150 * 1024;
static_assert(CW_BAR + XCD_BAR_WORDS <= CW_CNT && (CW_CNT + 64 * 32 * 2 * NLAYER) * 4 <= (int)CTL_BYTES && (CW_BAR + XCD_BAR_WORDS) * 4 <= (int)CTL_BYTES && MISC_OFF + 16 <= LDS_BYTES, "control words");
__global__ void __launch_bounds__(NTHREADS, 2) mega_fwd(Params P) {
    extern __shared__ __attribute__((aligned(16))) unsigned char lds_raw[];
    Frame F; F.lds = (LAS unsigned char*)lds_raw; F.tid = threadIdx.x; F.lane = F.tid & 63; F.wave = __builtin_amdgcn_readfirstlane(F.tid >> 6); F.G = gridDim.x; F.bx = blockIdx.x; F.P = &P; F.ws = P.ws;
    volatile LAS unsigned* st = (volatile LAS unsigned*)(F.lds + MISC_OFF);
    if (F.tid < 4) st[F.tid] = 0u;
    __syncthreads();
    const XcdBarrier bar = xcd_barrier_post(wsp<unsigned>(F, WS_CTL) + CW_BAR, st);
#define GRID_BAR() do { XcdBarrier b_ = bar; asm volatile("" : "+s"(b_.x)); asm volatile("" : "+s"(b_.bar)); xcd_barrier(b_); PH_BEGIN(); } while (0)
#define PH_BEGIN() do { asm volatile("" : "+v"(F.tid)); F.lane = F.tid & 63; asm volatile("" : "+s"(F.ws)); } while (0)
    phase_prep_small(F);
    phase_norm(F, P.in[0]);
#if PROBE == 11
    __syncthreads(); PH_BEGIN(); phase_prep_small(F); phase_norm(F, P.in[0]);
#endif
    GRID_BAR();
#if PROBE == 13
    GRID_BAR(); GRID_BAR(); GRID_BAR(); GRID_BAR(); GRID_BAR(); GRID_BAR(); GRID_BAR(); GRID_BAR(); GRID_BAR(); GRID_BAR();
    GRID_BAR(); GRID_BAR(); GRID_BAR(); GRID_BAR(); GRID_BAR(); GRID_BAR(); GRID_BAR(); GRID_BAR(); GRID_BAR(); GRID_BAR();
#endif
#ifndef TPROBE
#define TPROBE 0
#endif
#define TPH(id, ...) do { unsigned long long t0_ = 0; if (TPROBE == (id)) t0_ = __builtin_amdgcn_s_memrealtime(); __VA_ARGS__; GRID_BAR(); \
        if (TPROBE == (id)) { const unsigned long long t1_ = __builtin_amdgcn_s_memrealtime(); while (__builtin_amdgcn_s_memrealtime() - t1_ < 4ull * (t1_ - t0_)) __builtin_amdgcn_s_sleep(8); GRID_BAR(); } } while (0)
#pragma unroll 1
    for (int l = 0; l < NLAYER; ++l) {
        PH_BEGIN();
        TPH(1, phase_inproj(F, l); PH_BEGIN(); phase_prep_moe(F, l));
        { const bool split = (F.G & 15) == 0; const int Gp = split ? F.G / 2 : F.G;
          TPH(2, if (!split || F.bx < Gp) phase_uq(F, l, Gp, F.bx); PH_BEGIN(); if (!split || F.bx >= Gp) phase_ukv(F, l, Gp, split ? F.bx - Gp : F.bx)); }
        TPH(3, phase_attn(F));
        TPH(4, phase_outproj(F, l));
        TPH(5, phase_route(F, l));
        TPH(6, phase_moe1(F, l); PH_BEGIN(); phase_pe(F, l));
        TPH(7, phase_moe2(F, l));
        TPH(8, phase_norm2(F, l, 1.f));
        TPH(9, phase_ple(F, l));
    }
    phase_final(F);
#undef TPH
#undef GRID_BAR
#undef PH_BEGIN
}

extern "C" void kernel_launch(void* const* d_in, const int* in_sizes, int n_in, void* d_out, int out_size, void* d_ws, size_t ws_size, hipStream_t stream) {
    if (n_in != 24 || out_size != T * DM || ws_size < WS_END) { fprintf(stderr, "kernel_launch: unexpected shapes (n_in %d, out %d, ws %zu < %zu)\n", n_in, out_size, ws_size, (size_t)WS_END); return; }
    Params P{};
    for (int i = 0; i < 24; ++i) P.in[i] = (const float*)d_in[i];
    P.out = (float*)d_out; P.ws = (unsigned char*)d_ws;
    for (int i = 0; i < 16; ++i) P.inv_freq[i] = (float)pow(10000.0, -(double)i / 16.0);
    (void)hipMemsetAsync((char*)d_ws + WS_CTL, 0, CTL_BYTES, stream);
    static int grid = 0;
    if (grid == 0) {
        int dev = 0, cus = 0;
        if (hipGetDevice(&dev) != hipSuccess || hipDeviceGetAttribute(&cus, hipDeviceAttributeMultiprocessorCount, dev) != hipSuccess || cus <= 0) { grid = -1; return; }
        if (hipFuncSetAttribute((const void*)mega_fwd, hipFuncAttributeMaxDynamicSharedMemorySize, LDS_BYTES) != hipSuccess) { fprintf(stderr, "kernel_launch: hipFuncSetAttribute failed\n"); grid = -1; return; }
        grid = cus;
    }
    if (grid < 0) return;
    hipLaunchKernelGGL(mega_fwd, dim3(grid), dim3(NTHREADS), LDS_BYTES, stream, P);
}
```

```cpp
#include <hip/hip_runtime.h>
#include <cstdio>
#include <cstdint>
#include <cmath>

#define GAS __attribute__((address_space(1)))
#define LAS __attribute__((address_space(3)))
#define GAS __attribute__((address_space(1)))
typedef unsigned short bf16_t;
typedef short bf16x8 __attribute__((ext_vector_type(8)));
typedef float f32x4 __attribute__((ext_vector_type(4)));
typedef float f32x2 __attribute__((ext_vector_type(2)));
typedef unsigned u32x4 __attribute__((ext_vector_type(4)));
typedef unsigned u32x2 __attribute__((ext_vector_type(2)));

constexpr int NB = 8, SEQ = 4096, DM = 1024, NLAYER = 4, T = NB * SEQ;
constexpr int DPLE = 256, SBW = 512, MLAW = 512, QRANK = 384, KVRANK = 256, ROPE = 32, QKD = 96;
constexpr int INC = 2208, INP = 2304;
constexpr int NEXP = 32, DEXP = 256;
constexpr float EPS = 1e-6f;
constexpr float LOG2E = 1.4426950408889634f;
constexpr float QS_SB = 0.125f * LOG2E;
constexpr float QS_MLA = 0.10206207261596575f * LOG2E;
constexpr int NWAVES = 8, NTHREADS = 512;

constexpr size_t MiB = 1u << 20;
constexpr size_t WS_CTL = 0, CTL_BYTES = 1 * MiB;
constexpr size_t WS_COS = 1 * MiB, WS_SIN = 3 * MiB;
constexpr size_t WS_RS = 5 * MiB, WS_RSCQ = 6 * MiB, WS_RSCKV = 7 * MiB;
constexpr size_t WS_LISTE = 8 * MiB, WS_LISTW = 12 * MiB;
constexpr size_t WS_WR = 16 * MiB;
constexpr int RT_PITCH = 1032, RT_STRIDE = 73 * 1024;
constexpr size_t WS_WSM = 18 * MiB, WSM_STRIDE = 11 * MiB;
constexpr size_t WSM_IN = 0, WSM_OUT = 4608 * 1024, WSM_PG = WSM_OUT + 2 * MiB, WSM_UQ = WSM_PG + 2 * MiB, WSM_UKV = WSM_UQ + 576 * 1024, WSM_PE = WSM_UKV + 512 * 1024;
constexpr size_t WS_WG1 = 62 * MiB, WS_WD = 94 * MiB;
constexpr size_t WS_H32 = 110 * MiB, WS_HB = 238 * MiB;
constexpr size_t WS_ATT = 302 * MiB;
constexpr size_t WS_QKV = WS_ATT, WS_CKV = WS_ATT + 96 * MiB, WS_CQ = WS_CKV + 16 * MiB, WS_KR = WS_CQ + 24 * MiB, WS_QM = WS_KR + 2 * MiB,
                 WS_KN = WS_QM + 48 * MiB, WS_VM = WS_KN + 32 * MiB, WS_OA = WS_VM + 32 * MiB, WS_ATT_END = WS_OA + 64 * MiB;
constexpr size_t WS_HBI = WS_H32;
constexpr size_t WS_HID = WS_ATT, WS_Y = WS_ATT + 36 * MiB, WS_MOE_END = WS_Y + 128 * MiB;
constexpr size_t WS_SSQ = (WS_ATT_END > WS_MOE_END ? WS_ATT_END : WS_MOE_END), WS_OSS = WS_SSQ + 2 * MiB, WS_PE = WS_OSS + 2 * MiB, WS_PB = WS_PE + 64 * MiB, WS_END = WS_PB + 16 * MiB;
static_assert(WSM_PE + 512 * 1024 <= WSM_STRIDE, "small weights");
static_assert(WS_WSM + 4 * WSM_STRIDE <= WS_WG1, "ws map");
constexpr int CW_CNT = 8192;

constexpr int LDS_BYTES = 152 * 1024;

struct Params {
    const float* in[24];
    float* out;
    unsigned char* ws;
    float inv_freq[16];
};

__device__ __forceinline__ float bf2f(unsigned v) { return __uint_as_float(v << 16); }
__device__ __forceinline__ unsigned f2bf(float f) { unsigned u = __float_as_uint(f); return (u + 0x7fffu + ((u >> 16) & 1u)) >> 16; }
typedef float f32x2_cv_ __attribute__((ext_vector_type(2)));
typedef __bf16 bf16x2_cv_ __attribute__((ext_vector_type(2)));
__device__ __forceinline__ unsigned pk2(float lo, float hi) { f32x2_cv_ v = {lo, hi}; return __builtin_bit_cast(unsigned, __builtin_convertvector(v, bf16x2_cv_)); }
template <int CTRL> __device__ __forceinline__ float dpp_f(float v) { return __uint_as_float((unsigned)__builtin_amdgcn_update_dpp(0, (int)__float_as_uint(v), CTRL, 0xf, 0xf, true)); }
__device__ __forceinline__ float row16_sum(float v) {
    v += dpp_f<0xB1>(v); v += dpp_f<0x4E>(v); v += dpp_f<0x141>(v); v += dpp_f<0x140>(v); return v; }
__device__ __forceinline__ float wave_sum(float v) {
    v = row16_sum(v);
    const float a = __uint_as_float(__builtin_amdgcn_readlane((int)__float_as_uint(v), 0)), b = __uint_as_float(__builtin_amdgcn_readlane((int)__float_as_uint(v), 16)),
                c = __uint_as_float(__builtin_amdgcn_readlane((int)__float_as_uint(v), 32)), d = __uint_as_float(__builtin_amdgcn_readlane((int)__float_as_uint(v), 48));
    return (a + b) + (c + d);
}
__device__ __forceinline__ float half32_sum(float v) {
    v = row16_sum(v);
    auto rr = __builtin_amdgcn_permlane16_swap(__float_as_uint(v), __float_as_uint(v), false, false);
    return __uint_as_float(rr[0]) + __uint_as_float(rr[1]);
}
__device__ __forceinline__ float xor32(float x) { auto rr = __builtin_amdgcn_permlane32_swap(__float_as_uint(x), __float_as_uint(x), false, false); return __uint_as_float(((unsigned)(threadIdx.x & 32)) ? rr[0] : rr[1]); }
__device__ __forceinline__ float xor16(float x) { auto rr = __builtin_amdgcn_permlane16_swap(__float_as_uint(x), __float_as_uint(x), false, false); return __uint_as_float(((unsigned)(threadIdx.x & 16)) ? rr[0] : rr[1]); }
__device__ __forceinline__ float fexp2(float x) { return __builtin_amdgcn_exp2f(x); }
__device__ __forceinline__ float flog2(float x) { return __builtin_amdgcn_logf(x); }
__device__ __forceinline__ float frcp(float x) { return __builtin_amdgcn_rcpf(x); }
__device__ __forceinline__ void unpack8(u32x4 w, float* f) {
    f[0] = __uint_as_float(w.x << 16); f[1] = __uint_as_float(w.x & 0xffff0000u);
    f[2] = __uint_as_float(w.y << 16); f[3] = __uint_as_float(w.y & 0xffff0000u);
    f[4] = __uint_as_float(w.z << 16); f[5] = __uint_as_float(w.z & 0xffff0000u);
    f[6] = __uint_as_float(w.w << 16); f[7] = __uint_as_float(w.w & 0xffff0000u);
}
__device__ __forceinline__ u32x4 pack8(f32x4 a, f32x4 b) { u32x4 w; w.x = pk2(a[0], a[1]); w.y = pk2(a[2], a[3]); w.z = pk2(b[0], b[1]); w.w = pk2(b[2], b[3]); return w; }

__device__ __forceinline__ float rstd_part16(const float* p, float inv_n) { const f32x4 a = ((const f32x4*)p)[0], b = ((const f32x4*)p)[1], c = ((const f32x4*)p)[2], d = ((const f32x4*)p)[3];
    const f32x4 s4 = (a + b) + (c + d); return 1.0f / sqrtf(((s4[0] + s4[1]) + (s4[2] + s4[3])) * inv_n + EPS); }
__device__ __forceinline__ float rstd_part8(const float* p, float inv_n) { const f32x4 a = ((const f32x4*)p)[0], b = ((const f32x4*)p)[1]; const f32x4 s4 = a + b; return 1.0f / sqrtf(((s4[0] + s4[1]) + (s4[2] + s4[3])) * inv_n + EPS); }
__device__ __forceinline__ float rstd_part4(const float* p, float inv_n) { const f32x4 a = ((const f32x4*)p)[0]; return 1.0f / sqrtf(((a[0] + a[1]) + (a[2] + a[3])) * inv_n + EPS); }
__device__ __forceinline__ float sq8(const f32x4& a, const f32x4& b) { return ((a[0] * a[0] + a[1] * a[1]) + (a[2] * a[2] + a[3] * a[3])) + ((b[0] * b[0] + b[1] * b[1]) + (b[2] * b[2] + b[3] * b[3])); }
__device__ __forceinline__ float fq_sum(float v) { v += xor16(v); v += xor32(v); return v; }

namespace pg8 {
constexpr int BM = 256, BK = 64, HALF = 128, HTB = HALF * BK * 2, STAGE_BYTES = 8 * HTB, NXCD = 8, WGM = 8;
__host__ __device__ __forceinline__ int lds_byte(int r, int c) { const int st = (r >> 4) * 2 + (c >> 5), rr = r & 15, cc = c & 31, ob = rr * 64 + cc * 2; return st * 1024 + (ob ^ (((ob >> 9) & 1) << 5)); }
__host__ __device__ __forceinline__ void stage_rc(int b, int& R, int& C) { const int st = b / 1024, sb = b % 1024, swz = sb ^ (((sb >> 9) & 1) << 5); R = (st >> 1) * 16 + swz / 64; C = (st & 1) * 32 + (swz % 64) / 2; }
__host__ __device__ __forceinline__ int perm32(int rho) { const int n = rho >> 4, i = rho & 15; return 8 * (i >> 2) + 4 * n + (i & 3); }

struct Unit { int pm, pn, e, tile, nrows; };

struct StaticOrder {
    int nM, nN, nwg, G, c;
    __device__ void init(int M, int N, int G_, int c_) { nM = M / BM; nN = N / BM; nwg = nM * nN; G = G_; c = c_; }
    __device__ bool next(int i, Unit& u) const {
        const long L = (long)i * G + c; if (L >= nwg) return false;
        int wgid = (int)L; { const int q = nwg / NXCD, r = nwg % NXCD, xcd = wgid % NXCD, off = wgid / NXCD; wgid = (xcd < r ? xcd * (q + 1) : r * (q + 1) + (xcd - r) * q) + off; }
        const int nig = WGM * nN, gid = wgid / nig, fm = gid * WGM, gsz = (nM - fm) < WGM ? (nM - fm) : WGM;
        u.pm = fm + ((wgid % nig) % gsz); u.pn = (wgid % nig) / gsz; u.e = 0; u.tile = 0; u.nrows = 256; return true;
    }
};

template <class Epi, class Sched>
__device__ __forceinline__ void gemm_phase(LAS unsigned char* lds, const int tid, const char* Abase, const int K, const Sched& S, const Epi& E) {
    const int wid = __builtin_amdgcn_readfirstlane(tid >> 6), lane = tid & 63, wr = wid >> 2, wc = wid & 3, fr = lane & 15, fq = lane >> 4;
    const int nt = K / BK;
    unsigned voffB[2];
#pragma unroll
    for (int i = 0; i < 2; ++i) { int R, C; stage_rc(tid * 16 + i * 8192, R, C); const int Rb = (R & ~31) + perm32(R & 31); voffB[i] = (unsigned)(Rb * K + C) * 2u; }
    const size_t kstep = (size_t)(BK * 2);
    const size_t hstep = (size_t)HALF * K * 2;
    const unsigned ldsw = (unsigned)wid * 1024u;
    const int aoff = lds_byte(wr * 64 + fr, fq * 8), boff = lds_byte(wc * 32 + fr, fq * 8);
#define PG8_SA(b, h) (((b) * 2 + (h)) * HTB)
#define PG8_SB(b, h) ((4 + (b) * 2 + (h)) * HTB)
#define PG8_STAGE(bufoff, gbase, voff) do { _Pragma("unroll") for (int _i = 0; _i < 2; ++_i) \
        __builtin_amdgcn_global_load_lds((const unsigned*)((const char*)(gbase) + (voff)[_i]), (LAS unsigned*)(lds + (bufoff) + ldsw + _i * 8192), 16, 0, 0); } while (0)
#define PG8_LDA(dst, b, h) do { _Pragma("unroll") for (int m = 0; m < 4; ++m) _Pragma("unroll") for (int k = 0; k < 2; ++k) dst[m][k] = *(const LAS bf16x8*)(lds + PG8_SA(b, h) + aoff + m * 2048 + k * 1024); } while (0)
#define PG8_LDB(dst, b, h) do { _Pragma("unroll") for (int n = 0; n < 2; ++n) _Pragma("unroll") for (int k = 0; k < 2; ++k) dst[n][k] = *(const LAS bf16x8*)(lds + PG8_SB(b, h) + boff + n * 2048 + k * 1024); } while (0)
#define PG8_MMA(ai, bj, At, Bt) do { __builtin_amdgcn_s_setprio(1); _Pragma("unroll") for (int m = 0; m < 4; ++m) _Pragma("unroll") for (int n = 0; n < 2; ++n) _Pragma("unroll") for (int k = 0; k < 2; ++k) \
        acc[ai][bj][m][n] = __builtin_amdgcn_mfma_f32_16x16x32_bf16(Bt[n][k], At[m][k], acc[ai][bj][m][n], 0, 0, 0); __builtin_amdgcn_s_setprio(0); } while (0)
#define PG8_WAIT_V(n) asm volatile("s_waitcnt vmcnt(" #n ")" ::: "memory")
#define PG8_WAIT_L(n) asm volatile("s_waitcnt lgkmcnt(" #n ")" ::: "memory")
#define PG8_BAR __builtin_amdgcn_s_barrier()
#define PG8_SCHED __builtin_amdgcn_sched_barrier(0)
    Unit cur, nxt; int ui = 0;
    if (!S.next(0, cur)) return;
    f32x4 acc[2][2][4][2];
#pragma unroll
    for (int a = 0; a < 2; ++a)
#pragma unroll
        for (int b = 0; b < 2; ++b)
#pragma unroll
            for (int m = 0; m < 4; ++m)
#pragma unroll
                for (int n = 0; n < 2; ++n) acc[a][b][m][n] = (f32x4){0.f, 0.f, 0.f, 0.f};
    bf16x8 At[4][2], B0[2][2], B1[2][2];
    unsigned vc[2][2];
    LAS u32x4* vslot = (LAS u32x4*)(lds + STAGE_BYTES + 1024) + tid;
#define PG8_AOFFS(dst, U) do { int t2_ = tid; asm volatile("" : "+v"(t2_)); _Pragma("unroll") for (int i = 0; i < 2; ++i) { int R, C; stage_rc(t2_ * 16 + i * 8192, R, C); \
        dst[0][i] = S.a_off(U, R) + (unsigned)C * 2u; dst[1][i] = S.a_off(U, HALF + R) + (unsigned)C * 2u; } } while (0)
    PG8_AOFFS(vc, cur);
    const char* cB = S.b_tile(cur);
    E.begin(cur, ui, tid, lds);
    PG8_STAGE(PG8_SB(0, 0), cB, voffB); PG8_STAGE(PG8_SB(0, 1), cB + hstep, voffB); PG8_STAGE(PG8_SA(0, 0), Abase, vc[0]); PG8_STAGE(PG8_SA(0, 1), Abase, vc[1]);
    if (wr == 1) PG8_BAR;
    PG8_WAIT_V(2); PG8_BAR;
    PG8_STAGE(PG8_SB(1, 0), cB + kstep, voffB); PG8_STAGE(PG8_SA(1, 0), Abase + kstep, vc[0]); PG8_STAGE(PG8_SB(1, 1), cB + hstep + kstep, voffB);
    PG8_WAIT_V(6); PG8_BAR;
    for (;;) {
        const bool has_next = S.next(ui + 1, nxt);
        const char* nB = cB;
        { unsigned vn[2][2];
          if (has_next) { PG8_AOFFS(vn, nxt); nB = S.b_tile(nxt); *vslot = (u32x4){vn[0][0], vn[0][1], vn[1][0], vn[1][1]}; }
          else *vslot = (u32x4){vc[0][0], vc[0][1], vc[1][0], vc[1][1]}; }
        for (int t = 0; t < nt; t += 2) {
            if constexpr (Epi::MID) { if (t == (nt >> 1)) E.mid(acc, ui, wr, fr, lds); }
            const bool last = (t == nt - 2);
            const char* a1 = Abase + (size_t)(t + 1) * kstep;
            const char* a2 = last ? Abase : Abase + (size_t)(t + 2) * kstep; const char* b2 = last ? nB : cB + (size_t)(t + 2) * kstep;
            const char* a3 = a2 + kstep; const char* b3 = b2 + kstep;
            unsigned w2[2][2];
            if (last) { const u32x4 q = *vslot; w2[0][0] = q.x; w2[0][1] = q.y; w2[1][0] = q.z; w2[1][1] = q.w; }
            else { w2[0][0] = vc[0][0]; w2[0][1] = vc[0][1]; w2[1][0] = vc[1][0]; w2[1][1] = vc[1][1]; }
            PG8_LDB(B0, 0, 0); PG8_LDB(B1, 0, 1); PG8_SCHED; PG8_LDA(At, 0, 0); PG8_STAGE(PG8_SA(1, 1), a1, vc[1]);
            PG8_WAIT_V(8); PG8_WAIT_L(0); PG8_BAR; PG8_MMA(0, 0, At, B0); PG8_MMA(0, 1, At, B1); PG8_BAR; PG8_SCHED;
            PG8_LDA(At, 0, 1); PG8_STAGE(PG8_SB(0, 0), b2, voffB); PG8_STAGE(PG8_SB(0, 1), b2 + hstep, voffB); PG8_STAGE(PG8_SA(0, 0), a2, w2[0]);
            PG8_WAIT_V(8); PG8_WAIT_L(0); PG8_BAR; PG8_MMA(1, 0, At, B0); PG8_MMA(1, 1, At, B1); PG8_BAR; PG8_SCHED;
            PG8_LDB(B0, 1, 0); PG8_LDB(B1, 1, 1); PG8_SCHED; PG8_LDA(At, 1, 0); PG8_STAGE(PG8_SA(0, 1), a2, w2[1]);
            PG8_WAIT_V(8); PG8_WAIT_L(0); PG8_BAR; PG8_MMA(0, 0, At, B0); PG8_MMA(0, 1, At, B1); PG8_BAR; PG8_SCHED;
            PG8_LDA(At, 1, 1); PG8_STAGE(PG8_SB(1, 0), b3, voffB); PG8_STAGE(PG8_SB(1, 1), b3 + hstep, voffB); PG8_STAGE(PG8_SA(1, 0), a3, w2[0]);
            PG8_WAIT_V(8); PG8_WAIT_L(0); PG8_BAR; PG8_MMA(1, 0, At, B0); PG8_MMA(1, 1, At, B1); PG8_BAR; PG8_SCHED;
        }
        if (wr == 0) PG8_BAR;
        { int t3 = tid; asm volatile("" : "+v"(t3)); const int fr2 = t3 & 15, fq2 = (t3 >> 4) & 3;
          E(acc, cur, ui, wr, wc, fr2, fq2, lds); }
        if (!has_next) break;
#pragma unroll
        for (int a = 0; a < 2; ++a)
#pragma unroll
            for (int b = 0; b < 2; ++b)
#pragma unroll
                for (int m = 0; m < 4; ++m)
#pragma unroll
                    for (int n = 0; n < 2; ++n) acc[a][b][m][n] = (f32x4){0.f, 0.f, 0.f, 0.f};
        cur = nxt; cB = nB; ++ui;
        E.begin(cur, ui, tid, lds);
        { const u32x4 q = *vslot; vc[0][0] = q.x; vc[0][1] = q.y; vc[1][0] = q.z; vc[1][1] = q.w; }
        if (wr == 1) PG8_BAR;
    }
    PG8_WAIT_V(0);
    PG8_BAR;
#undef PG8_AOFFS
#undef PG8_SA
#undef PG8_SB
#undef PG8_STAGE
#undef PG8_LDA
#undef PG8_LDB
#undef PG8_MMA
#undef PG8_WAIT_V
#undef PG8_WAIT_L
#undef PG8_BAR
#undef PG8_SCHED
}
}
using pg8::Unit;

struct DenseSched {
    pg8::StaticOrder o; const char* Bt; int K;
    __device__ __forceinline__ bool next(int i, Unit& u) const { return o.next(i, u); }
    __device__ __forceinline__ unsigned a_off(const Unit& u, int r) const { return (unsigned)(u.pm * 256 + r) * (unsigned)(K * 2); }
    __device__ __forceinline__ const char* b_tile(const Unit& u) const { return Bt + (size_t)u.pn * 256 * K * 2; }
};
struct MoeSched {
    int G, c, npn, gather; const LAS int* tb; const int* liste; const char* Bt; int K, nB;
    __device__ __forceinline__ bool next(int i, Unit& u) const {
        if ((G & 7) == 0) {
            const int x = c & 7, W = G >> 3, q = i * W + (c >> 3);
            int tq = q / npn; u.pn = q % npn;
#pragma unroll 1
            for (int k = 0; k < 4; ++k) { const int e = x + 8 * k, nte = tb[e + 1] - tb[e];
                if (tq < nte) { u.e = e; u.tile = tq; u.pm = tb[e] + tq; const int rem = tb[40 + e] - 256 * tq; u.nrows = rem < 256 ? rem : 256; return true; }
                tq -= nte; }
            return false;
        }
        const int L = i * G + c, ntile = tb[32];
        if (L >= ntile * npn) return false;
        const int ti = L / npn; u.pn = L % npn; u.pm = ti;
        int e = 0;
#pragma unroll 1
        for (; e < 31; ++e) if (ti < tb[e + 1]) break;
        u.e = e; u.tile = ti - tb[e]; const int rem = tb[40 + e] - 256 * u.tile; u.nrows = rem < 256 ? rem : 256; return true;
    }
    __device__ __forceinline__ unsigned a_off(const Unit& u, int r) const {
        if (gather) { int tok = 0; if (r < u.nrows) tok = liste[(size_t)u.e * T + 256 * u.tile + r] >> 1; return (unsigned)tok * (unsigned)(K * 2); }
        return (unsigned)(u.pm * 256 + r) * (unsigned)(K * 2);
    }
    __device__ __forceinline__ const char* b_tile(const Unit& u) const { return Bt + ((size_t)u.e * nB + (size_t)u.pn * 256) * K * 2; }
};

#define EPI_DEFAULTS static constexpr bool MID = false; __device__ __forceinline__ void begin(const Unit&, int, int, LAS unsigned char*) const {}
#define EPI_NOMID static constexpr bool MID = false;
constexpr int RTAB_OFF = pg8::STAGE_BYTES + 1024 + 8192;
__device__ __forceinline__ void rtab_put(LAS unsigned char* lds, int ui, int r, float a, float b) { asm volatile("" : "+v"(r));
    ((LAS f32x2*)(lds + RTAB_OFF))[(ui & 1) * 256 + r] = (f32x2){a, b}; }
__device__ __forceinline__ f32x2 rtab_get(LAS unsigned char* lds, int ui, int r) { return ((const LAS f32x2*)(lds + RTAB_OFF))[(ui & 1) * 256 + r]; }
struct EpiIn {
    EPI_NOMID
    __device__ __forceinline__ void begin(const Unit& u, int ui, int tid, LAS unsigned char* lds) const { if (tid < 256) rtab_put(lds, ui, tid, rstd_part16(SSQ + (size_t)(u.pm * 256 + tid) * 16, 1.f / DM), 0.f); }
    const float* SSQ; bf16_t* QKV; bf16_t* CKV; bf16_t* CQ; bf16_t* KR; const float* COS; const float* SIN; float* SQQ; float* SQK;
    __device__ __forceinline__ void operator()(const f32x4 (&acc)[2][2][4][2], const Unit& u, int ui, int wr, int wc, int fr, int fq, LAS unsigned char* lds) const {
        const int pn = u.pn;
#pragma unroll
        for (int ai = 0; ai < 2; ++ai)
#pragma unroll
            for (int m = 0; m < 4; ++m) {
                const int rr = ai * 128 + wr * 64 + m * 16 + fr, row = u.pm * 256 + rr; const float rs = rtab_get(lds, ui, rr)[0];
                float sq = 0.f;
#pragma unroll
                for (int bj = 0; bj < 2; ++bj) {
                    const int c = bj * 128 + wc * 32 + fq * 8;
                    f32x4 v0 = acc[ai][bj][m][0] * rs, v1 = acc[ai][bj][m][1] * rs;
                    if (pn < 6) { if (pn < 2) { v0 = v0 * QS_SB; v1 = v1 * QS_SB; } *(u32x4*)(QKV + (size_t)row * 1536 + pn * 256 + c) = pack8(v0, v1); }
                    else if (pn == 6) { *(u32x4*)(CKV + (size_t)row * 256 + c) = pack8(v0, v1); sq += sq8(v0, v1); }
                    else if (pn == 7) { *(u32x4*)(CQ + (size_t)row * 384 + c) = pack8(v0, v1); sq += sq8(v0, v1); }
                    else if (bj == 0) { *(u32x4*)(CQ + (size_t)row * 384 + 256 + c) = pack8(v0, v1); sq += sq8(v0, v1); }
                    else if (wc == 0) {
                        const int ib = 8 * (fq & 1);
                        const f32x4 c0 = *(const f32x4*)(COS + (size_t)row * 16 + ib), c1 = *(const f32x4*)(COS + (size_t)row * 16 + ib + 4);
                        const f32x4 s0 = *(const f32x4*)(SIN + (size_t)row * 16 + ib), s1 = *(const f32x4*)(SIN + (size_t)row * 16 + ib + 4);
                        f32x4 p0, p1;
#pragma unroll
                        for (int i = 0; i < 4; ++i) { p0[i] = xor32(v0[i]); p1[i] = xor32(v1[i]); }
                        const float sg = (fq < 2) ? -1.f : 1.f;
                        const f32x4 o0 = v0 * c0 + p0 * s0 * sg, o1 = v1 * c1 + p1 * s1 * sg;
                        *(u32x4*)(KR + (size_t)row * 32 + fq * 8) = pack8(o0, o1);
                    }
                }
                if (pn >= 6) {
                    sq = fq_sum(sq);
                    if (fq == 0) { if (pn == 6) SQK[(size_t)row * 4 + wc] = sq; else SQQ[(size_t)row * 8 + (pn - 7) * 4 + wc] = sq; }
                }
                asm volatile("" ::: "memory");
            }
    }
};
struct EpiUq {
    EPI_NOMID
    __device__ __forceinline__ void begin(const Unit& u, int ui, int tid, LAS unsigned char* lds) const { if (tid < 256) rtab_put(lds, ui, tid, rstd_part8(RS + (size_t)(u.pm * 256 + tid) * 8, 1.f / QRANK) * QS_MLA, 0.f); }
    const float* RS; bf16_t* QM; const float* COS; const float* SIN;
    __device__ __forceinline__ void operator()(const f32x4 (&acc)[2][2][4][2], const Unit& u, int ui, int wr, int wc, int fr, int fq, LAS unsigned char* lds) const {
#pragma unroll
        for (int ai = 0; ai < 2; ++ai)
#pragma unroll
            for (int m = 0; m < 4; ++m) {
                const int rr = ai * 128 + wr * 64 + m * 16 + fr, row = u.pm * 256 + rr; const float rs = rtab_get(lds, ui, rr)[0];
#pragma unroll
                for (int bj = 0; bj < 2; ++bj) {
                    const int c = u.pn * 256 + bj * 128 + wc * 32 + fq * 8; const int g32 = u.pn * 8 + bj * 4 + wc;
                    f32x4 v0 = acc[ai][bj][m][0] * rs, v1 = acc[ai][bj][m][1] * rs;
                    if ((g32 % 3) == 2) {
                        const int ib = 8 * (fq & 1);
                        const f32x4 c0 = *(const f32x4*)(COS + (size_t)row * 16 + ib), c1 = *(const f32x4*)(COS + (size_t)row * 16 + ib + 4);
                        const f32x4 s0 = *(const f32x4*)(SIN + (size_t)row * 16 + ib), s1 = *(const f32x4*)(SIN + (size_t)row * 16 + ib + 4);
                        f32x4 p0, p1;
#pragma unroll
                        for (int i = 0; i < 4; ++i) { p0[i] = xor32(v0[i]); p1[i] = xor32(v1[i]); }
                        const float sg = (fq < 2) ? -1.f : 1.f;
                        v0 = v0 * c0 + p0 * s0 * sg; v1 = v1 * c1 + p1 * s1 * sg;
                    }
                    *(u32x4*)(QM + (size_t)row * 768 + c) = pack8(v0, v1);
                }
                asm volatile("" ::: "memory");
            }
    }
};
struct EpiUkv {
    EPI_NOMID
    __device__ __forceinline__ void begin(const Unit& u, int ui, int tid, LAS unsigned char* lds) const { if (tid < 256) rtab_put(lds, ui, tid, rstd_part4(RS + (size_t)(u.pm * 256 + tid) * 4, 1.f / KVRANK), 0.f); }
    const float* RS; bf16_t* KN; bf16_t* VM;
    __device__ __forceinline__ void operator()(const f32x4 (&acc)[2][2][4][2], const Unit& u, int ui, int wr, int wc, int fr, int fq, LAS unsigned char* lds) const {
        bf16_t* dst = u.pn < 2 ? KN : VM; const int cb = (u.pn & 1) * 256;
#pragma unroll
        for (int ai = 0; ai < 2; ++ai)
#pragma unroll
            for (int m = 0; m < 4; ++m) {
                const int rr = ai * 128 + wr * 64 + m * 16 + fr, row = u.pm * 256 + rr; const float rs = rtab_get(lds, ui, rr)[0];
#pragma unroll
                for (int bj = 0; bj < 2; ++bj) { const int c = cb + bj * 128 + wc * 32 + fq * 8;
                    *(u32x4*)(dst + (size_t)row * 512 + c) = pack8(acc[ai][bj][m][0] * rs, acc[ai][bj][m][1] * rs); }
            }
    }
};
struct EpiBf {
    EPI_DEFAULTS
    bf16_t* O; int ldc;
    __device__ __forceinline__ void operator()(const f32x4 (&acc)[2][2][4][2], const Unit& u, int ui, int wr, int wc, int fr, int fq, LAS unsigned char* lds) const {
#pragma unroll
        for (int ai = 0; ai < 2; ++ai)
#pragma unroll
            for (int m = 0; m < 4; ++m) {
                const int row = u.pm * 256 + ai * 128 + wr * 64 + m * 16 + fr;
#pragma unroll
                for (int bj = 0; bj < 2; ++bj) { const int c = u.pn * 256 + bj * 128 + wc * 32 + fq * 8;
                    *(u32x4*)(O + (size_t)row * ldc + c) = pack8(acc[ai][bj][m][0], acc[ai][bj][m][1]); }
            }
    }
};
constexpr int OTAB_OFF = RTAB_OFF;
struct EpiOut {
    static constexpr bool MID = true;
    const float* xin; const bf16_t* hin; bf16_t* hout; const float* OSS;
    __device__ __forceinline__ void begin(const Unit& u, int ui, int tid, LAS unsigned char* lds) const {
        if (tid < 256) { const float* p = OSS + (size_t)(u.pm * 256 + tid) * 16; const f32x4 a = ((const f32x4*)p)[0], b = ((const f32x4*)p)[1], c = ((const f32x4*)p)[2], d = ((const f32x4*)p)[3];
            const f32x4 s1 = a + b, s2 = c + d; const float rs = 1.0f / sqrtf(((s1[0] + s1[1]) + (s1[2] + s1[3])) * (1.f / 512.f) + EPS), rm = 1.0f / sqrtf(((s2[0] + s2[1]) + (s2[2] + s2[3])) * (1.f / 512.f) + EPS);
            ((LAS f32x2*)(lds + OTAB_OFF))[(ui & 1) * 256 + tid] = (f32x2){rs / rm, rm}; }
    }
    __device__ __forceinline__ void mid(f32x4 (&acc)[2][2][4][2], int ui, int wr, int fr, LAS unsigned char* lds) const {
#pragma unroll
        for (int ai = 0; ai < 2; ++ai)
#pragma unroll
            for (int m = 0; m < 4; ++m) { const float f = ((const LAS f32x2*)(lds + OTAB_OFF))[(ui & 1) * 256 + ai * 128 + wr * 64 + m * 16 + fr][0];
#pragma unroll
                for (int bj = 0; bj < 2; ++bj)
#pragma unroll
                    for (int n = 0; n < 2; ++n) acc[ai][bj][m][n] = acc[ai][bj][m][n] * f; }
    }
    __device__ __forceinline__ void operator()(const f32x4 (&acc)[2][2][4][2], const Unit& u, int ui, int wr, int wc, int fr, int fq, LAS unsigned char* lds) const {
#pragma unroll
        for (int ai = 0; ai < 2; ++ai) {
            if (xin) {
#pragma unroll
                for (int m = 0; m < 4; ++m) { const int r = ai * 128 + wr * 64 + m * 16 + fr, row = u.pm * 256 + r; const float rm = rtab_get(lds, ui, r)[1];
#pragma unroll
                    for (int bj = 0; bj < 2; ++bj) { const size_t o = (size_t)row * DM + u.pn * 256 + bj * 128 + wc * 32 + fq * 8;
                        const f32x4 a = *(const f32x4*)(xin + o), b = *(const f32x4*)(xin + o + 4);
                        *(u32x4*)(hout + o) = pack8(a + acc[ai][bj][m][0] * rm, b + acc[ai][bj][m][1] * rm); }
                    asm volatile("" ::: "memory"); }
            } else {
                u32x4 hb[4][2];
#pragma unroll
                for (int m = 0; m < 4; ++m)
#pragma unroll
                    for (int bj = 0; bj < 2; ++bj) hb[m][bj] = *(const u32x4*)(hin + (size_t)(u.pm * 256 + ai * 128 + wr * 64 + m * 16 + fr) * DM + u.pn * 256 + bj * 128 + wc * 32 + fq * 8);
#pragma unroll
                for (int m = 0; m < 4; ++m) { const int r = ai * 128 + wr * 64 + m * 16 + fr, row = u.pm * 256 + r; const float rm = rtab_get(lds, ui, r)[1];
#pragma unroll
                    for (int bj = 0; bj < 2; ++bj) { const size_t o = (size_t)row * DM + u.pn * 256 + bj * 128 + wc * 32 + fq * 8;
                        float f[8]; unpack8(hb[m][bj], f);
                        *(u32x4*)(hout + o) = pack8((f32x4){f[0], f[1], f[2], f[3]} + acc[ai][bj][m][0] * rm, (f32x4){f[4], f[5], f[6], f[7]} + acc[ai][bj][m][1] * rm); } }
            }
            asm volatile("" ::: "memory");
        }
    }
};
struct EpiG1 {
    EPI_NOMID
    __device__ __forceinline__ void begin(const Unit& u, int ui, int tid, LAS unsigned char* lds) const {
        if (tid < 256) { float rs = 0.f; if (tid < u.nrows) rs = RS[liste[(size_t)u.e * T + 256 * u.tile + tid] >> 1]; rtab_put(lds, ui, tid, rs, 0.f); } }
    const float* RS; const int* liste; bf16_t* HID;
    __device__ __forceinline__ void operator()(const f32x4 (&acc)[2][2][4][2], const Unit& u, int ui, int wr, int wc, int fr, int fq, LAS unsigned char* lds) const {
#pragma unroll
        for (int ai = 0; ai < 2; ++ai)
#pragma unroll
            for (int m = 0; m < 4; ++m) {
                const int r = ai * 128 + wr * 64 + m * 16 + fr;
                if (r < u.nrows) {
                    const float rs = rtab_get(lds, ui, r)[0];
                    f32x4 h[2];
#pragma unroll
                    for (int n = 0; n < 2; ++n) { const f32x4 g = acc[ai][0][m][n] * rs, up = acc[ai][1][m][n] * rs;
#pragma unroll
                        for (int i = 0; i < 4; ++i) h[n][i] = g[i] * frcp(1.f + fexp2(-g[i] * LOG2E)) * up[i]; }
                    *(u32x4*)(HID + (size_t)(u.pm * 256 + r) * 256 + u.pn * 128 + wc * 32 + fq * 8) = pack8(h[0], h[1]);
                }
                asm volatile("" ::: "memory");
            }
    }
};
struct EpiDn {
    EPI_NOMID
    __device__ __forceinline__ void begin(const Unit& u, int ui, int tid, LAS unsigned char* lds) const {
        asm volatile("" : "+v"(tid));
        if (tid < 256) { int ent = 0; float w = 0.f; if (tid < u.nrows) { const size_t li = (size_t)u.e * T + 256 * u.tile + tid; ent = liste[li]; w = listw[li]; } rtab_put(lds, ui, tid, __int_as_float(ent), w); } }
    const int* liste; const float* listw; bf16_t* Y;
    __device__ __forceinline__ void operator()(const f32x4 (&acc)[2][2][4][2], const Unit& u, int ui, int wr, int wc, int fr, int fq, LAS unsigned char* lds) const {
#pragma unroll
        for (int ai = 0; ai < 2; ++ai)
#pragma unroll
            for (int m = 0; m < 4; ++m) {
                const int r = ai * 128 + wr * 64 + m * 16 + fr;
                if (r < u.nrows) {
                    const f32x2 te = rtab_get(lds, ui, r); const int ent = __float_as_int(te[0]); const float w = te[1];
#pragma unroll
                    for (int bj = 0; bj < 2; ++bj) { const int c = u.pn * 256 + bj * 128 + wc * 32 + fq * 8;
                        *(u32x4*)(Y + (size_t)ent * DM + c) = pack8(acc[ai][bj][m][0] * w, acc[ai][bj][m][1] * w); }
                }
                asm volatile("" ::: "memory");
            }
    }
};
struct EpiPle {
    EPI_NOMID
    __device__ __forceinline__ void begin(const Unit& u, int ui, int tid, LAS unsigned char* lds) const { if (tid < 256) rtab_put(lds, ui, tid, RS[u.pm * 256 + tid], 0.f); }
    const float* RS; const bf16_t* PE; const bf16_t* H; bf16_t* HO; float* SSQ;
    __device__ __forceinline__ void operator()(const f32x4 (&acc)[2][2][4][2], const Unit& u, int ui, int wr, int wc, int fr, int fq, LAS unsigned char* lds) const {
#pragma unroll
        for (int ai = 0; ai < 2; ++ai) {
            u32x4 hb[4][2], pb[4][2];
#pragma unroll
            for (int m = 0; m < 4; ++m)
#pragma unroll
                for (int bj = 0; bj < 2; ++bj) { const size_t o = (size_t)(u.pm * 256 + ai * 128 + wr * 64 + m * 16 + fr) * DM + u.pn * 256 + bj * 128 + wc * 32 + fq * 8;
                    hb[m][bj] = *(const GAS u32x4*)(H + o); pb[m][bj] = *(const GAS u32x4*)(PE + o); }
#pragma unroll
            for (int m = 0; m < 4; ++m) {
                const int rr = ai * 128 + wr * 64 + m * 16 + fr, row = u.pm * 256 + rr; const float rs = rtab_get(lds, ui, rr)[0];
                float sq = 0.f;
#pragma unroll
                for (int bj = 0; bj < 2; ++bj) { const size_t o = (size_t)row * DM + u.pn * 256 + bj * 128 + wc * 32 + fq * 8;
                    float pe[8], hv[8]; unpack8(pb[m][bj], pe); unpack8(hb[m][bj], hv);
#pragma unroll
                    for (int i = 0; i < 4; ++i) { hv[i] += frcp(1.f + fexp2(-acc[ai][bj][m][0][i] * rs * LOG2E)) * pe[i]; hv[4 + i] += frcp(1.f + fexp2(-acc[ai][bj][m][1][i] * rs * LOG2E)) * pe[4 + i]; }
                    const u32x4 w = (u32x4){pk2(hv[0], hv[1]), pk2(hv[2], hv[3]), pk2(hv[4], hv[5]), pk2(hv[6], hv[7])};
                    *(GAS u32x4*)(HO + o) = w; unpack8(w, hv);
#pragma unroll
                    for (int i = 0; i < 8; ++i) sq += hv[i] * hv[i]; }
                sq = fq_sum(sq);
                if (fq == 0) *(GAS float*)(SSQ + (size_t)row * 16 + u.pn * 4 + wc) = sq;
            }
            asm volatile("" ::: "memory");
        }
    }
};


#define XB_TMO      128
#define XB_XCNT(j)  (256  + 64 * (j))
#define XB_XSUB(j)  (1280 + 64 * (j))
#define XB_XGEN(j)  (2304 + 64 * (j))
#define XB_TOP      3328
#define XB_TOPGEN   3392
#define XCD_BAR_WORDS 3456
#define XB_SPIN_CAP (1u << 18)

__device__ __forceinline__ unsigned xb_ld(unsigned* p)              { return __hip_atomic_load(p, __ATOMIC_RELAXED, __HIP_MEMORY_SCOPE_AGENT); }
__device__ __forceinline__ unsigned xb_add(unsigned* p, unsigned v) { return __hip_atomic_fetch_add(p, v, __ATOMIC_RELAXED, __HIP_MEMORY_SCOPE_AGENT); }
__device__ __forceinline__ unsigned xb_xcc_id() { return (unsigned)__builtin_amdgcn_s_getreg((3 << 11) | 20) & 0xFu; }
#define XB_SPIN(cond, bar) do { unsigned _sp = 0; while (cond) { __builtin_amdgcn_s_sleep(1); \
    if ((++_sp & 255u) == 0u) { if (xb_ld(&(bar)[XB_TMO])) break; if (_sp > XB_SPIN_CAP) { atomicAdd(&(bar)[XB_TMO], 1u); break; } } } } while (0)

struct XcdBarrier {
    unsigned* bar; unsigned x;
    volatile LAS unsigned* st;
};

__device__ __forceinline__ XcdBarrier xcd_barrier_post(unsigned* bar, volatile LAS unsigned* st) {
    XcdBarrier b; b.bar = bar; b.x = xb_xcc_id(); b.st = st;
    if (threadIdx.x == 0) (void)xb_add(&bar[XB_XCNT(b.x)], 1u);
    return b;
}
__device__ __forceinline__ void xcd_barrier_complete(unsigned* bar, unsigned x, unsigned& nloc, unsigned& nx) {
    const unsigned G = gridDim.x * gridDim.y * gridDim.z;
    unsigned sum, cnt, mine, sp = 0u;
    for (;;) {
        sum = 0u; cnt = 0u; mine = 0u;
#pragma unroll
        for (unsigned j = 0; j < 16; ++j) { const unsigned c = xb_ld(&bar[XB_XCNT(j)]); sum += c; cnt += (c > 0u) ? 1u : 0u; mine = (j == x) ? c : mine; }
        if (sum == G) break;
        __builtin_amdgcn_s_sleep(1);
        if ((++sp & 255u) == 0u) { if (xb_ld(&bar[XB_TMO])) break; if (sp > XB_SPIN_CAP) { atomicAdd(&bar[XB_TMO], 1u); break; } }
    }
    nloc = mine > 0u ? mine : 1u; nx = cnt > 0u ? cnt : 1u;
}

__device__ __forceinline__ void xcd_barrier(const XcdBarrier& b) {
    asm volatile("s_waitcnt vmcnt(0)" ::: "memory");
    __syncthreads();
    if (threadIdx.x == 0) {
        unsigned* bar = b.bar;
        __builtin_amdgcn_s_waitcnt(0);
        unsigned nloc = b.st[0], nx = b.st[1];
        if (nloc == 0u) { xcd_barrier_complete(bar, b.x, nloc, nx); b.st[0] = nloc; b.st[1] = nx; }
        const unsigned old = xb_add(&bar[XB_XSUB(b.x)], 1u);
        const unsigned gen = old / nloc;
        if (old + 1u == (gen + 1u) * nloc) {
            __builtin_amdgcn_fence(__ATOMIC_RELEASE, "agent");
            asm volatile("s_waitcnt vmcnt(0)" ::: "memory");
            const unsigned og = xb_add(&bar[XB_TOP], 1u);
            const unsigned tg = og / nx;
            if (og + 1u == (tg + 1u) * nx) xb_add(&bar[XB_TOPGEN], 1u);
            else XB_SPIN(xb_ld(&bar[XB_TOPGEN]) == tg, bar);
            __builtin_amdgcn_fence(__ATOMIC_ACQUIRE, "agent");
            xb_add(&bar[XB_XGEN(b.x)], 1u);
            asm volatile("s_waitcnt vmcnt(0)" ::: "memory");
        } else {
            XB_SPIN(xb_ld(&bar[XB_XGEN(b.x)]) == gen, bar);
            __builtin_amdgcn_fence(__ATOMIC_ACQUIRE, "agent");
            asm volatile("s_waitcnt vmcnt(0)" ::: "memory");
        }
    }
    __syncthreads();
}


struct Frame {
    LAS unsigned char* lds; int tid, lane, wave, G, bx;
    const Params* P; unsigned char* ws;
    __device__ __forceinline__ int gw() const { return bx * NWAVES + wave; }
    __device__ __forceinline__ int ngw() const { return G * NWAVES; }
};
template <class Tp> __device__ __forceinline__ Tp* wsp(const Frame& F, size_t off) { return (Tp*)(F.ws + off); }

__device__ __forceinline__ void prep_item(const float* W, int ldw, int srccol0, const float* g, bf16_t* dstrow0, int K, int k0, LAS float* scr, int lane) {
    const int c = lane & 7;
    if (srccol0 < 0) {
#pragma unroll
        for (int j = 0; j < 4; ++j) { const int n = (lane >> 3) + 8 * j; *(u32x4*)(dstrow0 + (size_t)n * K + k0 + 8 * c) = (u32x4){0u, 0u, 0u, 0u}; }
        return;
    }
#pragma unroll 8
    for (int i = 0; i < 32; ++i) { const int kk = 2 * i + (lane >> 5); float v = W[(size_t)(k0 + kk) * ldw + srccol0 + (lane & 31)]; if (g) v *= g[k0 + kk]; scr[kk * 33 + (lane & 31)] = v; }
    asm volatile("s_waitcnt lgkmcnt(0)" ::: "memory");
#pragma unroll
    for (int j = 0; j < 4; ++j) { const int n = (lane >> 3) + 8 * j; const LAS float* s = scr + (8 * c) * 33 + n;
        u32x4 o; o.x = pk2(s[0 * 33], s[1 * 33]); o.y = pk2(s[2 * 33], s[3 * 33]); o.z = pk2(s[4 * 33], s[5 * 33]); o.w = pk2(s[6 * 33], s[7 * 33]);
        *(u32x4*)(dstrow0 + (size_t)n * K + k0 + 8 * c) = o; }
    asm volatile("s_waitcnt lgkmcnt(0)" ::: "memory");
}
__device__ __forceinline__ void phase_prep_small(Frame& F) {
    const Params& P = *F.P;
    LAS float* scr = (LAS float*)(F.lds + F.wave * 16384);
    constexpr int I_IN = 16 * 72, I_UQ = 6 * 24, I_UKV = 4 * 32, I_OUT = 16 * 32, I_PG = 16 * 32, I_PE = 4 * 32, I_L = I_IN + I_UQ + I_UKV + I_OUT + I_PG + I_PE;
    for (int it = F.gw(); it < NLAYER * I_L; it += F.ngw()) {
        const int l = it / I_L; int r = it % I_L;
        unsigned char* wb = F.ws + WS_WSM + (size_t)l * WSM_STRIDE;
        if (r < I_IN) { const int kb = r / 72, gi = r % 72, n0 = gi * 32; int src;
            if (n0 < 1536) src = n0; else if (n0 < 1792) src = 1920 + (n0 - 1536); else if (n0 < 2176) src = 1536 + (n0 - 1792); else if (n0 < 2208) src = n0; else src = -1;
            prep_item(P.in[4] + (size_t)l * DM * INC, INC, src, P.in[3] + l * DM, (bf16_t*)(wb + WSM_IN) + (size_t)n0 * DM, DM, kb * 64, scr, F.lane); continue; }
        r -= I_IN;
        if (r < I_UQ) { const int kb = r / 24, n0 = (r % 24) * 32;
            prep_item(P.in[6] + (size_t)l * QRANK * 768, 768, n0, P.in[5] + l * QRANK, (bf16_t*)(wb + WSM_UQ) + (size_t)n0 * QRANK, QRANK, kb * 64, scr, F.lane); continue; }
        r -= I_UQ;
        if (r < I_UKV) { const int kb = r / 32, n0 = (r % 32) * 32; const int hh = (n0 & 511) >> 6, d = n0 & 63; const int src = hh * 128 + (n0 >= 512 ? 64 : 0) + d;
            prep_item(P.in[8] + (size_t)l * KVRANK * 1024, 1024, src, P.in[7] + l * KVRANK, (bf16_t*)(wb + WSM_UKV) + (size_t)n0 * KVRANK, KVRANK, kb * 64, scr, F.lane); continue; }
        r -= I_UKV;
        if (r < I_OUT) { const int kb = r / 32, n0 = (r % 32) * 32; const int k0 = kb * 64;
            const float* g = k0 < 512 ? P.in[9] + l * 512 : P.in[10] + l * 512 - 512;
            prep_item(P.in[11] + (size_t)l * DM * DM, DM, n0, g, (bf16_t*)(wb + WSM_OUT) + (size_t)n0 * DM, DM, k0, scr, F.lane); continue; }
        r -= I_OUT;
        if (r < I_PG) { const int kb = r / 32, n0 = (r % 32) * 32;
            prep_item(P.in[21] + (size_t)l * DM * DM, DM, n0, P.in[20] + l * DM, (bf16_t*)(wb + WSM_PG) + (size_t)n0 * DM, DM, kb * 64, scr, F.lane); continue; }
        r -= I_PG;
        { const int kb = r / 32, n0 = (r % 32) * 32;
            prep_item(P.in[22] + (size_t)l * DPLE * DM, DM, n0, nullptr, (bf16_t*)(wb + WSM_PE) + (size_t)n0 * DPLE, DPLE, kb * 64, scr, F.lane); }
    }
    bf16_t* WRT = wsp<bf16_t>(F, WS_WR);
    for (int i = F.bx * NTHREADS + F.tid; i < NLAYER * 36 * DM; i += F.G * NTHREADS) {
        const int l = i / (36 * DM), c = (i / DM) % 36, k = i % DM;
        const float w = (c < 32 ? P.in[15][((size_t)l * DM + k) * 32 + c] : P.in[13][((size_t)l * DM + k) * 4 + (c - 32)]) * P.in[12][l * DM + k];
        const unsigned hb = f2bf(w); const float lo = w - bf2f(hb);
        bf16_t* tb = WRT + (size_t)l * (2 * RT_STRIDE / 2);
        tb[c * RT_PITCH + k] = (bf16_t)hb; tb[RT_STRIDE / 2 + c * RT_PITCH + k] = (bf16_t)f2bf(lo);
    }
    float* COS = wsp<float>(F, WS_COS); float* SIN = wsp<float>(F, WS_SIN); const int* pos = (const int*)P.in[2];
    for (int i = F.bx * NTHREADS + F.tid; i < T * 16; i += F.G * NTHREADS) {
        const float ang = (float)pos[i >> 4] * P.inv_freq[i & 15];
        const double a = (double)ang; const double q = __builtin_rint(a * 0.63661977236758134308);
        double r = __builtin_fma(-q, 1.57079632679489655800, a); r = __builtin_fma(-q, 6.12323399573676603587e-17, r);
        const double z = r * r;
        const double sp = r + r * z * (-0.166666666416265235595 + z * (0.0083333293858894631756 + z * (-0.000198393348360966317347 + z * 0.0000027183114939898219064)));
        const double cp = 1.0 + z * (-0.499999997251031003120 + z * (0.0416666233237390631894 + z * (-0.00138867637746099294692 + z * 0.0000243904487962774090654)));
        const int qi = (int)((long long)q & 3);
        const double sv = (qi == 0) ? sp : (qi == 1) ? cp : (qi == 2) ? -sp : -cp;
        const double cv = (qi == 0) ? cp : (qi == 1) ? -sp : (qi == 2) ? -cp : sp;
        COS[i] = (float)cv; SIN[i] = (float)sv;
    }
}
__device__ __forceinline__ void prep_item64(const float* W, int ldw, int srccol0, const float* g, bf16_t* dstrow0, int K, int k0, LAS float* scr, int lane) {
    f32x4 v[16];
    const int kq = lane >> 4, n4 = (lane & 15) * 4;
#pragma unroll
    for (int i = 0; i < 16; ++i) v[i] = __builtin_nontemporal_load((const f32x4*)(W + (size_t)(k0 + 4 * i + kq) * ldw + srccol0 + n4));
#pragma unroll
    for (int i = 0; i < 16; ++i) { const float gg = g ? g[k0 + 4 * i + kq] : 1.f; LAS float* d = scr + (4 * i + kq) * 65 + n4; d[0] = v[i][0] * gg; d[1] = v[i][1] * gg; d[2] = v[i][2] * gg; d[3] = v[i][3] * gg; }
    asm volatile("s_waitcnt lgkmcnt(0)" ::: "memory");
    const int c = lane & 7;
#pragma unroll
    for (int j = 0; j < 8; ++j) { const int n = (lane >> 3) + 8 * j; const LAS float* s = scr + (8 * c) * 65 + n;
        u32x4 o; o.x = pk2(s[0 * 65], s[1 * 65]); o.y = pk2(s[2 * 65], s[3 * 65]); o.z = pk2(s[4 * 65], s[5 * 65]); o.w = pk2(s[6 * 65], s[7 * 65]);
        *(u32x4*)(dstrow0 + (size_t)n * K + k0 + 8 * c) = o; }
    asm volatile("s_waitcnt lgkmcnt(0)" ::: "memory");
}
__device__ __forceinline__ void phase_prep_moe(Frame& F, int l) {
    const Params& P = *F.P;
    LAS float* scr = (LAS float*)(F.lds + F.wave * 16640);
    constexpr int I_G1 = 16 * 8, I_DN = 4 * 16, I_E = I_G1 + I_DN;
    bf16_t* WG1 = wsp<bf16_t>(F, WS_WG1); bf16_t* WD = wsp<bf16_t>(F, WS_WD);
    const int nextra = ((T / 256) * (INP / 256)) % F.G, nlight = F.G - nextra;
    const int slots = (nextra ? nextra : 0) * NWAVES + nlight * NWAVES * (nextra ? 5 : 1);
    const bool light = F.bx >= nextra; const int mult = (light && nextra) ? 5 : 1;
    const int base = light ? nextra * NWAVES + ((F.bx - nextra) * NWAVES + F.wave) * mult : F.bx * NWAVES + F.wave;
    for (int rnd = 0; rnd * slots < NEXP * I_E; ++rnd)
      for (int k = 0; k < mult; ++k) {
        const int it = rnd * slots + base + k; if (it >= NEXP * I_E) break;
        const int e = it / I_E; int r = it % I_E;
        if (r < I_G1) { const int kb = r >> 3, n0 = (r & 7) * 64; const int pn = n0 >> 8, c = n0 & 255;
            const float* W = (c < 128 ? P.in[17] : P.in[18]) + ((size_t)l * NEXP + e) * DM * DEXP; const int src = pn * 128 + (c & 127);
            prep_item64(W, DEXP, src, P.in[12] + l * DM, WG1 + ((size_t)e * 512 + n0) * DM, DM, kb * 64, scr, F.lane); }
        else { r -= I_G1; const int kb = r >> 4, n0 = (r & 15) * 64;
            prep_item64(P.in[19] + ((size_t)l * NEXP + e) * DEXP * DM, DM, n0, nullptr, WD + ((size_t)e * DM + n0) * DEXP, DEXP, kb * 64, scr, F.lane); }
      }
}

__device__ __forceinline__ void phase_norm(Frame& F, const float* hin) {
    bf16_t* HB = wsp<bf16_t>(F, WS_HBI); float* SSQ = wsp<float>(F, WS_SSQ);
    for (int row = F.gw(); row < T; row += F.ngw()) {
        const f32x4* xr = (const f32x4*)(hin + (size_t)row * DM) + F.lane; f32x4 v[4]; float s = 0.f;
#pragma unroll
        for (int j = 0; j < 4; ++j) { v[j] = xr[64 * j]; s += (v[j][0] * v[j][0] + v[j][1] * v[j][1]) + (v[j][2] * v[j][2] + v[j][3] * v[j][3]); }
        s = wave_sum(s);
        u32x2* o = (u32x2*)(HB + (size_t)row * DM) + F.lane;
#pragma unroll
        for (int j = 0; j < 4; ++j) o[64 * j] = (u32x2){pk2(v[j][0], v[j][1]), pk2(v[j][2], v[j][3])};
        if (F.lane < 16) SSQ[(size_t)row * 16 + F.lane] = F.lane == 0 ? s : 0.f;
    }
}
__device__ __forceinline__ void lds_dma16(const void* g, LAS unsigned char* l) {
    unsigned keep; const unsigned dst = (unsigned)__builtin_amdgcn_readfirstlane((int)(unsigned)(uintptr_t)l);
    asm volatile("s_mov_b32 %0, m0\n\ts_mov_b32 m0, %2\n\ts_nop 0\n\tglobal_load_lds_dwordx4 %1, off\n\ts_mov_b32 m0, %0" : "=&s"(keep) : "v"(g), "s"(dst) : "memory"); }
__device__ __forceinline__ void phase_route(Frame& F, int l, bool dummy = false) {
    const Params& P = *F.P; bf16_t* PB = wsp<bf16_t>(F, WS_PB); const float* pl = P.in[1] + (size_t)l * T * DPLE;
    const char* WRT = (const char*)(F.ws + WS_WR) + (size_t)l * 2 * RT_STRIDE;
    const bf16_t* HB = wsp<bf16_t>(F, WS_HB); float* RS = wsp<float>(F, WS_RS);
    unsigned* cnt = wsp<unsigned>(F, WS_CTL) + CW_CNT + 64 * 32 * (dummy ? NLAYER + l : l); int* liste = dummy ? wsp<int>(F, WS_Y) : wsp<int>(F, WS_LISTE); float* listw = dummy ? wsp<float>(F, WS_Y + 4 * MiB) : wsp<float>(F, WS_LISTW);
    const float* brg = P.in[14] + l * 4; const float* bre = P.in[16] + l * 32;
    constexpr int SC_OFF = RT_STRIDE, SC_WAVE = 16 * 49 * 4, RK_OFF = SC_OFF + NWAVES * SC_WAVE;
    LAS unsigned* lcnt = (LAS unsigned*)(F.lds + RK_OFF); LAS unsigned* lbase = lcnt + 32; LAS unsigned* ent = lcnt + 64;
    LAS float* sc = (LAS float*)(F.lds + SC_OFF + F.wave * SC_WAVE);
    const int step = F.ngw(), ri = F.lane & 15, kq = F.lane >> 4;
    for (int pc = F.wave; pc < 73; pc += NWAVES) lds_dma16(WRT + (size_t)pc * 1024 + F.lane * 16, F.lds + pc * 1024);
    if (F.tid < 32) lcnt[F.tid] = 0u;
    int nent = 0;
    for (int row0 = F.gw(); row0 < T; row0 += 16 * step) {
        const int myrow = row0 + ri * step; const bool rv = myrow < T;
        const bf16_t* xr = HB + (size_t)(rv ? myrow : row0) * DM + 8 * kq;
        bf16x8 af[32]; float ssq = 0.f;
#pragma unroll
        for (int sI = 0; sI < 32; ++sI) af[sI] = *(const bf16x8*)(xr + 32 * sI);
        if (rv) {
#pragma unroll
            for (int q = 0; q < 4; ++q) { const float* pp = pl + (size_t)myrow * DPLE + 64 * kq + 16 * q; const f32x4 a = ((const f32x4*)pp)[0], b2 = ((const f32x4*)pp)[1], c2 = ((const f32x4*)pp)[2], d2 = ((const f32x4*)pp)[3];
                u32x4* dst = (u32x4*)(PB + (size_t)myrow * DPLE + 64 * kq + 16 * q); dst[0] = pack8(a, b2); dst[1] = pack8(c2, d2); } }
#pragma unroll
        for (int sI = 0; sI < 32; ++sI) { float f[8]; unpack8(__builtin_bit_cast(u32x4, af[sI]), f);
#pragma unroll
            for (int i = 0; i < 8; ++i) ssq += f[i] * f[i]; }
        ssq += xor16(ssq); ssq += xor32(ssq);
        f32x4 acc[3] = {{0.f, 0.f, 0.f, 0.f}, {0.f, 0.f, 0.f, 0.f}, {0.f, 0.f, 0.f, 0.f}};
#pragma unroll 1
        for (int pass = 0; pass < 2; ++pass) {
            asm volatile("s_waitcnt vmcnt(0)" ::: "memory"); __syncthreads();
            const LAS unsigned char* tb = F.lds + (size_t)ri * (RT_PITCH * 2) + kq * 16;
#pragma unroll
            for (int sI = 0; sI < 32; ++sI) {
#pragma unroll
                for (int blk = 0; blk < 3; ++blk) { const int cb = blk < 2 ? blk * 16 : 20;
                    const bf16x8 bfr = *(const LAS bf16x8*)(tb + (size_t)cb * (RT_PITCH * 2) + sI * 64);
                    acc[blk] = __builtin_amdgcn_mfma_f32_16x16x32_bf16(af[sI], bfr, acc[blk], 0, 0, 0); }
            }
            __syncthreads();
            if (pass == 0) { for (int pc = F.wave; pc < 73; pc += NWAVES) lds_dma16(WRT + RT_STRIDE + (size_t)pc * 1024 + F.lane * 16, F.lds + pc * 1024); }
            else if (row0 + 16 * step < T) { for (int pc = F.wave; pc < 73; pc += NWAVES) lds_dma16(WRT + (size_t)pc * 1024 + F.lane * 16, F.lds + pc * 1024); }
        }
#pragma unroll
        for (int blk = 0; blk < 3; ++blk)
#pragma unroll
            for (int i = 0; i < 4; ++i) sc[(4 * kq + i) * 49 + 16 * blk + ri] = acc[blk][i];
        asm volatile("s_waitcnt lgkmcnt(0)" ::: "memory");
        if (F.lane < 16 && rv) {
            const LAS float* lr = sc + F.lane * 49;
            const float rs = 1.0f / sqrtf(ssq * (1.f / DM) + EPS);
            const float g0 = lr[44] * rs + brg[0], g1 = lr[45] * rs + brg[1], g2 = lr[46] * rs + brg[2], g3 = lr[47] * rs + brg[3];
            int g = 0; float gm = g0; if (g1 > gm) { gm = g1; g = 1; } if (g2 > gm) { gm = g2; g = 2; } if (g3 > gm) { gm = g3; g = 3; }
            const float gp = 1.0f / (fexp2((g0 - gm) * LOG2E) + fexp2((g1 - gm) * LOG2E) + fexp2((g2 - gm) * LOG2E) + fexp2((g3 - gm) * LOG2E));
            float le[8];
#pragma unroll
            for (int q = 0; q < 8; ++q) le[q] = lr[8 * g + q] * rs + bre[8 * g + q];
            int i1 = 0; float l1 = le[0];
#pragma unroll
            for (int j = 1; j < 8; ++j) if (le[j] > l1) { l1 = le[j]; i1 = j; }
            int i2 = (i1 == 0) ? 1 : 0; float l2 = (i1 == 0) ? le[1] : le[0];
#pragma unroll
            for (int j = 1; j < 8; ++j) if (j != i1 && le[j] > l2) { l2 = le[j]; i2 = j; }
            const float e2 = fexp2((l2 - l1) * LOG2E); const float w1 = gp / (1.f + e2), w2 = gp * e2 / (1.f + e2);
            const int ea = g * 8 + i1, eb = g * 8 + i2;
            RS[myrow] = rs;
            if (nent == 0) {
                const unsigned pa = atomicAdd((unsigned*)(lcnt + ea), 1u), pb = atomicAdd((unsigned*)(lcnt + eb), 1u);
                LAS unsigned* en = ent + (size_t)(F.wave * 32 + F.lane * 2) * 4;
                en[0] = (unsigned)ea; en[1] = pa; en[2] = (unsigned)(myrow * 2); en[3] = __float_as_uint(w1);
                en[4] = (unsigned)eb; en[5] = pb; en[6] = (unsigned)(myrow * 2 + 1); en[7] = __float_as_uint(w2);
            } else {
                const unsigned pa = atomicAdd(cnt + 64 * ea, 1u); liste[(size_t)ea * T + pa] = myrow * 2; listw[(size_t)ea * T + pa] = w1;
                const unsigned pb = atomicAdd(cnt + 64 * eb, 1u); liste[(size_t)eb * T + pb] = myrow * 2 + 1; listw[(size_t)eb * T + pb] = w2;
            }
        }
        if (nent == 0) { int nv = 0; for (int r = 0; r < 16; ++r) nv += (row0 + r * step < T) ? 1 : 0; nent = nv > 0 ? nv : 1; }
    }
    asm volatile("s_waitcnt vmcnt(0) lgkmcnt(0)" ::: "memory");
    __syncthreads();
    if (F.tid < 32) lbase[F.tid] = lcnt[F.tid] ? atomicAdd(cnt + 64 * F.tid, lcnt[F.tid]) : 0u;
    __syncthreads();
    { const int r = F.lane >> 1; const bool v = F.lane < 32 && (F.gw() + r * step < T);
      if (v) { const LAS unsigned* en = ent + (size_t)(F.wave * 32 + F.lane) * 4;
          const size_t li = (size_t)en[0] * T + lbase[en[0]] + en[1];
          liste[li] = (int)en[2]; listw[li] = __uint_as_float(en[3]); } }
}
__device__ __forceinline__ void phase_norm2(Frame& F, int l, float ysc) {
    bf16_t* HB = wsp<bf16_t>(F, WS_HB); float* RS = wsp<float>(F, WS_RS); const bf16_t* Y = wsp<bf16_t>(F, WS_Y);
    for (int row = F.gw(); row < T; row += F.ngw()) {
        u32x2* xr = (u32x2*)(HB + (size_t)row * DM) + F.lane; float s = 0.f;
        const u32x2* y0 = (const u32x2*)(Y + (size_t)row * 2 * DM) + F.lane; const u32x2* y1 = y0 + DM / 4;
        u32x2 hw[4], ya[4], yb[4];
#pragma unroll
        for (int j = 0; j < 4; ++j) { hw[j] = xr[64 * j]; ya[j] = y0[64 * j]; yb[j] = y1[64 * j]; }
#pragma unroll
        for (int j = 0; j < 4; ++j) { const u32x2 a = ya[j], b = yb[j];
            float v0 = bf2f(hw[j].x & 0xffffu) + ysc * (bf2f(a.x & 0xffffu) + bf2f(b.x & 0xffffu)), v1 = bf2f(hw[j].x >> 16) + ysc * (bf2f(a.x >> 16) + bf2f(b.x >> 16));
            float v2 = bf2f(hw[j].y & 0xffffu) + ysc * (bf2f(a.y & 0xffffu) + bf2f(b.y & 0xffffu)), v3 = bf2f(hw[j].y >> 16) + ysc * (bf2f(a.y >> 16) + bf2f(b.y >> 16));
            const u32x2 o = (u32x2){pk2(v0, v1), pk2(v2, v3)}; xr[64 * j] = o;
            v0 = bf2f(o.x & 0xffffu); v1 = bf2f(o.x >> 16); v2 = bf2f(o.y & 0xffffu); v3 = bf2f(o.y >> 16);
            s += (v0 * v0 + v1 * v1) + (v2 * v2 + v3 * v3); }
        s = wave_sum(s);
        if (F.lane == 0) RS[row] = 1.0f / sqrtf(s * (1.f / DM) + EPS);
    }
}
__device__ __forceinline__ void phase_final(Frame& F) {
    const Params& P = *F.P; const bf16_t* H = wsp<bf16_t>(F, WS_HBI); const float* g = P.in[23];
    for (int row = F.gw(); row < T; row += F.ngw()) {
        const u32x2* xr = (const u32x2*)(H + (size_t)row * DM) + F.lane; f32x4 v[4]; float s = 0.f;
#pragma unroll
        for (int j = 0; j < 4; ++j) { const u32x2 w = xr[64 * j]; v[j] = (f32x4){bf2f(w.x & 0xffffu), bf2f(w.x >> 16), bf2f(w.y & 0xffffu), bf2f(w.y >> 16)}; s += (v[j][0] * v[j][0] + v[j][1] * v[j][1]) + (v[j][2] * v[j][2] + v[j][3] * v[j][3]); }
        s = wave_sum(s); const float rs = 1.0f / sqrtf(s * (1.f / DM) + EPS);
        f32x4* o = (f32x4*)(P.out + (size_t)row * DM) + F.lane;
#pragma unroll
        for (int j = 0; j < 4; ++j) o[64 * j] = v[j] * rs * ((const f32x4*)g)[F.lane + 64 * j];
    }
}

namespace att {
typedef float f32x16 __attribute__((ext_vector_type(16)));
typedef short s16x4 __attribute__((ext_vector_type(4)));
typedef short v4i16_t __attribute__((ext_vector_type(4)));
typedef __bf16 bf16x2_t __attribute__((ext_vector_type(2)));
constexpr int NS = 6, PF = 5;
constexpr int FLAG_OFF = 131072 + 512;
__device__ __forceinline__ int crow(int r, int hi) { return (r & 3) + 8 * (r >> 2) + 4 * hi; }
__device__ __forceinline__ unsigned cvtpk(float lo, float hi) { f32x2 v = {lo, hi}; bf16x2_t b = __builtin_convertvector(v, bf16x2_t); return __builtin_bit_cast(unsigned, b); }
__device__ __forceinline__ s16x4 vtr(const LAS unsigned char* p) { return __builtin_bit_cast(s16x4, __builtin_amdgcn_ds_read_tr16_b64_v4i16((LAS v4i16_t*)p)); }
__device__ __forceinline__ void dma16(const void* g, LAS unsigned char* l) {
    unsigned keep; const unsigned dst = (unsigned)__builtin_amdgcn_readfirstlane((int)(unsigned)(uintptr_t)l);
    asm volatile("s_mov_b32 %0, m0\n\ts_mov_b32 m0, %2\n\ts_nop 0\n\tglobal_load_lds_dwordx4 %1, off\n\ts_mov_b32 m0, %0" : "=&s"(keep) : "v"(g), "s"(dst) : "memory"); }
__device__ __forceinline__ float vmul(float a, float b) { float r; asm("v_mul_f32 %0, %1, %2" : "=v"(r) : "v"(a), "v"(b)); return r; }
__device__ __forceinline__ float vsub(float a, float b) { float r; asm("v_sub_f32 %0, %1, %2" : "=v"(r) : "v"(a), "v"(b)); return r; }
__device__ __forceinline__ float vadd(float a, float b) { float r; asm("v_add_f32 %0, %1, %2" : "=v"(r) : "v"(a), "v"(b)); return r; }
__device__ __forceinline__ float swap32(float x) { auto rr = __builtin_amdgcn_permlane32_swap(__float_as_uint(x), __float_as_uint(x), false, false); return __uint_as_float(((unsigned)(threadIdx.x & 32)) ? rr[0] : rr[1]); }
__device__ __forceinline__ float swap_sel(float a, float b) { auto rr = __builtin_amdgcn_permlane32_swap(__float_as_uint(a), __float_as_uint(b), false, false); return __uint_as_float(((unsigned)(threadIdx.x & 32)) ? rr[0] : rr[1]); }
#define ATT_WAIT_BAR(N) asm volatile("s_waitcnt vmcnt(%0) lgkmcnt(0)\n\ts_barrier" :: "n"(N) : "memory")
__device__ __forceinline__ bf16x8 pfrag(const f32x16& w, int b8) { u32x4 u; u.x = cvtpk(w[b8], w[b8 + 1]); u.y = cvtpk(w[b8 + 2], w[b8 + 3]); u.z = cvtpk(w[b8 + 4], w[b8 + 5]); u.w = cvtpk(w[b8 + 6], w[b8 + 7]); return __builtin_bit_cast(bf16x8, u); }
#define VTR_(dst, OFF) asm volatile("ds_read_b64_tr_b16 %0, %1 offset:" #OFF : "=v"(dst) : "v"(a_))
#define VLD_(i, O0, O1) do { u32x2 lo_, hi_; VTR_(lo_, O0); VTR_(hi_, O1); vf[i] = __builtin_bit_cast(bf16x8, (u32x4){lo_.x, lo_.y, hi_.x, hi_.y}); } while (0)
__device__ __forceinline__ void v_load(bf16x8 (&vf)[8], const LAS unsigned char* vp) {
    const unsigned a_ = (unsigned)(uintptr_t)vp;
    VLD_(0, 0, 512);    VLD_(1, 4096, 4608);
    VLD_(2, 1024, 1536); VLD_(3, 5120, 5632);
    VLD_(4, 2048, 2560); VLD_(5, 6144, 6656);
    VLD_(6, 3072, 3584); VLD_(7, 7168, 7680);
}
#undef VLD_
#undef VTR_
#define V_WAIT(vf) asm volatile("s_waitcnt lgkmcnt(0)" : "+v"(vf[0]), "+v"(vf[1]), "+v"(vf[2]), "+v"(vf[3]), "+v"(vf[4]), "+v"(vf[5]), "+v"(vf[6]), "+v"(vf[7]))
__device__ __forceinline__ void pv_tile(f32x16& o0, f32x16& o1, const bf16x8 (&vf)[8], const f32x16& w0, const f32x16& w1) {
#pragma unroll
    for (int ks = 0; ks < 4; ++ks) {
        const bf16x8 pf = pfrag(ks < 2 ? w0 : w1, 8 * (ks & 1));
        o0 = __builtin_amdgcn_mfma_f32_32x32x16_bf16(vf[2 * ks], pf, o0, 0, 0, 0);
        o1 = __builtin_amdgcn_mfma_f32_32x32x16_bf16(vf[2 * ks + 1], pf, o1, 0, 0, 0);
    }
}
__device__ __forceinline__ void store_o(bf16_t* orow, const f32x16& o0, const f32x16& o1, int hi, float sc, float* oss) {
    float sq = 0.f;
#pragma unroll
    for (int r = 0; r < 16; ++r) sq += o0[r] * o0[r] + o1[r] * o1[r];
    sq = (sq + xor32(sq)) * (sc * sc);
    if (hi == 0) *(GAS float*)oss = sq;
#pragma unroll
    for (int half = 0; half < 2; ++half) {
        const f32x16& o = half ? o1 : o0;
#pragma unroll
        for (int k = 0; k < 4; k += 2) {
            unsigned ax = cvtpk(o[4 * k] * sc, o[4 * k + 1] * sc), ay = cvtpk(o[4 * k + 2] * sc, o[4 * k + 3] * sc);
            unsigned bx = cvtpk(o[4 * k + 4] * sc, o[4 * k + 5] * sc), by = cvtpk(o[4 * k + 6] * sc, o[4 * k + 7] * sc);
            { auto r = __builtin_amdgcn_permlane32_swap(ax, bx, false, false); ax = r[0]; bx = r[1]; }
            { auto r = __builtin_amdgcn_permlane32_swap(ay, by, false, false); ay = r[0]; by = r[1]; }
            *(GAS u32x4*)(orow + 32 * half + 8 * k + 8 * hi) = (u32x4){ax, ay, bx, by};
        }
    }
}

template <bool DIAG> __device__ __forceinline__ void sb_tile(const LAS unsigned char* ks, int vpo, const bf16x8 (&qr)[4], f32x16& o0, f32x16& o1, float& carry, int kb, int q, int r32, int hi) {
    f32x16 z0 = {}, z1 = {};
    bf16x8 kf[8], vf[8];
#pragma unroll
    for (int d0 = 0; d0 < 4; ++d0) { kf[2 * d0] = *(const LAS bf16x8*)(ks + (2 * d0 + hi) * 1024 + r32 * 16); kf[2 * d0 + 1] = *(const LAS bf16x8*)(ks + (2 * d0 + hi) * 1024 + 512 + r32 * 16); }
    __builtin_amdgcn_sched_barrier(0);
#pragma unroll
    for (int d0 = 0; d0 < 4; ++d0) { z0 = __builtin_amdgcn_mfma_f32_32x32x16_bf16(kf[2 * d0], qr[d0], z0, 0, 0, 0); z1 = __builtin_amdgcn_mfma_f32_32x32x16_bf16(kf[2 * d0 + 1], qr[d0], z1, 0, 0, 0); }
    v_load(vf, ks + 8192 + vpo);
    __builtin_amdgcn_sched_barrier(0);
    f32x16 s0, s1;
#pragma unroll
    for (int r = 0; r < 16; ++r) { s0[r] = frcp(1.f + fexp2(z0[r])); s1[r] = frcp(1.f + fexp2(z1[r])); }
    asm volatile("s_nop 0" : "+v"(s0), "+v"(s1));
    if (DIAG) {
        const int dq = q - kb - 4 * hi;
#pragma unroll
        for (int r = 0; r < 16; ++r) { if (crow(r, 0) >= dq) s0[r] = 1.f; if (32 + crow(r, 0) >= dq) s1[r] = 1.f; }
    }
#pragma unroll
    for (int g = 0; g < 4; ++g) {
        s0[4 * g + 2] = vmul(s0[4 * g + 2], s0[4 * g + 3]); s0[4 * g + 1] = vmul(s0[4 * g + 1], s0[4 * g + 2]); s0[4 * g] = vmul(s0[4 * g], s0[4 * g + 1]);
        s1[4 * g + 2] = vmul(s1[4 * g + 2], s1[4 * g + 3]); s1[4 * g + 1] = vmul(s1[4 * g + 1], s1[4 * g + 2]); s1[4 * g] = vmul(s1[4 * g], s1[4 * g + 1]);
    }
    float I[9]; I[8] = 1.f; I[7] = s1[12];
#pragma unroll
    for (int g = 6; g >= 0; --g) I[g] = vmul(I[g + 1], g < 4 ? s0[4 * g] : s1[4 * (g - 4)]);
    float off[8];
#pragma unroll
    for (int g = 0; g < 8; ++g) {
        const float x = swap_sel(I[g], I[g + 1]);
        off[g] = (g == 7) ? vmul(carry, x) : vmul(vmul(carry, I[g + 1]), x);
    }
    carry = vmul(carry, vmul(I[0], swap32(I[0])));
    f32x16 w0, w1;
#pragma unroll
    for (int g = 0; g < 4; ++g) {
        { const float o = off[g]; const float S3 = vmul(s0[4 * g + 3], o), S2 = vmul(s0[4 * g + 2], o), S1 = vmul(s0[4 * g + 1], o), S0 = vmul(s0[4 * g], o);
          w0[4 * g + 3] = vsub(o, S3); w0[4 * g + 2] = vsub(S3, S2); w0[4 * g + 1] = vsub(S2, S1); w0[4 * g] = vsub(S1, S0); }
        { const float o = off[4 + g]; const float S3 = vmul(s1[4 * g + 3], o), S2 = vmul(s1[4 * g + 2], o), S1 = vmul(s1[4 * g + 1], o), S0 = vmul(s1[4 * g], o);
          w1[4 * g + 3] = vsub(o, S3); w1[4 * g + 2] = vsub(S3, S2); w1[4 * g + 1] = vsub(S2, S1); w1[4 * g] = vsub(S1, S0); }
    }
    V_WAIT(vf);
    pv_tile(o0, o1, vf, w0, w1);
}
__device__ __forceinline__ void sb_unit(LAS unsigned char* lds, int tid, const bf16_t* QKV, bf16_t* OA, float* OSS, int b, int h, int qb) {
    asm volatile("" : "+v"(tid));
    const int lane = tid & 63, r32 = lane & 31, hi = lane >> 5, wid = __builtin_amdgcn_readfirstlane(tid >> 6);
    const size_t rowb = (size_t)b * SEQ; const int q0 = qb * 256;
    const bf16_t* Qw = QKV + (rowb + q0 + wid * 32) * 1536 + h * 64;
    const bf16_t* Kh = QKV + rowb * 1536 + 512 + h * 64; const bf16_t* Vh = Kh + 512;
    const int kt_hi = (q0 >> 6) + 3, NT = kt_hi + 1, jd = 3 - (wid >> 1);
    const bf16_t* ksrc = Kh + (size_t)lane * 1536 + wid * 8;
    const bf16_t* vsrc = Vh + (size_t)(16 * (wid & 3) + (lane >> 2)) * 1536 + (wid >> 2) * 32 + (lane & 3) * 8;
#define SB_ISSUE(j) do { int kt_ = kt_hi - (j); kt_ = kt_ < 0 ? 0 : kt_; LAS unsigned char* sl_ = lds + ((j) % NS) * 16384 + wid * 1024; \
        dma16(ksrc + (size_t)kt_ * 64 * 1536, sl_); dma16(vsrc + (size_t)kt_ * 64 * 1536, sl_ + 8192); } while (0)
    bf16x8 qr[4];
#pragma unroll
    for (int d0 = 0; d0 < 4; ++d0) qr[d0] = *(const GAS bf16x8*)(Qw + (size_t)r32 * 1536 + d0 * 16 + hi * 8);
#pragma unroll
    for (int j = 0; j < PF; ++j) SB_ISSUE(j);
    asm volatile("" : "+v"(qr[0]), "+v"(qr[1]), "+v"(qr[2]), "+v"(qr[3]));
    f32x16 o0 = {}, o1 = {}; float carry = 1.f; bool mydone = false;
    const int q = q0 + wid * 32 + r32;
    volatile LAS unsigned* flags = (volatile LAS unsigned*)(lds + FLAG_OFF);
    const int vpo = ((lane >> 4) & 1) * 32 + (lane & 3) * 8 + (4 * hi + ((lane & 15) >> 2)) * 64;
    for (int j = 0; j < NT; ++j) {
        ATT_WAIT_BAR(2);
        if (j >= 1) { const u32x4 fa = *(const LAS u32x4*)(lds + FLAG_OFF + ((j - 1) & 1) * 32), fb = *(const LAS u32x4*)(lds + FLAG_OFF + ((j - 1) & 1) * 32 + 16);
            if ((fa.x & fa.y & fa.z & fa.w & fb.x & fb.y & fb.z & fb.w) != 0u) break; }
        SB_ISSUE(j + PF);
        const int tj = j + jd;
        if (tj < NT && !mydone) {
            const LAS unsigned char* ks = lds + (tj % NS) * 16384; const int kb = (kt_hi - tj) * 64;
            if (j == 0) sb_tile<true>(ks, vpo, qr, o0, o1, carry, kb, q, r32, hi); else sb_tile<false>(ks, vpo, qr, o0, o1, carry, kb, q, r32, hi);
        }
        mydone = __all(carry < 1.17549435e-38f) || (tj + 1 >= NT);
        if (lane == 0) flags[(j & 1) * 8 + wid] = mydone ? 1u : 0u;
    }
    store_o(OA + (rowb + q) * DM + h * 64, o0, o1, hi, 1.f, OSS + (rowb + q) * 16 + h);
    asm volatile("s_waitcnt lgkmcnt(0)\n\ts_barrier" ::: "memory");
#undef SB_ISSUE
}

__device__ __forceinline__ void mla_kload(bf16x8 (&kf)[12], const LAS unsigned char* ks, int r32, int hi, int g) {
#pragma unroll
    for (int i = 0; i < 2; ++i) { const int d0 = 2 * g + i; kf[2 * d0] = *(const LAS bf16x8*)(ks + (2 * d0 + hi) * 1024 + r32 * 16); kf[2 * d0 + 1] = *(const LAS bf16x8*)(ks + (2 * d0 + hi) * 1024 + 512 + r32 * 16); }
}
struct AU { int b, h, qb; };
constexpr int MLA_SLOT = 20480;
__device__ __forceinline__ void mla_issue(LAS unsigned char* lds, int wid, const bf16_t* ksrc, const bf16_t* rsrc, const bf16_t* vsrc, int kt) {
    LAS unsigned char* sl_ = lds + (kt % NS) * MLA_SLOT;
    dma16(ksrc + (size_t)kt * 64 * 512, sl_ + wid * 1024); if (wid < 4) dma16(rsrc + (size_t)kt * 64 * 32, sl_ + (8 + wid) * 1024);
    dma16(vsrc + (size_t)kt * 64 * 512, sl_ + 12288 + wid * 1024);
}
#define MLA_ADDR(u) const int lane = tid & 63, r32 = lane & 31, hi = lane >> 5, wid = __builtin_amdgcn_readfirstlane(tid >> 6); \
    const size_t rowb = (size_t)(u).b * SEQ; const int q0 = (u).qb * 256, h = (u).h; \
    const int NT = (q0 >> 6) + 4; \
    const bf16_t* ksrc = KN + (rowb + lane) * 512 + h * 64 + wid * 8; \
    const bf16_t* rsrc = KR + (rowb + lane) * 32 + (wid & 3) * 8; \
    const bf16_t* vsrc = VM + (rowb + 16 * (wid & 3) + (lane >> 2)) * 512 + h * 64 + (wid >> 2) * 32 + (lane & 3) * 8;
__device__ __forceinline__ void mla_prologue(LAS unsigned char* lds, int tid, const bf16_t* QM, const bf16_t* KN, const bf16_t* KR, const bf16_t* VM, AU u, bf16x8 (&qr)[6]) {
    asm volatile("" : "+v"(tid));
    MLA_ADDR(u)
    const bf16_t* Qw = QM + (rowb + q0 + wid * 32) * 768 + h * 96;
#pragma unroll
    for (int d0 = 0; d0 < 6; ++d0) qr[d0] = *(const GAS bf16x8*)(Qw + (size_t)r32 * 768 + d0 * 16 + hi * 8);
#pragma unroll
    for (int j = 0; j < 5; ++j) if (j < NT) mla_issue(lds, wid, ksrc, rsrc, vsrc, j);
}
__device__ __forceinline__ void mla_unit(LAS unsigned char* lds, int tid, const bf16_t* QM, const bf16_t* KN, const bf16_t* KR, const bf16_t* VM, bf16_t* OA, float* OSS, AU u, bool has_next, AU nx, bf16x8 (&qr)[6]) {
    asm volatile("" : "+v"(tid));
    MLA_ADDR(u)
    const int mych = (q0 >> 6) + (wid >> 1);
    constexpr int SLOT = MLA_SLOT;
#define MLA_ISSUE(j) mla_issue(lds, wid, ksrc, rsrc, vsrc, (j))
#define MLA_WAITN(n) do { if (wid < 4) ATT_WAIT_BAR(3 * (n)); else ATT_WAIT_BAR(2 * (n)); } while (0)
#define MLA_WAIT_DYN(nf) do { const int nf_ = (nf); if (nf_ >= 3) MLA_WAITN(3); else if (nf_ == 2) MLA_WAITN(2); else if (nf_ == 1) MLA_WAITN(1); else MLA_WAITN(0); } while (0)
    asm volatile("s_waitcnt vmcnt(0)" : "+v"(qr[0]), "+v"(qr[1]), "+v"(qr[2]), "+v"(qr[3]), "+v"(qr[4]), "+v"(qr[5]));
    f32x16 o0 = {}, o1 = {}, negm = {}; float mref = 0.f, lsum = 0.f;
    const int vpo = ((lane >> 4) & 1) * 32 + (lane & 3) * 8 + (4 * hi + ((lane & 15) >> 2)) * 64;
    MLA_WAIT_DYN((NT < 5 ? NT - 1 : 4) - 1);
    if (5 < NT) MLA_ISSUE(5);
    bf16x8 kf[12];
    mla_kload(kf, lds, r32, hi, 0); mla_kload(kf, lds, r32, hi, 1); mla_kload(kf, lds, r32, hi, 2);
    for (int j = 0; j < NT; ++j) {
        const LAS unsigned char* sl = lds + (j % NS) * SLOT; const LAS unsigned char* sn = lds + ((j + 1) % NS) * SLOT;
        if (j <= mych) {
            f32x16 z0, z1;
            z0 = __builtin_amdgcn_mfma_f32_32x32x16_bf16(kf[0], qr[0], negm, 0, 0, 0); z1 = __builtin_amdgcn_mfma_f32_32x32x16_bf16(kf[1], qr[0], negm, 0, 0, 0);
#pragma unroll
            for (int d0 = 1; d0 < 6; ++d0) { z0 = __builtin_amdgcn_mfma_f32_32x32x16_bf16(kf[2 * d0], qr[d0], z0, 0, 0, 0); z1 = __builtin_amdgcn_mfma_f32_32x32x16_bf16(kf[2 * d0 + 1], qr[d0], z1, 0, 0, 0); }
            bf16x8 vf[8];
            v_load(vf, sl + 12288 + vpo);
            __builtin_amdgcn_sched_barrier(0);
#define MLA_MOVE_REF(FIRST) do { float tm = fmaxf(z0[0], z1[0]); _Pragma("unroll") for (int r = 1; r < 16; ++r) tm = fmaxf(tm, fmaxf(z0[r], z1[r])); tm = fmaxf(tm, swap32(tm)); \
                const float dl = (FIRST) ? tm : fmaxf(tm, 0.f); mref += dl; const float al = fexp2(-dl); lsum *= al; \
                _Pragma("unroll") for (int r = 0; r < 16; ++r) { z0[r] -= dl; z1[r] -= dl; negm[r] = -mref; o0[r] *= al; o1[r] *= al; } } while (0)
            if (j == 0) MLA_MOVE_REF(true);
            float one = 1.f; asm("" : "+v"(one));
            float ps = 0.f, pb = 0.f;
#pragma unroll
            for (int r = 0; r < 16; ++r) { z0[r] = fexp2(z0[r]); ps = __builtin_fmaf(z0[r], one, ps); z1[r] = fexp2(z1[r]); pb += z1[r]; }
            ps += pb;
            if (__builtin_expect(__any(!(ps < 1.8446744e19f)), 0)) {
                z0 = __builtin_amdgcn_mfma_f32_32x32x16_bf16(kf[0], qr[0], negm, 0, 0, 0); z1 = __builtin_amdgcn_mfma_f32_32x32x16_bf16(kf[1], qr[0], negm, 0, 0, 0);
#pragma unroll
                for (int d0 = 1; d0 < 6; ++d0) { z0 = __builtin_amdgcn_mfma_f32_32x32x16_bf16(kf[2 * d0], qr[d0], z0, 0, 0, 0); z1 = __builtin_amdgcn_mfma_f32_32x32x16_bf16(kf[2 * d0 + 1], qr[d0], z1, 0, 0, 0); }
                MLA_MOVE_REF(false);
                ps = 0.f;
#pragma unroll
                for (int r = 0; r < 16; ++r) { z0[r] = fexp2(z0[r]); z1[r] = fexp2(z1[r]); ps += z0[r] + z1[r]; }
            }
#undef MLA_MOVE_REF
            lsum += ps;
            __builtin_amdgcn_sched_barrier(0);
            V_WAIT(vf);
#pragma unroll
            for (int ks2 = 0; ks2 < 4; ++ks2) {
                const bf16x8 pf = pfrag(ks2 < 2 ? z0 : z1, 8 * (ks2 & 1));
                o0 = __builtin_amdgcn_mfma_f32_32x32x16_bf16(vf[2 * ks2], pf, o0, 0, 0, 0);
                o1 = __builtin_amdgcn_mfma_f32_32x32x16_bf16(vf[2 * ks2 + 1], pf, o1, 0, 0, 0);
                if (ks2 < 3) mla_kload(kf, sn, r32, hi, ks2);
                __builtin_amdgcn_sched_barrier(0);
            }
        } else if (j + 1 <= mych) {   }
        { const int im = (j + 5 < NT - 1) ? j + 5 : NT - 1; MLA_WAIT_DYN(im - (j + 2)); }
        if (j + 6 < NT) MLA_ISSUE(j + 6);
    }
    lsum += swap32(lsum);
    bf16_t* orow = OA + (rowb + q0 + wid * 32 + r32) * DM + 512 + h * 64; float* oss = OSS + (rowb + q0 + wid * 32 + r32) * 16 + 8 + h; const int hi2 = hi;
    store_o(orow, o0, o1, hi2, 1.0f / lsum, oss);
    asm volatile("s_waitcnt lgkmcnt(0)\n\ts_barrier" ::: "memory");
    if (has_next) mla_prologue(lds, tid, QM, KN, KR, VM, nx, qr);
#undef MLA_ISSUE
#undef MLA_WAITN
#undef MLA_WAIT_DYN
}
}

__device__ __forceinline__ void phase_attn(Frame& F) {
    const bf16_t* QKV = wsp<bf16_t>(F, WS_QKV); bf16_t* OA = wsp<bf16_t>(F, WS_OA); float* OSS = wsp<float>(F, WS_OSS);
    const bf16_t* QM = wsp<bf16_t>(F, WS_QM); const bf16_t* KN = wsp<bf16_t>(F, WS_KN); const bf16_t* KR = wsp<bf16_t>(F, WS_KR); const bf16_t* VM = wsp<bf16_t>(F, WS_VM);
    const int vcu = (F.G % 8 == 0) ? (F.bx % 8) * (F.G / 8) + F.bx / 8 : F.bx;
    { const int nu = vcu < 512 ? 2 * ((512 - vcu + F.G - 1) / F.G) : 0;
      auto unit = [&](int i) { const int p = vcu + (i >> 1) * F.G, bh = p >> 3, s = p & 7; return att::AU{bh >> 3, bh & 7, (i & 1) ? s : 15 - s}; };
      if (nu > 0) {
          bf16x8 qr[6];
          att::mla_prologue(F.lds, F.tid, QM, KN, KR, VM, unit(0), qr);
#pragma unroll 1
          for (int i = 0; i < nu; ++i) att::mla_unit(F.lds, F.tid, QM, KN, KR, VM, OA, OSS, unit(i), i + 1 < nu, unit(i + 1 < nu ? i + 1 : i), qr);
      } }
    for (int u = vcu; u < 1024; u += F.G) { const int bh = u >> 4; att::sb_unit(F.lds, F.tid, QKV, OA, OSS, bh >> 3, bh & 7, u & 15); }
}

__device__ __forceinline__ DenseSched dense_sched(const Frame& F, int N, const void* Bt, int K) { DenseSched S; S.o.init(T, N, F.G, F.bx); S.Bt = (const char*)Bt; S.K = K; return S; }
__device__ __forceinline__ void phase_inproj(Frame& F, int l) {
    const DenseSched S = dense_sched(F, INP, F.ws + WS_WSM + (size_t)l * WSM_STRIDE + WSM_IN, DM);
    const EpiIn E{wsp<float>(F, WS_SSQ), wsp<bf16_t>(F, WS_QKV), wsp<bf16_t>(F, WS_CKV), wsp<bf16_t>(F, WS_CQ), wsp<bf16_t>(F, WS_KR), wsp<float>(F, WS_COS), wsp<float>(F, WS_SIN), wsp<float>(F, WS_RSCQ), wsp<float>(F, WS_RSCKV)};
    pg8::gemm_phase(F.lds, F.tid, (const char*)(F.ws + WS_HBI), DM, S, E);
}
__device__ __forceinline__ void phase_uq(Frame& F, int l, int Gp, int cp) {
    DenseSched S; S.o.init(T, 768, Gp, cp); S.Bt = (const char*)(F.ws + WS_WSM + (size_t)l * WSM_STRIDE + WSM_UQ); S.K = QRANK;
    const EpiUq E{wsp<float>(F, WS_RSCQ), wsp<bf16_t>(F, WS_QM), wsp<float>(F, WS_COS), wsp<float>(F, WS_SIN)};
    pg8::gemm_phase(F.lds, F.tid, (const char*)(F.ws + WS_CQ), QRANK, S, E);
}
__device__ __forceinline__ void phase_ukv(Frame& F, int l, int Gp, int cp) {
    DenseSched S; S.o.init(T, 1024, Gp, cp); S.Bt = (const char*)(F.ws + WS_WSM + (size_t)l * WSM_STRIDE + WSM_UKV); S.K = KVRANK;
    const EpiUkv E{wsp<float>(F, WS_RSCKV), wsp<bf16_t>(F, WS_KN), wsp<bf16_t>(F, WS_VM)};
    pg8::gemm_phase(F.lds, F.tid, (const char*)(F.ws + WS_CKV), KVRANK, S, E);
}
__device__ __forceinline__ void phase_outproj(Frame& F, int l) {
    const DenseSched S = dense_sched(F, DM, F.ws + WS_WSM + (size_t)l * WSM_STRIDE + WSM_OUT, DM);
    EpiOut E; E.xin = l == 0 ? F.P->in[0] : nullptr; E.hin = wsp<bf16_t>(F, WS_HBI); E.hout = wsp<bf16_t>(F, WS_HB); E.OSS = wsp<float>(F, WS_OSS);
    pg8::gemm_phase(F.lds, F.tid, (const char*)(F.ws + WS_OA), DM, S, E);
}
__device__ __forceinline__ void moe_table(Frame& F, int l) {
    LAS int* tb = (LAS int*)(F.lds + pg8::STAGE_BYTES);
    __syncthreads();
    if (F.tid == 0) { const unsigned* cnt = wsp<unsigned>(F, WS_CTL) + CW_CNT + 64 * 32 * l; int acc = 0;
        for (int e = 0; e < NEXP; ++e) { const int c = (int)__hip_atomic_load(cnt + 64 * e, __ATOMIC_RELAXED, __HIP_MEMORY_SCOPE_AGENT); tb[e] = acc; tb[40 + e] = c; acc += (c + 255) >> 8; }
        tb[32] = acc; }
    __syncthreads();
}
__device__ __forceinline__ void phase_moe1(Frame& F, int l) {
    moe_table(F, l);
    MoeSched S; S.G = F.G; S.c = F.bx; S.npn = 2; S.gather = 1; S.tb = (const LAS int*)(F.lds + pg8::STAGE_BYTES); S.liste = wsp<int>(F, WS_LISTE); S.Bt = (const char*)(F.ws + WS_WG1); S.K = DM; S.nB = 512;
    const EpiG1 E{wsp<float>(F, WS_RS), wsp<int>(F, WS_LISTE), wsp<bf16_t>(F, WS_HID)};
    pg8::gemm_phase(F.lds, F.tid, (const char*)(F.ws + WS_HB), DM, S, E);
}
__device__ __forceinline__ void phase_moe2(Frame& F, int l) {
    moe_table(F, l);
    MoeSched S; S.G = F.G; S.c = F.bx; S.npn = 4; S.gather = 0; S.tb = (const LAS int*)(F.lds + pg8::STAGE_BYTES); S.liste = wsp<int>(F, WS_LISTE); S.Bt = (const char*)(F.ws + WS_WD); S.K = DEXP; S.nB = 1024;
    const EpiDn E{wsp<int>(F, WS_LISTE), wsp<float>(F, WS_LISTW), wsp<bf16_t>(F, WS_Y)};
    pg8::gemm_phase(F.lds, F.tid, (const char*)(F.ws + WS_HID), DEXP, S, E);
}
__device__ __forceinline__ void phase_pe(Frame& F, int l) {
    if ((F.G & 7) != 0 || F.G < 128) { const DenseSched S = dense_sched(F, DM, F.ws + WS_WSM + (size_t)l * WSM_STRIDE + WSM_PE, DPLE); const EpiBf E{wsp<bf16_t>(F, WS_PE), DM}; pg8::gemm_phase(F.lds, F.tid, (const char*)(F.ws + WS_PB), DPLE, S, E); return; }
    const int rank = F.bx >> 3; if (rank < 8) return;
    DenseSched S; S.o.init(T, DM, F.G - 64, (F.bx & 7) + 8 * (rank - 8)); S.Bt = (const char*)(F.ws + WS_WSM + (size_t)l * WSM_STRIDE + WSM_PE); S.K = DPLE;
    const EpiBf E{wsp<bf16_t>(F, WS_PE), DM};
    pg8::gemm_phase(F.lds, F.tid, (const char*)(F.ws + WS_PB), DPLE, S, E);
}
__device__ __forceinline__ void phase_ple(Frame& F, int l) {
    const DenseSched S = dense_sched(F, DM, F.ws + WS_WSM + (size_t)l * WSM_STRIDE + WSM_PG, DM);
    const EpiPle E{wsp<float>(F, WS_RS), wsp<bf16_t>(F, WS_PE), wsp<bf16_t>(F, WS_HB), wsp<bf16_t>(F, WS_HBI), wsp<float>(F, WS_SSQ)};
    pg8::gemm_phase(F.lds, F.tid, (const char*)(F.ws + WS_HB), DM, S, E);
}

#ifndef PROBE
#define PROBE 0
#endif
constexpr int CW_BAR = 4096;
constexpr int MISC_OFF = 150 * 1024;
static_assert(CW_BAR + XCD_BAR_WORDS <= CW_CNT && (CW_CNT + 64 * 32 * 2 * NLAYER) * 4 <= (int)CTL_BYTES && (CW_BAR + XCD_BAR_WORDS) * 4 <= (int)CTL_BYTES && MISC_OFF + 16 <= LDS_BYTES, "control words");
__global__ void __launch_bounds__(NTHREADS, 2) mega_fwd(Params P) {
    extern __shared__ __attribute__((aligned(16))) unsigned char lds_raw[];
    Frame F; F.lds = (LAS unsigned char*)lds_raw; F.tid = threadIdx.x; F.lane = F.tid & 63; F.wave = __builtin_amdgcn_readfirstlane(F.tid >> 6); F.G = gridDim.x; F.bx = blockIdx.x; F.P = &P; F.ws = P.ws;
    volatile LAS unsigned* st = (volatile LAS unsigned*)(F.lds + MISC_OFF);
    if (F.tid < 4) st[F.tid] = 0u;
    __syncthreads();
    const XcdBarrier bar = xcd_barrier_post(wsp<unsigned>(F, WS_CTL) + CW_BAR, st);
#define GRID_BAR() do { XcdBarrier b_ = bar; asm volatile("" : "+s"(b_.x)); asm volatile("" : "+s"(b_.bar)); xcd_barrier(b_); PH_BEGIN(); } while (0)
#define PH_BEGIN() do { asm volatile("" : "+v"(F.tid)); F.lane = F.tid & 63; asm volatile("" : "+s"(F.ws)); } while (0)
    phase_prep_small(F);
    phase_norm(F, P.in[0]);
#if PROBE == 11
    __syncthreads(); PH_BEGIN(); phase_prep_small(F); phase_norm(F, P.in[0]);
#endif
    GRID_BAR();
#if PROBE == 13
    GRID_BAR(); GRID_BAR(); GRID_BAR(); GRID_BAR(); GRID_BAR(); GRID_BAR(); GRID_BAR(); GRID_BAR(); GRID_BAR(); GRID_BAR();
    GRID_BAR(); GRID_BAR(); GRID_BAR(); GRID_BAR(); GRID_BAR(); GRID_BAR(); GRID_BAR(); GRID_BAR(); GRID_BAR(); GRID_BAR();
#endif
#ifndef TPROBE
#define TPROBE 0
#endif
#define TPH(id, ...) do { unsigned long long t0_ = 0; if (TPROBE == (id)) t0_ = __builtin_amdgcn_s_memrealtime(); __VA_ARGS__; GRID_BAR(); \
        if (TPROBE == (id)) { const unsigned long long t1_ = __builtin_amdgcn_s_memrealtime(); while (__builtin_amdgcn_s_memrealtime() - t1_ < 4ull * (t1_ - t0_)) __builtin_amdgcn_s_sleep(8); GRID_BAR(); } } while (0)
#pragma unroll 1
    for (int l = 0; l < NLAYER; ++l) {
        PH_BEGIN();
        TPH(1, phase_inproj(F, l); PH_BEGIN(); phase_prep_moe(F, l));
        { const bool split = (F.G & 15) == 0; const int Gp = split ? F.G / 2 : F.G;
          TPH(2, if (!split || F.bx < Gp) phase_uq(F, l, Gp, F.bx); PH_BEGIN(); if (!split || F.bx >= Gp) phase_ukv(F, l, Gp, split ? F.bx - Gp : F.bx)); }
        TPH(3, phase_attn(F));
        TPH(4, phase_outproj(F, l));
        TPH(5, phase_route(F, l));
        TPH(6, phase_moe1(F, l); PH_BEGIN(); phase_pe(F, l));
        TPH(7, phase_moe2(F, l));
        TPH(8, phase_norm2(F, l, 1.f));
        TPH(9, phase_ple(F, l));
    }
    phase_final(F);
#undef TPH
#undef GRID_BAR
#undef PH_BEGIN
}

extern "C" void kernel_launch(void* const* d_in, const int* in_sizes, int n_in, void* d_out, int out_size, void* d_ws, size_t ws_size, hipStream_t stream) {
    if (n_in != 24 || out_size != T * DM || ws_size < WS_END) { fprintf(stderr, "kernel_launch: unexpected shapes (n_in %d, out %d, ws %zu < %zu)\n", n_in, out_size, ws_size, (size_t)WS_END); return; }
    Params P{};
    for (int i = 0; i < 24; ++i) P.in[i] = (const float*)d_in[i];
    P.out = (float*)d_out; P.ws = (unsigned char*)d_ws;
    for (int i = 0; i < 16; ++i) P.inv_freq[i] = (float)pow(10000.0, -(double)i / 16.0);
    (void)hipMemsetAsync((char*)d_ws + WS_CTL, 0, CTL_BYTES, stream);
    static int grid = 0;
    if (grid == 0) {
        int dev = 0, cus = 0;
        if (hipGetDevice(&dev) != hipSuccess || hipDeviceGetAttribute(&cus, hipDeviceAttributeMultiprocessorCount, dev) != hipSuccess || cus <= 0) { grid = -1; return; }
        if (hipFuncSetAttribute((const void*)mega_fwd, hipFuncAttributeMaxDynamicSharedMemorySize, LDS_BYTES) != hipSuccess) { fprintf(stderr, "kernel_launch: hipFuncSetAttribute failed\n"); grid = -1; return; }
        grid = cus;
    }
    if (grid < 0) return;
    hipLaunchKernelGGL(mega_fwd, dim3(grid), dim3(NTHREADS), LDS_BYTES, stream, P);
}
```
